# Optimizing an MI355X kernel written in HIP

```python
import jax, jax.numpy as jnp
from jax import lax
import numpy as np

D_MODEL = 1024
BATCH = 8
SEQ = 8192
DEPTH = 4

GRID_W = 64
CTX_LEN = 256
EPS = 1e-6
N_HEADS = 8
N_KV_HEADS = 2
GQA_GROUP = N_HEADS // N_KV_HEADS
HEAD_DIM = 64
ATTN_WIDTH = N_HEADS * HEAD_DIM
KV_WIDTH = N_KV_HEADS * HEAD_DIM
ATTN_SCALE = HEAD_DIM ** -0.5
ROPE_THETA = 10000.0
ROPE_PAIRS_PER_AXIS = HEAD_DIM // 4
Q_BLOCK = 128
CONV_A_WIDTH = D_MODEL // 2
CONV_A_K = 31
EVEN_IN = ATTN_WIDTH + 2 * KV_WIDTH + 2 * CONV_A_WIDTH
EVEN_SPLITS = (ATTN_WIDTH, ATTN_WIDTH + KV_WIDTH, ATTN_WIDTH + 2 * KV_WIDTH,
               ATTN_WIDTH + 2 * KV_WIDTH + CONV_A_WIDTH)
EVEN_OUT = ATTN_WIDTH + CONV_A_WIDTH
SC_WIDTH = D_MODEL
SC_K = 3
N_EXPERTS = 16
N_GROUPS = 4
EXPERTS_PER_GROUP = N_EXPERTS // N_GROUPS
TOP_K = 2
D_EXPERT = 512
MOE_BLOCK = 256
N_EVEN = (DEPTH + 1) // 2
N_ODD = DEPTH // 2
LAST_ATTN_LAYER = (DEPTH - 1) - ((DEPTH - 1) % 2)

kernel_name = "hybrid_dit_conformer_gqa_shortconv_moe"


def rms_norm(x, g):
    xf = x.astype(jnp.float32)
    y = xf * lax.rsqrt(jnp.mean(xf * xf, axis=-1, keepdims=True) + EPS)
    return (y * g.astype(jnp.float32)).astype(x.dtype)


def layer_norm(x, g, b):
    xf = x.astype(jnp.float32)
    mu = jnp.mean(xf, axis=-1, keepdims=True)
    var = jnp.mean(jnp.square(xf - mu), axis=-1, keepdims=True)
    y = (xf - mu) * lax.rsqrt(var + EPS)
    return (y * g.astype(jnp.float32) + b.astype(jnp.float32)).astype(x.dtype)


def modulate(h, shift, scale):
    return h * (1 + scale) + shift


def depthwise_conv(x, w, pad):
    return lax.conv_general_dilated(x, w[:, None, :], window_strides=(1,), padding=[(pad, pad)],
                                    dimension_numbers=("NWC", "WIO", "NWC"),
                                    feature_group_count=x.shape[-1])


def axial_rope_tables(n_tokens):
    rows = n_tokens // GRID_W
    row = jnp.repeat(jnp.arange(rows, dtype=jnp.float32), GRID_W)
    col = jnp.tile(jnp.arange(GRID_W, dtype=jnp.float32), rows)
    inv = ROPE_THETA ** (-jnp.arange(ROPE_PAIRS_PER_AXIS, dtype=jnp.float32) / ROPE_PAIRS_PER_AXIS)
    ang = jnp.concatenate([row[:, None] * inv, col[:, None] * inv], axis=-1)
    return jnp.cos(ang), jnp.sin(ang)


def apply_rope(x, cos, sin):
    bshape = (1, cos.shape[0]) + (1,) * (x.ndim - 3) + (cos.shape[1],)
    cs, sn = cos.reshape(bshape), sin.reshape(bshape)
    xf = x.astype(jnp.float32).reshape(x.shape[:-1] + (HEAD_DIM // 2, 2))
    x1, x2 = xf[..., 0], xf[..., 1]
    out = jnp.stack([x1 * cs - x2 * sn, x1 * sn + x2 * cs], axis=-1)
    return out.reshape(x.shape).astype(x.dtype)


def gqa_attend(q, k, v):
    s = jnp.einsum("bqhgd,bkhd->bhgqk", q * ATTN_SCALE, k).astype(jnp.float32)
    p = jax.nn.softmax(s, axis=-1).astype(v.dtype)
    return jnp.einsum("bhgqk,bkhd->bqhgd", p, v)


def split_even(p, q_g, k_g):
    b, l, _ = p.shape
    q, k, v, a, a_gate = jnp.split(p, EVEN_SPLITS, axis=-1)
    q = rms_norm(q.reshape(b, l, N_KV_HEADS, GQA_GROUP, HEAD_DIM), q_g)
    k = rms_norm(k.reshape(b, l, N_KV_HEADS, HEAD_DIM), k_g)
    v = v.reshape(b, l, N_KV_HEADS, HEAD_DIM)
    return q, k, v, a * jax.nn.sigmoid(a_gate)


def conformer_conv(a, dw_w, dw_b, ln_g, ln_b):
    y = depthwise_conv(a, dw_w, CONV_A_K // 2) + dw_b
    return jax.nn.silu(layer_norm(y, ln_g, ln_b))


def even_mixer(hx, hz, w_in, q_g, k_g, dw_w, dw_b, ln_g, ln_b, w_out, cos, sin, ctx_out):
    b, s, _ = hx.shape
    qx, kx, vx, ax = split_even(hx @ w_in, q_g, k_g)
    qx = apply_rope(qx, cos, sin)
    kx = apply_rope(kx, cos, sin)
    if ctx_out:
        qz, kz, vz, az = split_even(hz @ w_in, q_g, k_g)
    else:
        kz, vz = jnp.split(hz @ w_in[:, ATTN_WIDTH:ATTN_WIDTH + 2 * KV_WIDTH], 2, axis=-1)
        kz = rms_norm(kz.reshape(b, -1, N_KV_HEADS, HEAD_DIM), k_g)
        vz = vz.reshape(b, -1, N_KV_HEADS, HEAD_DIM)
    k_all = jnp.concatenate([kx, kz], axis=1)
    v_all = jnp.concatenate([vx, vz], axis=1)
    n_blk = s // Q_BLOCK
    q_blocks = qx.reshape(b, n_blk, Q_BLOCK, N_KV_HEADS, GQA_GROUP, HEAD_DIM).swapaxes(0, 1)
    attn_x = lax.map(lambda qb: gqa_attend(qb, k_all, v_all), q_blocks)
    attn_x = attn_x.swapaxes(0, 1).reshape(b, s, ATTN_WIDTH)
    ox = jnp.concatenate([attn_x, conformer_conv(ax, dw_w, dw_b, ln_g, ln_b)], axis=-1) @ w_out
    if not ctx_out:
        return ox, None
    attn_z = gqa_attend(qz, kz, vz).reshape(b, -1, ATTN_WIDTH)
    oz = jnp.concatenate([attn_z, conformer_conv(az, dw_w, dw_b, ln_g, ln_b)], axis=-1) @ w_out
    return ox, oz


def short_conv_mixer(h, w_in, conv_w, w_out):
    gb, gc, v = jnp.split(h @ w_in, 3, axis=-1)
    return (gb * depthwise_conv(gc * v, conv_w, SC_K // 2)) @ w_out


def route(h, router_w, router_bias):
    aff = jax.nn.sigmoid((h @ router_w).astype(jnp.float32))
    sel = (aff + router_bias.astype(jnp.float32)).reshape(-1, N_GROUPS, EXPERTS_PER_GROUP)
    grp_score = lax.top_k(sel, 2)[0].sum(-1)
    grp = jnp.argmax(grp_score, axis=-1)
    sel_in = jnp.take_along_axis(sel, grp[:, None, None], axis=1)[:, 0]
    _, local = lax.top_k(sel_in, TOP_K)
    e_idx = (grp[:, None] * EXPERTS_PER_GROUP + local).astype(jnp.int32)
    w = jnp.take_along_axis(aff, e_idx, axis=1)
    return e_idx, w / w.sum(-1, keepdims=True)


def moe_ffn(h, router_w, router_bias, w_gate, w_up, w_down):
    n_tok = h.shape[0]
    n_assign = n_tok * TOP_K
    e_idx, e_w = route(h, router_w, router_bias)
    flat_e = e_idx.reshape(-1)
    order = jnp.argsort(flat_e)
    counts = jnp.bincount(flat_e, length=N_EXPERTS).astype(jnp.int32)
    padded = (counts + MOE_BLOCK - 1) // MOE_BLOCK * MOE_BLOCK
    starts = jnp.cumsum(counts) - counts
    pad_ends = jnp.cumsum(padded)
    pad_starts = pad_ends - padded
    sorted_e = flat_e[order]
    dest_sorted = pad_starts[sorted_e] + jnp.arange(n_assign, dtype=jnp.int32) - starts[sorted_e]
    dest = jnp.zeros((n_assign,), jnp.int32).at[order].set(dest_sorted.astype(jnp.int32))
    n_blocks = -(-n_assign // MOE_BLOCK) + N_EXPERTS
    n_rows = n_blocks * MOE_BLOCK
    row_token = jnp.full((n_rows,), n_tok, jnp.int32).at[dest].set(
        jnp.arange(n_assign, dtype=jnp.int32) // TOP_K)
    block_e = jnp.minimum(jnp.searchsorted(pad_ends, jnp.arange(n_blocks, dtype=jnp.int32) * MOE_BLOCK,
                                           side="right"), N_EXPERTS - 1)

    def expert_block(args):
        tok, e = args
        xb = jnp.take(h, tok, axis=0, mode="fill", fill_value=0)
        return (jax.nn.silu(xb @ w_gate[e]) * (xb @ w_up[e])) @ w_down[e]

    out = lax.map(expert_block, (row_token.reshape(n_blocks, MOE_BLOCK), block_e)).reshape(n_rows, -1)
    y = out[dest].reshape(n_tok, TOP_K, -1) * e_w[..., None].astype(h.dtype)
    return y.sum(axis=1)


def setup_inputs(seed: int = 0) -> dict:
    key = jax.random.key(seed)
    ks = jax.random.split(key, 24)
    D = D_MODEL

    def nrm(k, shape, scale):
        return jax.random.normal(k, shape, jnp.float32) * scale

    return {
        "x": nrm(ks[0], (BATCH, SEQ, D), 1.0),
        "c": nrm(ks[1], (BATCH, D), 1.0),
        "ctx": nrm(ks[2], (BATCH, CTX_LEN, D), 1.0),
        "c_ctx": nrm(ks[3], (D,), 1.0),
        "w_mod": nrm(ks[4], (DEPTH, D, 6 * D), 0.5 * D ** -0.5),
        "b_mod": nrm(ks[5], (DEPTH, 6 * D), 0.02),
        "norm_mix_g": 1.0 + nrm(ks[6], (DEPTH, D), 0.02),
        "norm_ffn_g": 1.0 + nrm(ks[7], (DEPTH, D), 0.02),
        "ev_w_in": nrm(ks[8], (N_EVEN, D, EVEN_IN), D ** -0.5),
        "ev_q_norm_g": 1.0 + nrm(ks[9], (N_EVEN, HEAD_DIM), 0.02),
        "ev_k_norm_g": 1.0 + nrm(ks[10], (N_EVEN, HEAD_DIM), 0.02),
        "ev_dw_w": nrm(ks[11], (N_EVEN, CONV_A_K, CONV_A_WIDTH), CONV_A_K ** -0.5),
        "ev_dw_b": nrm(ks[12], (N_EVEN, CONV_A_WIDTH), 0.02),
        "ev_ln_g": 1.0 + nrm(ks[13], (N_EVEN, CONV_A_WIDTH), 0.02),
        "ev_ln_b": nrm(ks[14], (N_EVEN, CONV_A_WIDTH), 0.02),
        "ev_w_out": nrm(ks[15], (N_EVEN, EVEN_OUT, D), EVEN_OUT ** -0.5),
        "od_w_in": nrm(ks[16], (N_ODD, D, 3 * SC_WIDTH), D ** -0.5),
        "od_conv_w": nrm(ks[17], (N_ODD, SC_K, SC_WIDTH), SC_K ** -0.5),
        "od_w_out": nrm(ks[18], (N_ODD, SC_WIDTH, D), SC_WIDTH ** -0.5),
        "router_w": nrm(ks[19], (D, N_EXPERTS), D ** -0.5),
        "router_bias": nrm(ks[20], (N_EXPERTS,), 0.01),
        "moe_w_gate": nrm(ks[21], (DEPTH, N_EXPERTS, D, D_EXPERT), D ** -0.5),
        "moe_w_up": nrm(ks[22], (DEPTH, N_EXPERTS, D, D_EXPERT), D ** -0.5),
        "moe_w_down": nrm(ks[23], (DEPTH, N_EXPERTS, D_EXPERT, D), D_EXPERT ** -0.5),
    }


def reference(x, c, ctx, c_ctx, w_mod, b_mod, norm_mix_g, norm_ffn_g, ev_w_in, ev_q_norm_g,
              ev_k_norm_g, ev_dw_w, ev_dw_b, ev_ln_g, ev_ln_b, ev_w_out, od_w_in, od_conv_w,
              od_w_out, router_w, router_bias, moe_w_gate, moe_w_up, moe_w_down):
    b, s, d = x.shape
    cos, sin = axial_rope_tables(s)
    z = ctx
    c_act = jax.nn.silu(c)
    cz_act = jax.nn.silu(c_ctx)
    n_lat = b * s
    for l in range(DEPTH):
        i = l // 2
        is_attn = l % 2 == 0
        ctx_in = l <= LAST_ATTN_LAYER
        ctx_out = l < LAST_ATTN_LAYER
        mx = jnp.split(c_act @ w_mod[l] + b_mod[l], 6, axis=-1)
        hx = modulate(rms_norm(x, norm_mix_g[l]), mx[0][:, None], mx[1][:, None])
        hz = None
        if ctx_in:
            mz = jnp.split(cz_act @ w_mod[l] + b_mod[l], 6, axis=-1)
            hz = modulate(rms_norm(z, norm_mix_g[l]), mz[0], mz[1])
        if is_attn:
            ox, oz = even_mixer(hx, hz, ev_w_in[i], ev_q_norm_g[i], ev_k_norm_g[i], ev_dw_w[i],
                                ev_dw_b[i], ev_ln_g[i], ev_ln_b[i], ev_w_out[i], cos, sin, ctx_out)
        else:
            ox = short_conv_mixer(hx, od_w_in[i], od_conv_w[i], od_w_out[i])
            oz = short_conv_mixer(hz, od_w_in[i], od_conv_w[i], od_w_out[i]) if ctx_out else None
        x = x + mx[2][:, None] * ox
        hx = modulate(rms_norm(x, norm_ffn_g[l]), mx[3][:, None], mx[4][:, None])
        if ctx_out:
            z = z + mz[2] * oz
            hz = modulate(rms_norm(z, norm_ffn_g[l]), mz[3], mz[4])
            tokens = jnp.concatenate([hx.reshape(-1, d), hz.reshape(-1, d)], axis=0)
        else:
            tokens = hx.reshape(-1, d)
        y = moe_ffn(tokens, router_w, router_bias, moe_w_gate[l], moe_w_up[l], moe_w_down[l])
        x = x + mx[5][:, None] * y[:n_lat].reshape(b, s, d)
        if ctx_out:
            z = z + mz[5] * y[n_lat:].reshape(z.shape)
    return x
```

```cpp
#include <hip/hip_runtime.h>
#include <cstdio>
#include <cstdint>

#ifndef MK_ONE_LAUNCH
#define MK_ONE_LAUNCH 1
#endif

#define LAS __attribute__((address_space(3)))
#define GAS __attribute__((address_space(1)))
typedef unsigned short bf16;
typedef short bf16x8 __attribute__((ext_vector_type(8)));
typedef float f32x4 __attribute__((ext_vector_type(4)));
typedef float f32x2 __attribute__((ext_vector_type(2)));
typedef unsigned u32x4 __attribute__((ext_vector_type(4)));
typedef unsigned u32x2 __attribute__((ext_vector_type(2)));
typedef __bf16 bf16x2_t __attribute__((ext_vector_type(2)));

constexpr int D = 1024, NB = 8, SEQ = 8192, NLAT = NB * SEQ, CTXL = 256, NCTX = NB * CTXL, TALL = NLAT + NCTX, ZROW = TALL;
constexpr int KVS = SEQ + CTXL;
constexpr int NH = 8, NKVH = 2, HD = 64, AW = 512, KVW = 128, CAW = 512, EVIN = 1792, ODIN = 3072;
constexpr int NE = 16, DE = 512, MAXBLK = 544, MAXROWS = MAXBLK * 256, VCAP = 2 * TALL;
constexpr int DEPTH = 4;
constexpr float EPS = 1e-6f;
constexpr float C2 = 0.125f * 1.4426950408889634f;

constexpr size_t MiB = 1u << 20;
constexpr size_t WS_CTL = 0, CTL_ZERO_BYTES = 128 * 1024;
constexpr size_t WS_MOD = 1 * MiB;
constexpr size_t WS_ROPE = 2 * MiB;
constexpr size_t WS_RT = 3 * MiB;
constexpr size_t WS_DEST = 5 * MiB;
constexpr size_t WS_WB = 6 * MiB;
constexpr size_t WS_ROWTOK = 931 * MiB;
constexpr size_t WS_Z = 8 * MiB;
constexpr size_t WS_W_EVIN = 16 * MiB, WS_W_EVOUT = 23 * MiB, WS_W_ODIN = 27 * MiB, WS_W_ODOUT = 39 * MiB, WS_W_MOE1 = 43 * MiB, WS_W_MOE2 = 171 * MiB;
constexpr size_t WS_HB = 236 * MiB;
constexpr size_t WS_BIG = 369 * MiB;
constexpr size_t WS_P = WS_BIG, WS_CAT = WS_BIG, WS_OX = 501 * MiB, WS_HMID = WS_BIG, WS_Y = 505 * MiB;
constexpr size_t WS_Q = 765 * MiB, WS_K = 831 * MiB, WS_V = 848 * MiB, WS_AG = 865 * MiB, WS_S = 765 * MiB;
constexpr size_t WS_U = WS_BIG, WS_GB = 633 * MiB;
constexpr size_t WS_END = 940 * MiB;
constexpr int CW_TMO = 0, CW_CODE = 1, CW_BAR = 4096, CW_CNT = 8192;

constexpr int RING_BYTES = 131072, LDSCTL_OFF = RING_BYTES, MISC_OFF = LDSCTL_OFF + 320, LDS_BYTES = 147456;
constexpr int NWAVES = 8, NTHR = 512;

__device__ __forceinline__ unsigned pk2(float lo, float hi) { f32x2 v = {lo, hi}; bf16x2_t b = __builtin_convertvector(v, bf16x2_t); return __builtin_bit_cast(unsigned, b); }
__device__ __forceinline__ float bflo(unsigned w) { return __uint_as_float(w << 16); }
__device__ __forceinline__ float bfhi(unsigned w) { return __uint_as_float(w & 0xffff0000u); }
__device__ __forceinline__ void unpack8(const u32x4 w, float* f) { f[0] = bflo(w.x); f[1] = bfhi(w.x); f[2] = bflo(w.y); f[3] = bfhi(w.y); f[4] = bflo(w.z); f[5] = bfhi(w.z); f[6] = bflo(w.w); f[7] = bfhi(w.w); }
__device__ __forceinline__ u32x4 pack8(const float* f) { u32x4 w; w.x = pk2(f[0], f[1]); w.y = pk2(f[2], f[3]); w.z = pk2(f[4], f[5]); w.w = pk2(f[6], f[7]); return w; }
__device__ __forceinline__ float wave_sum(float v) {
#pragma unroll
    for (int o = 1; o < 64; o <<= 1) v += __shfl_xor(v, o);
    return v;
}
__device__ __forceinline__ float fast_exp2(float x) { return __builtin_amdgcn_exp2f(x); }
__device__ __forceinline__ float fast_rcp(float x) { return __builtin_amdgcn_rcpf(x); }
__device__ __forceinline__ float sigmoidf_(float x) { return fast_rcp(1.0f + fast_exp2(-1.4426950408889634f * x)); }
__device__ __forceinline__ float siluf_(float x) { return x * sigmoidf_(x); }
__device__ __forceinline__ unsigned opaque_zero() { unsigned z = 0u; asm volatile("" : "+v"(z)); return z; }
__device__ __forceinline__ unsigned long long rfl64(unsigned long long v) { const unsigned lo = __builtin_amdgcn_readfirstlane((unsigned)v), hi = __builtin_amdgcn_readfirstlane((unsigned)(v >> 32)); return ((unsigned long long)hi << 32) | lo; }
#define LDS_WAIT() asm volatile("s_waitcnt lgkmcnt(0)" ::: "memory")

namespace pg8 {
constexpr int BM = 256, BK = 64, HALF = 128, HTB = HALF * BK * 2, STAGE_BYTES = 8 * HTB, NXCD = 8, WGM = 8;
__host__ __device__ __forceinline__ int lds_byte(int r, int c) { const int st = (r >> 4) * 2 + (c >> 5), rr = r & 15, cc = c & 31, ob = rr * 64 + cc * 2; return st * 1024 + (ob ^ (((ob >> 9) & 1) << 5)); }
__host__ __device__ __forceinline__ void stage_rc(int b, int& R, int& C) { const int st = b / 1024, sb = b % 1024, swz = sb ^ (((sb >> 9) & 1) << 5); R = (st >> 1) * 16 + swz / 64; C = (st & 1) * 32 + (swz % 64) / 2; }
__host__ __device__ __forceinline__ int perm32(int rho) { const int n = rho >> 4, i = rho & 15; return 8 * (i >> 2) + 4 * n + (i & 3); }

struct Unit { int pm, pn, e; };

struct DenseOrder {
    int nM, nN, nwg, G, c, K; const bf16* Bt;
    __device__ void init(int M, int N, int K_, const bf16* Bt_, int G_, int c_) { nM = M / BM; nN = N / BM; nwg = nM * nN; G = G_; c = c_; K = K_; Bt = Bt_; }
    __device__ bool next(int i, Unit& u) const {
        const long L = (long)i * G + c; if (L >= nwg) return false;
        int wgid = (int)L; { const int q = nwg / NXCD, r = nwg % NXCD, xcd = wgid % NXCD, off = wgid / NXCD; wgid = (xcd < r ? xcd * (q + 1) : r * (q + 1) + (xcd - r) * q) + off; }
        const int nig = WGM * nN, gid = wgid / nig, fm = gid * WGM, gsz = (nM - fm) < WGM ? (nM - fm) : WGM;
        u.pm = fm + ((wgid % nig) % gsz); u.pn = (wgid % nig) / gsz; u.e = 0; return true;
    }
    __device__ __forceinline__ const char* bbase(const Unit& u) const { return (const char*)Bt + (size_t)u.pn * 256 * K * 2; }
    __device__ __forceinline__ void aoffs(const Unit& u, const int (&Rr)[2], const int (&Cc)[2], unsigned (&a)[2][2]) const {
#pragma unroll
        for (int h = 0; h < 2; ++h)
#pragma unroll
            for (int i = 0; i < 2; ++i) a[h][i] = (unsigned)((u.pm * 256 + h * 128 + Rr[i]) * K + Cc[i]) * 2u;
    }
};
template <bool GATHER> struct MoeOrder {
    int nblk, G, c, K; const bf16* Bt; size_t estride; const LAS int* pend; const unsigned* rowtok;
    __device__ bool next(int i, Unit& u) const {
        const long L = (long)i * G + c; if (L >= (long)nblk * 4) return false;
        u.pm = (int)(L >> 2); u.pn = (int)(L & 3); const int r0 = u.pm * 256; int e = 0;
#pragma unroll
        for (int j = 0; j < 15; ++j) e += (r0 >= pend[j]) ? 1 : 0;
        u.e = __builtin_amdgcn_readfirstlane(e); return true;
    }
    __device__ __forceinline__ const char* bbase(const Unit& u) const { return (const char*)Bt + (size_t)u.e * estride + (size_t)u.pn * 256 * K * 2; }
    __device__ __forceinline__ void aoffs(const Unit& u, const int (&Rr)[2], const int (&Cc)[2], unsigned (&a)[2][2]) const {
#pragma unroll
        for (int h = 0; h < 2; ++h)
#pragma unroll
            for (int i = 0; i < 2; ++i) { const int row = u.pm * 256 + h * 128 + Rr[i]; unsigned src = (unsigned)row;
                if (GATHER) { const int rin = row - pend[16 + u.e]; const unsigned tk = rowtok[(size_t)u.e * VCAP + rin]; src = rin < pend[32 + u.e] ? tk : (unsigned)ZROW; }
                a[h][i] = (src * (unsigned)K + (unsigned)Cc[i]) * 2u; }
    }
};

struct EpiPlain {
    bf16* O; int ldc;
    __device__ __forceinline__ void operator()(const f32x4 (&acc)[2][2][4][2], const Unit& u, int wr, int wc, int fr, int fq) const {
        const int row0 = u.pm * BM + wr * 64 + fr, col0 = u.pn * BM + wc * 32 + 8 * fq;
#pragma unroll
        for (int ai = 0; ai < 2; ++ai)
#pragma unroll
            for (int m = 0; m < 4; ++m) { bf16* rowp = O + (size_t)(row0 + ai * HALF + m * 16) * ldc + col0;
#pragma unroll
                for (int bj = 0; bj < 2; ++bj) { const f32x4 v0 = acc[ai][bj][m][0], v1 = acc[ai][bj][m][1];
                    u32x4 w; w.x = pk2(v0[0], v0[1]); w.y = pk2(v0[2], v0[3]); w.z = pk2(v1[0], v1[1]); w.w = pk2(v1[2], v1[3]);
                    *(u32x4*)(rowp + bj * HALF) = w; } }
    }
};
struct EpiSwiGLU {
    bf16* H;
    __device__ __forceinline__ void operator()(const f32x4 (&acc)[2][2][4][2], const Unit& u, int wr, int wc, int fr, int fq) const {
        const int row0 = u.pm * BM + wr * 64 + fr, col0 = u.pn * 128 + wc * 32 + 8 * fq;
#pragma unroll
        for (int ai = 0; ai < 2; ++ai)
#pragma unroll
            for (int m = 0; m < 4; ++m) { bf16* rowp = H + (size_t)(row0 + ai * HALF + m * 16) * DE + col0;
                float o[8];
#pragma unroll
                for (int n = 0; n < 2; ++n)
#pragma unroll
                    for (int j = 0; j < 4; ++j) { const float g = acc[ai][0][m][n][j], up = acc[ai][1][m][n][j]; o[n * 4 + j] = siluf_(g) * up; }
                *(u32x4*)rowp = pack8(o); }
    }
};

struct EpiEvenIn {
    bf16 *Q, *KB, *VB, *AG; const float* qg; const float* kg; const f32x2* rope;
    __device__ __forceinline__ void operator()(const f32x4 (&acc)[2][2][4][2], const Unit& u, int wr, int wc, int fr, int fq) const {
        const int row0 = u.pm * BM + wr * 64 + fr;
        if (u.pn >= 3) {
            const int col0 = (u.pn - 3) * 128 + wc * 32 + 8 * fq;
#pragma unroll
            for (int ai = 0; ai < 2; ++ai)
#pragma unroll
                for (int m = 0; m < 4; ++m) { float o[8];
#pragma unroll
                    for (int n = 0; n < 2; ++n)
#pragma unroll
                        for (int j = 0; j < 4; ++j) o[n * 4 + j] = acc[ai][0][m][n][j] * sigmoidf_(acc[ai][1][m][n][j]);
                    *(u32x4*)(AG + (size_t)(row0 + ai * HALF + m * 16) * CAW + col0) = pack8(o); }
            return;
        }
        if (u.pn == 2 && wc >= 2) {
#pragma unroll
            for (int ai = 0; ai < 2; ++ai)
#pragma unroll
                for (int m = 0; m < 4; ++m) { const int row = row0 + ai * HALF + m * 16;
                    const size_t kvrow = row < NLAT ? (size_t)(row >> 13) * KVS + (row & (SEQ - 1)) : (size_t)((row - NLAT) >> 8) * KVS + SEQ + ((row - NLAT) & 255);
#pragma unroll
                    for (int bj = 0; bj < 2; ++bj) { float o[8];
#pragma unroll
                        for (int n = 0; n < 2; ++n)
#pragma unroll
                            for (int j = 0; j < 4; ++j) o[n * 4 + j] = acc[ai][bj][m][n][j];
                        *(u32x4*)(VB + kvrow * KVW + (wc - 2) * 64 + 32 * bj + 8 * fq) = pack8(o); } }
            return;
        }
        const bool isq = u.pn < 2; const float* g = isq ? qg : kg; const float post = isq ? C2 : 1.0f;
        f32x4 gv[2][2];
#pragma unroll
        for (int bj = 0; bj < 2; ++bj)
#pragma unroll
            for (int n = 0; n < 2; ++n) gv[bj][n] = *(const f32x4*)(g + 32 * bj + 8 * fq + 4 * n);
#pragma unroll
        for (int ai = 0; ai < 2; ++ai)
#pragma unroll
            for (int m = 0; m < 4; ++m) { const int row = row0 + ai * HALF + m * 16;
                float ss = 0.f;
#pragma unroll
                for (int bj = 0; bj < 2; ++bj)
#pragma unroll
                    for (int n = 0; n < 2; ++n) { const f32x4 x = acc[ai][bj][m][n]; ss += (x[0] * x[0] + x[1] * x[1]) + (x[2] * x[2] + x[3] * x[3]); }
                ss += __shfl_xor(ss, 16); ss += __shfl_xor(ss, 32);
                const float rstd = __builtin_amdgcn_rsqf(ss * (1.0f / 64.0f) + EPS);
                const bool isx = row < NLAT; const int pos = row & (SEQ - 1);
                bf16* dst; if (isq) dst = Q + (size_t)row * AW + (u.pn * 4 + wc) * 64;
                else { const size_t kvrow = isx ? (size_t)(row >> 13) * KVS + pos : (size_t)((row - NLAT) >> 8) * KVS + SEQ + ((row - NLAT) & 255); dst = KB + kvrow * KVW + wc * 64; }
#pragma unroll
                for (int bj = 0; bj < 2; ++bj) { float o[8];
                    const int ps = bj ? (pos & 63) : (pos >> 6);
#pragma unroll
                    for (int n = 0; n < 2; ++n) { f32x4 f = acc[ai][bj][m][n] * rstd * gv[bj][n];
                        if (isx) { const f32x4 cs = *(const f32x4*)(rope + ps * 16 + 4 * fq + 2 * n);
                            const float x0 = f[0], x1 = f[1], x2 = f[2], x3 = f[3];
                            f[0] = x0 * cs[0] - x1 * cs[1]; f[1] = x0 * cs[1] + x1 * cs[0]; f[2] = x2 * cs[2] - x3 * cs[3]; f[3] = x2 * cs[3] + x3 * cs[2]; }
                        o[n * 4 + 0] = f[0] * post; o[n * 4 + 1] = f[1] * post; o[n * 4 + 2] = f[2] * post; o[n * 4 + 3] = f[3] * post; }
                    *(u32x4*)(dst + 32 * bj + 8 * fq) = pack8(o); } }
    }
};
struct EpiOddIn {
    bf16 *U, *GB;
    __device__ __forceinline__ void operator()(const f32x4 (&acc)[2][2][4][2], const Unit& u, int wr, int wc, int fr, int fq) const {
        const int row0 = u.pm * BM + wr * 64 + fr;
#pragma unroll
        for (int ai = 0; ai < 2; ++ai)
#pragma unroll
            for (int m = 0; m < 4; ++m) { const size_t row = (size_t)(row0 + ai * HALF + m * 16);
                if (u.pn < 8) { float o[8];
#pragma unroll
                    for (int n = 0; n < 2; ++n)
#pragma unroll
                        for (int j = 0; j < 4; ++j) o[n * 4 + j] = acc[ai][0][m][n][j] * acc[ai][1][m][n][j];
                    *(u32x4*)(U + row * D + u.pn * 128 + wc * 32 + 8 * fq) = pack8(o);
                } else {
#pragma unroll
                    for (int bj = 0; bj < 2; ++bj) { float o[8];
#pragma unroll
                        for (int n = 0; n < 2; ++n)
#pragma unroll
                            for (int j = 0; j < 4; ++j) o[n * 4 + j] = acc[ai][bj][m][n][j];
                        *(u32x4*)(GB + row * D + (u.pn - 8) * 256 + bj * HALF + wc * 32 + 8 * fq) = pack8(o); } } }
    }
};
struct EvenInOrder {
    DenseOrder d; bool kvonly;
    __device__ bool next(int i, Unit& u) const {
        const long L = (long)i * d.G + d.c; const int nx = d.nwg;
        if (L < nx) return d.next(i, u);
        const int j = (int)(L - nx); const int nextra = kvonly ? (NCTX / 256) : (NCTX / 256) * 7; if (j >= nextra) return false;
        if (kvonly) { u.pm = NLAT / 256 + j; u.pn = 2; } else { u.pm = NLAT / 256 + j / 7; u.pn = j % 7; }
        u.e = 0; return true;
    }
    __device__ __forceinline__ const char* bbase(const Unit& u) const { return d.bbase(u); }
    __device__ __forceinline__ void aoffs(const Unit& u, const int (&Rr)[2], const int (&Cc)[2], unsigned (&a)[2][2]) const { d.aoffs(u, Rr, Cc, a); }
};

template <class Epi, class Sched>
__device__ __forceinline__ void gemm_phase(LAS unsigned char* lds, const bf16* A, const int K, const Sched& S, const Epi& E, const int tid) {
    const int wid = __builtin_amdgcn_readfirstlane(tid >> 6), lane = tid & 63, wr = wid >> 2, wc = wid & 3, fr = lane & 15, fq = lane >> 4;
    const int nt = K / BK;
    int Rr[2], Cc[2]; unsigned voffB[2];
#pragma unroll
    for (int i = 0; i < 2; ++i) { int R, C; stage_rc(tid * 16 + i * 8192, R, C); const int Rb = (R & ~31) + perm32(R & 31); Rr[i] = R; Cc[i] = C; voffB[i] = (unsigned)(Rb * K + C) * 2u; }
    const size_t kstep = (size_t)(BK * 2);
    const size_t hstep = (size_t)HALF * K * 2;
    const unsigned ldsw = (unsigned)wid * 1024u;
    const int aoff = lds_byte(wr * 64 + fr, fq * 8), boff = lds_byte(wc * 32 + fr, fq * 8);
    const char* Ab = (const char*)A;
#define PG8_SA(b, h) (((b) * 2 + (h)) * HTB)
#define PG8_SB(b, h) ((4 + (b) * 2 + (h)) * HTB)
#define PG8_STAGE_B(bufoff, gbase) do { const char* _ub = (const char*)(gbase); asm volatile("" : "+s"(_ub)); _Pragma("unroll") for (int _i = 0; _i < 2; ++_i) \
        __builtin_amdgcn_global_load_lds((const unsigned*)(_ub + voffB[_i]), (LAS unsigned*)(lds + (bufoff) + ldsw + _i * 8192), 16, 0, 0); } while (0)
#define PG8_STAGE_A(bufoff, kb, offs) do { const char* _ub = Ab + (size_t)(kb); asm volatile("" : "+s"(_ub)); _Pragma("unroll") for (int _i = 0; _i < 2; ++_i) \
        __builtin_amdgcn_global_load_lds((const unsigned*)(_ub + (offs)[_i]), (LAS unsigned*)(lds + (bufoff) + ldsw + _i * 8192), 16, 0, 0); } while (0)
#define PG8_LDA(dst, b, h) do { _Pragma("unroll") for (int m = 0; m < 4; ++m) _Pragma("unroll") for (int k = 0; k < 2; ++k) dst[m][k] = *(const LAS bf16x8*)(lds + PG8_SA(b, h) + aoff + m * 2048 + k * 1024); } while (0)
#define PG8_LDB(dst, b, h) do { _Pragma("unroll") for (int n = 0; n < 2; ++n) _Pragma("unroll") for (int k = 0; k < 2; ++k) dst[n][k] = *(const LAS bf16x8*)(lds + PG8_SB(b, h) + boff + n * 2048 + k * 1024); } while (0)
#define PG8_MMA(ai, bj, At, Bt) do { __builtin_amdgcn_s_setprio(1); _Pragma("unroll") for (int m = 0; m < 4; ++m) _Pragma("unroll") for (int n = 0; n < 2; ++n) _Pragma("unroll") for (int k = 0; k < 2; ++k) \
        acc[ai][bj][m][n] = __builtin_amdgcn_mfma_f32_16x16x32_bf16(Bt[n][k], At[m][k], acc[ai][bj][m][n], 0, 0, 0); __builtin_amdgcn_s_setprio(0); } while (0)
#define PG8_WAIT_V(n) asm volatile("s_waitcnt vmcnt(" #n ")" ::: "memory")
#define PG8_WAIT_L(n) asm volatile("s_waitcnt lgkmcnt(" #n ")" ::: "memory")
#define PG8_BAR __builtin_amdgcn_s_barrier()
#define PG8_SCHED __builtin_amdgcn_sched_barrier(0)
    Unit cur, nxt; int ui = 0;
    if (!S.next(0, cur)) return;
    f32x4 acc[2][2][4][2];
#pragma unroll
    for (int a = 0; a < 2; ++a)
#pragma unroll
        for (int b = 0; b < 2; ++b)
#pragma unroll
            for (int m = 0; m < 4; ++m)
#pragma unroll
                for (int n = 0; n < 2; ++n) acc[a][b][m][n] = (f32x4){0.f, 0.f, 0.f, 0.f};
    bf16x8 At[4][2], B0[2][2], B1[2][2];
    unsigned aC[2][2], aN[2][2];
    S.aoffs(cur, Rr, Cc, aC);
    const char* cB = S.bbase(cur);
    PG8_STAGE_B(PG8_SB(0, 0), cB); PG8_STAGE_B(PG8_SB(0, 1), cB + hstep); PG8_STAGE_A(PG8_SA(0, 0), 0, aC[0]); PG8_STAGE_A(PG8_SA(0, 1), 0, aC[1]);
    if (wr == 1) PG8_BAR;
    PG8_WAIT_V(2); PG8_BAR;
    PG8_STAGE_B(PG8_SB(1, 0), cB + kstep); PG8_STAGE_A(PG8_SA(1, 0), kstep, aC[0]); PG8_STAGE_B(PG8_SB(1, 1), cB + hstep + kstep);
    PG8_WAIT_V(6); PG8_BAR;
    for (;;) {
        const bool has_next = S.next(ui + 1, nxt);
        const char* nB = has_next ? S.bbase(nxt) : cB;
        if (has_next) S.aoffs(nxt, Rr, Cc, aN);
        else {
#pragma unroll
            for (int h = 0; h < 2; ++h)
#pragma unroll
                for (int i = 0; i < 2; ++i) aN[h][i] = aC[h][i];
        }
#pragma unroll 1
        for (int t = 0; t < nt; t += 2) {
            const bool last = (t == nt - 2);
            const size_t kb1 = (size_t)(t + 1) * kstep;
            const size_t kb2 = last ? (size_t)0 : (size_t)(t + 2) * kstep, kb3 = kb2 + kstep;
            const char* b2 = last ? nB : cB + (size_t)(t + 2) * kstep; const char* b3 = b2 + kstep;
            unsigned x2[2][2];
#pragma unroll
            for (int h = 0; h < 2; ++h)
#pragma unroll
                for (int i = 0; i < 2; ++i) x2[h][i] = last ? aN[h][i] : aC[h][i];
            PG8_LDB(B0, 0, 0); PG8_LDB(B1, 0, 1); PG8_SCHED; PG8_LDA(At, 0, 0); PG8_STAGE_A(PG8_SA(1, 1), kb1, aC[1]);
            PG8_WAIT_V(8); PG8_WAIT_L(0); PG8_BAR; PG8_MMA(0, 0, At, B0); PG8_MMA(0, 1, At, B1); PG8_BAR; PG8_SCHED;
            PG8_LDA(At, 0, 1); PG8_STAGE_B(PG8_SB(0, 0), b2); PG8_STAGE_B(PG8_SB(0, 1), b2 + hstep); PG8_STAGE_A(PG8_SA(0, 0), kb2, x2[0]);
            PG8_WAIT_V(8); PG8_WAIT_L(0); PG8_BAR; PG8_MMA(1, 0, At, B0); PG8_MMA(1, 1, At, B1); PG8_BAR; PG8_SCHED;
            PG8_LDB(B0, 1, 0); PG8_LDB(B1, 1, 1); PG8_SCHED; PG8_LDA(At, 1, 0); PG8_STAGE_A(PG8_SA(0, 1), kb2, x2[1]);
            PG8_WAIT_V(8); PG8_WAIT_L(0); PG8_BAR; PG8_MMA(0, 0, At, B0); PG8_MMA(0, 1, At, B1); PG8_BAR; PG8_SCHED;
            PG8_LDA(At, 1, 1); PG8_STAGE_B(PG8_SB(1, 0), b3); PG8_STAGE_B(PG8_SB(1, 1), b3 + hstep); PG8_STAGE_A(PG8_SA(1, 0), kb3, x2[0]);
            PG8_WAIT_V(8); PG8_WAIT_L(0); PG8_BAR; PG8_MMA(1, 0, At, B0); PG8_MMA(1, 1, At, B1); PG8_BAR; PG8_SCHED;
        }
        if (wr == 0) PG8_BAR;
        E(acc, cur, wr, wc, fr, fq);
        if (!has_next) break;
#pragma unroll
        for (int a = 0; a < 2; ++a)
#pragma unroll
            for (int b = 0; b < 2; ++b)
#pragma unroll
                for (int m = 0; m < 4; ++m)
#pragma unroll
                    for (int n = 0; n < 2; ++n) acc[a][b][m][n] = (f32x4){0.f, 0.f, 0.f, 0.f};
        cur = nxt; cB = nB; ++ui;
#pragma unroll
        for (int h = 0; h < 2; ++h)
#pragma unroll
            for (int i = 0; i < 2; ++i) aC[h][i] = aN[h][i];
        if (wr == 1) PG8_BAR;
    }
    PG8_WAIT_V(0);
    PG8_BAR;
#undef PG8_SA
#undef PG8_SB
#undef PG8_STAGE_A
#undef PG8_STAGE_B
#undef PG8_LDA
#undef PG8_LDB
#undef PG8_MMA
#undef PG8_WAIT_V
#undef PG8_WAIT_L
#undef PG8_BAR
#undef PG8_SCHED
}
}

#ifndef ATTN_STORE16
#define ATTN_STORE16(p,v) (*(u32x4*)(p)=(v))
#endif
namespace attn_body {
using bf16=unsigned short;
using bf16x8=__attribute__((ext_vector_type(8)))short;
using s16x4=__attribute__((ext_vector_type(4)))short;
using f32x16=__attribute__((ext_vector_type(16)))float;
using u32x4=__attribute__((ext_vector_type(4)))unsigned;
constexpr int D=64,QP=512,KP=128,OP=1024;
constexpr int NW=8,QBLK=32,QB=QBLK*NW,KVBLK=64;
constexpr int ATTN_UNIT_ROWS=QB;
__device__ __forceinline__ int crow(int r,int hi){return (r&3)+8*(r>>2)+4*hi;}
#define SBAR() __builtin_amdgcn_sched_barrier(0)
constexpr int NSLOT=3, SLOTB=8192;
constexpr int LDS_K=0, LDS_V=NSLOT*SLOTB, LDS_WS=2*NSLOT*SLOTB, LDS_OST=LDS_WS+NW*64*4, LDS_BYTES=LDS_OST+NW*4096;
constexpr float C2=0.125f*1.4426950408889634f;
__device__ __forceinline__ void glds16(const void*sbase,unsigned voff,unsigned lds_dst){unsigned keep;
  asm volatile("s_mov_b32 %0, m0\n\ts_mov_b32 m0, %3\n\ts_nop 0\n\tglobal_load_lds_dwordx4 %1, %2\n\ts_mov_b32 m0, %0":"=&s"(keep):"v"(voff),"s"(sbase),"s"(lds_dst):"memory");}
__device__ __forceinline__ float max3f(float a,float b,float c){float r;asm("v_max3_f32 %0, %1, %2, %3":"=v"(r):"v"(a),"v"(b),"v"(c));return r;}
__device__ __forceinline__ float max2f(float a,float b){float r;asm("v_max_f32_e32 %0, %1, %2":"=v"(r):"v"(a),"v"(b));return r;}
__device__ __forceinline__ float fadd_s(float a,float b){float r;asm("v_add_f32_e32 %0, %1, %2":"=v"(r):"v"(a),"v"(b));return r;}
__device__ __forceinline__ float fsub_s(float a,float b){float r;asm("v_sub_f32_e32 %0, %1, %2":"=v"(r):"v"(a),"v"(b));return r;}
typedef float f32x2_t __attribute__((ext_vector_type(2))); typedef __bf16 bf16x2_t __attribute__((ext_vector_type(2)));
__device__ __forceinline__ unsigned cvtpk_s(float lo,float hi){f32x2_t v={lo,hi};bf16x2_t b=__builtin_convertvector(v,bf16x2_t);return __builtin_bit_cast(unsigned,b);}
#define WAIT_BAR(N) asm volatile("s_waitcnt vmcnt(" #N ") lgkmcnt(0)\n\ts_barrier":::"memory")

__device__ __forceinline__ void qkt(f32x16&p0,f32x16&p1,const char*Kslot,const bf16x8*qr,const f32x16&negm,int r32,int hi){
  const char*kb=Kslot+hi*1024+r32*16;
  #pragma unroll
  for(int d0=0;d0<4;++d0){
    const bf16x8 b0=*reinterpret_cast<const bf16x8*>(kb+d0*2048);
    const bf16x8 b1=*reinterpret_cast<const bf16x8*>(kb+d0*2048+512);
    if(d0==0){p0=__builtin_amdgcn_mfma_f32_32x32x16_bf16(b0,qr[0],negm,0,0,0);p1=__builtin_amdgcn_mfma_f32_32x32x16_bf16(b1,qr[0],negm,0,0,0);}
    else{p0=__builtin_amdgcn_mfma_f32_32x32x16_bf16(b0,qr[d0],p0,0,0,0);p1=__builtin_amdgcn_mfma_f32_32x32x16_bf16(b1,qr[d0],p1,0,0,0);}}
}
typedef __attribute__((address_space(3))) const char* lds_cptr;
typedef short v4i16_t __attribute__((ext_vector_type(4)));
__device__ __forceinline__ void kload8(bf16x8*kf,lds_cptr kp){
  kf[0]=*(const __attribute__((address_space(3))) bf16x8*)(kp);      kf[1]=*(const __attribute__((address_space(3))) bf16x8*)(kp+512);
  kf[2]=*(const __attribute__((address_space(3))) bf16x8*)(kp+2048); kf[3]=*(const __attribute__((address_space(3))) bf16x8*)(kp+2560);
  kf[4]=*(const __attribute__((address_space(3))) bf16x8*)(kp+4096); kf[5]=*(const __attribute__((address_space(3))) bf16x8*)(kp+4608);
  kf[6]=*(const __attribute__((address_space(3))) bf16x8*)(kp+6144); kf[7]=*(const __attribute__((address_space(3))) bf16x8*)(kp+6656);
}
__device__ __forceinline__ void kload2(bf16x8*kf,lds_cptr kp,int j){ kf[2*j]=*(const __attribute__((address_space(3))) bf16x8*)(kp+j*2048); kf[2*j+1]=*(const __attribute__((address_space(3))) bf16x8*)(kp+j*2048+512); }
__device__ __forceinline__ s16x4 vtr(lds_cptr p){ return __builtin_bit_cast(s16x4,__builtin_amdgcn_ds_read_tr16_b64_v4i16((__attribute__((address_space(3))) v4i16_t*)p)); }
__device__ __forceinline__ float rowmax(const f32x16&p0,const f32x16&p1){
  float a=max3f(p0[0],p0[1],p1[0]),b=max3f(p0[2],p0[3],p1[1]);a=max3f(a,p1[2],p1[3]);
  #pragma unroll
  for(int r=4;r<16;r+=4){a=max3f(a,p0[r],p0[r+1]);b=max3f(b,p0[r+2],p0[r+3]);a=max3f(a,p1[r],p1[r+1]);b=max3f(b,p1[r+2],p1[r+3]);}
  const float m=max2f(a,b);
  auto rr=__builtin_amdgcn_permlane32_swap(__float_as_uint(m),__float_as_uint(m),false,false);
  return max2f(__uint_as_float(rr[0]),__uint_as_float(rr[1]));
}
__device__ __forceinline__ void pv(f32x16*o,int vb,bf16x8 pa0,bf16x8 pa1,bf16x8 pa2,bf16x8 pa3){
  #pragma unroll
  for(int d0=0;d0<2;++d0){s16x4 lo[4],hi[4];
    #pragma unroll
    for(int ks=0;ks<4;++ks){
      asm volatile("ds_read_b64_tr_b16 %0,%1 offset:%c2":"=&v"(lo[ks]):"v"(vb),"i"(d0*4096+ks*1024):"memory");
      asm volatile("ds_read_b64_tr_b16 %0,%1 offset:%c2":"=&v"(hi[ks]):"v"(vb),"i"(d0*4096+ks*1024+512):"memory");}
    asm volatile("s_waitcnt lgkmcnt(0)":::"memory");SBAR();
    #define PK(k) (bf16x8){lo[k][0],lo[k][1],lo[k][2],lo[k][3],hi[k][0],hi[k][1],hi[k][2],hi[k][3]}
    o[d0]=__builtin_amdgcn_mfma_f32_32x32x16_bf16(pa0,PK(0),o[d0],0,0,0);
    o[d0]=__builtin_amdgcn_mfma_f32_32x32x16_bf16(pa1,PK(1),o[d0],0,0,0);
    o[d0]=__builtin_amdgcn_mfma_f32_32x32x16_bf16(pa2,PK(2),o[d0],0,0,0);
    o[d0]=__builtin_amdgcn_mfma_f32_32x32x16_bf16(pa3,PK(3),o[d0],0,0,0);
    #undef PK
  }
}

__device__ __forceinline__ unsigned short f2bf_(float x){f32x2_t v={x,0.f};bf16x2_t bb=__builtin_convertvector(v,bf16x2_t);return (unsigned short)(__builtin_bit_cast(unsigned,bb)&0xffffu);}
template<int THRL> __device__ __forceinline__ void attn_unit(const bf16*Qb,const bf16*__restrict__ Kh,const bf16*__restrict__ Vh,bf16*Ob,const int NT,char*shm,const int tid){
  const int lane=tid&63,r32=lane&31,hi=lane>>5; const int wid=__builtin_amdgcn_readfirstlane(tid>>6);
  const bf16*Qw=Qb+(long)(wid*QBLK)*QP;
  const unsigned lds0=(unsigned)(uintptr_t)shm;
  float*wsf=(float*)(shm+LDS_WS)+wid*64;
  const unsigned ksrc=(unsigned)(lane*KP+wid*8)*2u;
  const unsigned vsrc=(unsigned)((16*(wid&3)+(lane>>2))*KP+(wid>>2)*32+(lane&3)*8)*2u;
  const unsigned kdst=lds0+LDS_K+wid*1024, vdst=lds0+LDS_V+wid*1024;
  #define DMA_K(t,slot) glds16(Kh+(long)(t)*KVBLK*KP,ksrc,(unsigned)__builtin_amdgcn_readfirstlane(kdst+(slot)))
  #define DMA_V(t,slot) glds16(Vh+(long)(t)*KVBLK*KP,vsrc,(unsigned)__builtin_amdgcn_readfirstlane(vdst+(slot)))
  const int vb0=(int)(lds0+LDS_V)+((lane>>4)&1)*32+(lane&3)*8+(4*hi+((lane&15)>>2))*64;
  const char*Kbase=shm+LDS_K; bf16x8 kf[8];
  const lds_cptr shm3=(lds_cptr)shm; const lds_cptr kp0=shm3+LDS_K+hi*1024+r32*16; const lds_cptr vp0=shm3+LDS_V+((lane>>4)&1)*32+(lane&3)*8+(4*hi+((lane&15)>>2))*64;
  DMA_K(0,0);DMA_V(0,0);DMA_K(1,SLOTB);
  bf16x8 qr[4];
  #pragma unroll
  for(int d0=0;d0<4;++d0)qr[d0]=*reinterpret_cast<const bf16x8*>(&Qw[(long)r32*QP+d0*16+hi*8]);
  float mhat=0.f,l_reg=0.f;f32x16 o[2];o[0]=f32x16{};o[1]=f32x16{};f32x16 negm=f32x16{};asm volatile("":"+v"(negm));
  #define CMASK(P0,P1,t) do{}while(0)
  bool resc=false;
  #define START(P0,P1) do{ const float rm=rowmax(P0,P1); resc=false; \
    { const float dl=rm; mhat=fadd_s(mhat,dl); \
      _Pragma("unroll") for(int r=0;r<16;++r){P0[r]=fsub_s(P0[r],dl);P1[r]=fsub_s(P1[r],dl);} \
      _Pragma("unroll") for(int r=0;r<16;++r)negm[r]=-mhat; asm volatile("":"+v"(negm)); } \
    _Pragma("unroll") for(int r=0;r<16;++r)P0[r]=__builtin_amdgcn_exp2f(P0[r]); }while(0)
  #define RESC() do{ if(resc){ asm volatile("s_waitcnt lgkmcnt(0)":::"memory"); \
      _Pragma("unroll") for(int d_=0;d_<2;++d_) _Pragma("unroll") for(int r=0;r<16;++r)o[d_][r]*=wsf[crow(r,hi)]; } }while(0)
  f32x16 pA0,pA1,pB0,pB1;
  int sl_prev=0,sl_cur=0,sl_next=SLOTB;
  #define ROT() do{sl_prev=sl_cur;sl_cur=sl_next;sl_next=(sl_next==(NSLOT-1)*SLOTB)?0:sl_next+SLOTB;}while(0)
  DMA_K(2,2*SLOTB);
  WAIT_BAR(3);
  qkt(pA0,pA1,Kbase,qr,negm,r32,hi);asm volatile("s_nop 15\n\ts_nop 7":"+v"(pA0),"+v"(pA1));CMASK(pA0,pA1,0);
  START(pA0,pA1);
  _Pragma("unroll") for(int r=0;r<16;++r)pA1[r]=__builtin_amdgcn_exp2f(pA1[r]);
  WAIT_BAR(0);
  DMA_K(3,0);DMA_V(1,SLOTB);
  ROT();
  kload8(kf,kp0+sl_cur);
  WAIT_BAR(2);
  s16x4 vlo[8],vhi[8]; u32x4 pw0,pw1,pw2,pw3;
  #define PKW(P,B) cvtpk_s(P[B],P[B+1])
  #define PAF(k) __builtin_bit_cast(bf16x8,pw##k)
  #define VFR(i) (bf16x8){vlo[i][0],vlo[i][1],vlo[i][2],vlo[i][3],vhi[i][0],vhi[i][1],vhi[i][2],vhi[i][3]}
  #define PIN(x) asm volatile("":"+v"(x))
  #define MX3(a,b,c) __builtin_fmaxf(__builtin_fmaxf((a),(b)),(c))
  #define GAPA(MF,A0,A1,A2,A3,W0,W1,PW) do{ MF; sacc+=A0; sacc+=A1; sacc+=A2; sacc+=A3; PIN(sacc); W0; W1; PIN(PW); SBAR(); }while(0)
  #define EX(v) __builtin_amdgcn_exp2f(v)
  #define GAPB(MF,X,B) do{ MF; X[B]=EX(X[B]); X[B+1]=EX(X[B+1]); X[B+2]=EX(X[B+2]); X[B+3]=EX(X[B+3]); PIN(X); SBAR(); }while(0)
  #define VRD(i) do{ vlo[i]=vtr(vp_+(((i)>>2)*4096+((i)&3)*1024)); vhi[i]=vtr(vp_+(((i)>>2)*4096+((i)&3)*1024+512)); }while(0)
  #define KRD(G,j) do{ if(G){ kload2(kf,kp0+sl_next,j); SBAR(); } }while(0)
  #define STEP(C0,C1,P0,P1,t,GK,GV,GL) do{ SBAR(); \
    const lds_cptr vp_=vp0+sl_prev; \
    VRD(0); SBAR(); float sacc=(P0[0]+P0[1]); \
    GAPA(C0=__builtin_amdgcn_mfma_f32_32x32x16_bf16(kf[0],qr[0],negm,0,0,0), P0[2],P0[3],P0[4],P0[5],     pw0[0]=PKW(P0,0), pw0[1]=PKW(P0,2), pw0); \
    VRD(4); SBAR(); GAPA(C1=__builtin_amdgcn_mfma_f32_32x32x16_bf16(kf[1],qr[0],negm,0,0,0), P0[6],P0[7],P0[8],P0[9],     pw0[2]=PKW(P0,4), pw0[3]=PKW(P0,6), pw0); \
    VRD(1); SBAR(); GAPA(C0=__builtin_amdgcn_mfma_f32_32x32x16_bf16(kf[2],qr[1],C0,0,0,0),   P0[10],P0[11],P0[12],P0[13], pw1[0]=PKW(P0,8), pw1[1]=PKW(P0,10), pw1); \
    VRD(5); SBAR(); GAPA(C1=__builtin_amdgcn_mfma_f32_32x32x16_bf16(kf[3],qr[1],C1,0,0,0),   P0[14],P0[15],P1[0],P1[1],   pw1[2]=PKW(P0,12),pw1[3]=PKW(P0,14), pw1); \
    VRD(2); SBAR(); GAPA(C0=__builtin_amdgcn_mfma_f32_32x32x16_bf16(kf[4],qr[2],C0,0,0,0),   P1[2],P1[3],P1[4],P1[5],     pw2[0]=PKW(P1,0), pw2[1]=PKW(P1,2), pw2); \
    VRD(6); SBAR(); GAPA(C1=__builtin_amdgcn_mfma_f32_32x32x16_bf16(kf[5],qr[2],C1,0,0,0),   P1[6],P1[7],P1[8],P1[9],     pw2[2]=PKW(P1,4), pw2[3]=PKW(P1,6), pw2); \
    VRD(3); SBAR(); GAPA(C0=__builtin_amdgcn_mfma_f32_32x32x16_bf16(kf[6],qr[3],C0,0,0,0),   P1[10],P1[11],P1[12],P1[13], pw3[0]=PKW(P1,8), pw3[1]=PKW(P1,10), pw3); \
    VRD(7); SBAR(); GAPA(C1=__builtin_amdgcn_mfma_f32_32x32x16_bf16(kf[7],qr[3],C1,0,0,0),   P1[14],P1[15],0.f,0.f,       pw3[2]=PKW(P1,12),pw3[3]=PKW(P1,14), pw3); \
    l_reg+=sacc; \
    if(GK){DMA_K((t)+3,sl_cur);} if(GV){DMA_V((t)+1,sl_next);} \
    CMASK(C0,C1,t); \
    { float a=MX3(C0[0],C0[1],C1[0]),b=MX3(C0[2],C0[3],C1[1]); a=MX3(a,C1[2],C1[3]); \
      _Pragma("unroll") for(int r=4;r<16;r+=4){a=MX3(a,C0[r],C0[r+1]);b=MX3(b,C0[r+2],C0[r+3]);a=MX3(a,C1[r],C1[r+1]);b=MX3(b,C1[r+2],C1[r+3]);} \
      float rm=__builtin_fmaxf(a,b); { auto rr=__builtin_amdgcn_permlane32_swap(__float_as_uint(rm),__float_as_uint(rm),false,false); rm=__builtin_fmaxf(__uint_as_float(rr[0]),__uint_as_float(rr[1])); } \
      resc=false; \
      if(__builtin_expect(__any(rm>(float)THRL),0)){ const float dl=__builtin_fmaxf(rm,0.f); mhat+=dl; \
        _Pragma("unroll") for(int r=0;r<16;++r){C0[r]-=dl;C1[r]-=dl;} \
        _Pragma("unroll") for(int r=0;r<16;++r)negm[r]=-mhat; asm volatile("":"+v"(negm)); \
        const float f=__builtin_amdgcn_exp2f(-dl); l_reg*=f; if(hi==0)wsf[r32]=f; resc=true; } } \
    SBAR(); \
    GAPB(o[0]=__builtin_amdgcn_mfma_f32_32x32x16_bf16(PAF(0),VFR(0),o[0],0,0,0), C0,0); \
    GAPB(o[1]=__builtin_amdgcn_mfma_f32_32x32x16_bf16(PAF(0),VFR(4),o[1],0,0,0), C0,4); \
    KRD(GL,0); GAPB(o[0]=__builtin_amdgcn_mfma_f32_32x32x16_bf16(PAF(1),VFR(1),o[0],0,0,0), C0,8); \
    KRD(GL,1); GAPB(o[1]=__builtin_amdgcn_mfma_f32_32x32x16_bf16(PAF(1),VFR(5),o[1],0,0,0), C0,12); \
    KRD(GL,2); GAPB(o[0]=__builtin_amdgcn_mfma_f32_32x32x16_bf16(PAF(2),VFR(2),o[0],0,0,0), C1,0); \
    KRD(GL,3); GAPB(o[1]=__builtin_amdgcn_mfma_f32_32x32x16_bf16(PAF(2),VFR(6),o[1],0,0,0), C1,4); \
    GAPB(o[0]=__builtin_amdgcn_mfma_f32_32x32x16_bf16(PAF(3),VFR(3),o[0],0,0,0), C1,8); \
    GAPB(o[1]=__builtin_amdgcn_mfma_f32_32x32x16_bf16(PAF(3),VFR(7),o[1],0,0,0), C1,12); \
    }while(0)
  int t=1;
  #undef CMASK
  #define CMASK(P0,P1,t) do{}while(0)
  for(;t+5<NT;t+=2){
    STEP(pB0,pB1,pA0,pA1,t,true,true,true);     WAIT_BAR(2); RESC(); ROT();
    STEP(pA0,pA1,pB0,pB1,t+1,true,true,true);   WAIT_BAR(2); RESC(); ROT();
  }
  #undef CMASK
  #define CMASK(P0,P1,t) do{}while(0)
  #define ENDW(tt) do{ if((tt)+3<NT){WAIT_BAR(2);} else if((tt)+2<NT){WAIT_BAR(1);} else {WAIT_BAR(0);} }while(0)
  for(;t+1<NT;t+=2){
    STEP(pB0,pB1,pA0,pA1,t,(t+3<NT),(t+1<NT),(t+1<NT));       ENDW(t);   RESC(); ROT();
    STEP(pA0,pA1,pB0,pB1,t+1,(t+4<NT),(t+2<NT),(t+2<NT));     ENDW(t+1); RESC(); ROT();
  }
  STEP(pB0,pB1,pA0,pA1,NT-1,false,false,false); RESC();
  { float sacc=pB0[0]+pB0[1]; _Pragma("unroll") for(int r=2;r<16;++r)sacc+=pB0[r]; _Pragma("unroll") for(int r=0;r<16;++r)sacc+=pB1[r]; l_reg+=sacc;
    pw0=(u32x4){PKW(pB0,0),PKW(pB0,2),PKW(pB0,4),PKW(pB0,6)};pw1=(u32x4){PKW(pB0,8),PKW(pB0,10),PKW(pB0,12),PKW(pB0,14)};pw2=(u32x4){PKW(pB1,0),PKW(pB1,2),PKW(pB1,4),PKW(pB1,6)};pw3=(u32x4){PKW(pB1,8),PKW(pB1,10),PKW(pB1,12),PKW(pB1,14)};
    SBAR(); pv(o,vb0+sl_cur,PAF(0),PAF(1),PAF(2),PAF(3)); }
  #undef PKW
  #undef PAF
  #undef VFR
  #undef PIN
  #undef MX3
  #undef GAPA
  #undef GAPB
  #undef EX
  #undef VRD
  #undef KRD
  #undef STEP
  #undef ENDW
  {auto rr=__builtin_amdgcn_permlane32_swap(__float_as_uint(l_reg),__float_as_uint(l_reg),false,false);l_reg=__uint_as_float(rr[0])+__uint_as_float(rr[1]);}
  if(hi==0)wsf[32+r32]=l_reg;asm volatile("s_waitcnt lgkmcnt(0)":::"memory");
  float rli[16];
  #pragma unroll
  for(int r=0;r<16;++r)rli[r]=__builtin_amdgcn_rcpf(wsf[32+crow(r,hi)]);
  bf16*Ow=Ob+(long)(wid*QBLK)*OP;
  { bf16*stg=(bf16*)(shm+LDS_OST)+wid*2048;
    #pragma unroll
    for(int r=0;r<16;++r){const int orow=crow(r,hi);
      #pragma unroll
      for(int d0=0;d0<2;++d0)stg[orow*64+d0*32+r32]=f2bf_(o[d0][r]*rli[r]);}
    asm volatile("s_waitcnt lgkmcnt(0)":::"memory");
    #pragma unroll
    for(int i=0;i<4;++i){const int row=i*8+(lane>>3),ch=lane&7; const u32x4 v=*(const u32x4*)(stg+row*64+ch*8); ATTN_STORE16(Ow+(long)row*OP+ch*8,v);} }
  asm volatile("s_waitcnt lgkmcnt(0)\n\ts_barrier":::"memory");
  #undef DMA_K
  #undef DMA_V
  #undef CMASK
  #undef START
  #undef RESC
  #undef ROT
}
constexpr int ATTN_LDS_BYTES=LDS_BYTES;
#undef SBAR
#undef WAIT_BAR
}

#define XB_TMO      128
#define XB_XCNT(j)  (256  + 64 * (j))
#define XB_XSUB(j)  (1280 + 64 * (j))
#define XB_XGEN(j)  (2304 + 64 * (j))
#define XB_TOP      3328
#define XB_TOPGEN   3392
#define XCD_BAR_WORDS 3456
#define XB_SPIN_CAP (1u << 22)
__device__ __forceinline__ unsigned xb_ld(unsigned* p)              { return __hip_atomic_load(p, __ATOMIC_RELAXED, __HIP_MEMORY_SCOPE_AGENT); }
__device__ __forceinline__ unsigned xb_add(unsigned* p, unsigned v) { return __hip_atomic_fetch_add(p, v, __ATOMIC_RELAXED, __HIP_MEMORY_SCOPE_AGENT); }
__device__ __forceinline__ unsigned xb_xcc_id() { return (unsigned)__builtin_amdgcn_s_getreg((3 << 11) | 20) & 0xFu; }
#define XB_SPIN(cond, bar) do { unsigned _sp = 0; while (cond) { __builtin_amdgcn_s_sleep(1); \
    if ((++_sp & 255u) == 0u) { if (xb_ld(&(bar)[XB_TMO])) break; if (_sp > XB_SPIN_CAP) { atomicAdd(&(bar)[XB_TMO], 1u); break; } } } } while (0)
struct XcdBarrier { unsigned* bar; unsigned x; volatile LAS unsigned* st; };
__device__ __forceinline__ XcdBarrier xcd_barrier_post(unsigned* bar, volatile LAS unsigned* st, const int tid) {
    XcdBarrier b; b.bar = bar; b.x = xb_xcc_id(); b.st = st;
    if (tid == 0) (void)xb_add(&bar[XB_XCNT(b.x)], 1u);
    return b;
}
__device__ __forceinline__ void xcd_barrier_complete(unsigned* bar, unsigned x, unsigned& nloc, unsigned& nx) {
    const unsigned G = gridDim.x * gridDim.y * gridDim.z;
    unsigned sum, cnt, mine, sp = 0u;
    for (;;) {
        sum = 0u; cnt = 0u; mine = 0u;
#pragma unroll
        for (unsigned j = 0; j < 16; ++j) { const unsigned c = xb_ld(&bar[XB_XCNT(j)]); sum += c; cnt += (c > 0u) ? 1u : 0u; mine = (j == x) ? c : mine; }
        if (sum == G) break;
        __builtin_amdgcn_s_sleep(1);
        if ((++sp & 255u) == 0u) { if (xb_ld(&bar[XB_TMO])) break; if (sp > XB_SPIN_CAP) { atomicAdd(&bar[XB_TMO], 1u); break; } }
    }
    nloc = mine > 0u ? mine : 1u; nx = cnt > 0u ? cnt : 1u;
}
__device__ __forceinline__ void xcd_barrier(const XcdBarrier& b, const int tid) {
    asm volatile("s_waitcnt vmcnt(0)" ::: "memory");
    __syncthreads();
    if (tid == 0) {
        unsigned* bar = b.bar;
        __builtin_amdgcn_s_waitcnt(0);
        unsigned nloc = b.st[0], nx = b.st[1];
        if (nloc == 0u) { xcd_barrier_complete(bar, b.x, nloc, nx); b.st[0] = nloc; b.st[1] = nx; }
        const unsigned old = xb_add(&bar[XB_XSUB(b.x)], 1u);
        const unsigned gen = old / nloc;
        if (old + 1u == (gen + 1u) * nloc) {
            __builtin_amdgcn_fence(__ATOMIC_RELEASE, "agent");
            asm volatile("s_waitcnt vmcnt(0)" ::: "memory");
            const unsigned og = xb_add(&bar[XB_TOP], 1u);
            const unsigned tg = og / nx;
            if (og + 1u == (tg + 1u) * nx) xb_add(&bar[XB_TOPGEN], 1u);
            else XB_SPIN(xb_ld(&bar[XB_TOPGEN]) == tg, bar);
            __builtin_amdgcn_fence(__ATOMIC_ACQUIRE, "agent");
            xb_add(&bar[XB_XGEN(b.x)], 1u);
            asm volatile("s_waitcnt vmcnt(0)" ::: "memory");
        } else {
            XB_SPIN(xb_ld(&bar[XB_XGEN(b.x)]) == gen, bar);
            __builtin_amdgcn_fence(__ATOMIC_ACQUIRE, "agent");
            asm volatile("s_waitcnt vmcnt(0)" ::: "memory");
        }
    }
    __syncthreads();
}

struct Args { const float* in[24]; float* out; unsigned char* ws; int ph_lo, ph_hi, dry, pad; };
struct Frame {
    LAS unsigned char* lds;
    unsigned char* ldsg;
    volatile LAS unsigned* MISC;
    unsigned* ctl;
    unsigned char* ws; float* out; float* xw; const float* const* in;
    int tid, lane, wave, G, gw, NGW;
};
__device__ __forceinline__ const float* inp(const float* p) { unsigned long long v = (unsigned long long)p; asm volatile("" : "+s"(v)); return (const float*)(const GAS float*)v; }
#define F_x (inp(F.in[0]))
#define F_c (inp(F.in[1]))
#define F_ctx (inp(F.in[2]))
#define F_c_ctx (inp(F.in[3]))
#define F_w_mod (inp(F.in[4]))
#define F_b_mod (inp(F.in[5]))
#define F_g_mix (inp(F.in[6]))
#define F_g_ffn (inp(F.in[7]))
#define F_ev_w_in (inp(F.in[8]))
#define F_ev_qg (inp(F.in[9]))
#define F_ev_kg (inp(F.in[10]))
#define F_ev_dw_w (inp(F.in[11]))
#define F_ev_dw_b (inp(F.in[12]))
#define F_ev_ln_g (inp(F.in[13]))
#define F_ev_ln_b (inp(F.in[14]))
#define F_ev_w_out (inp(F.in[15]))
#define F_od_w_in (inp(F.in[16]))
#define F_od_conv_w (inp(F.in[17]))
#define F_od_w_out (inp(F.in[18]))
#define F_router_w (inp(F.in[19]))
#define F_router_b (inp(F.in[20]))
#define F_w_gate (inp(F.in[21]))
#define F_w_up (inp(F.in[22]))
#define F_w_down (inp(F.in[23]))
#define F_MOD    ((float*)(F.ws + WS_MOD))
#define F_ROPE   ((f32x2*)(F.ws + WS_ROPE))
#define F_RT     ((u32x4*)(F.ws + WS_RT))
#define F_ROWTOK ((unsigned*)(F.ws + WS_ROWTOK))
#define F_Z      ((float*)(F.ws + WS_Z))
#define F_W_EVIN  ((bf16*)(F.ws + WS_W_EVIN))
#define F_W_EVOUT ((bf16*)(F.ws + WS_W_EVOUT))
#define F_W_ODIN  ((bf16*)(F.ws + WS_W_ODIN))
#define F_W_ODOUT ((bf16*)(F.ws + WS_W_ODOUT))
#define F_W_MOE1  ((bf16*)(F.ws + WS_W_MOE1))
#define F_W_MOE2  ((bf16*)(F.ws + WS_W_MOE2))
#define F_HB   ((bf16*)(F.ws + WS_HB))
#define F_CAT  ((bf16*)(F.ws + WS_CAT))
#define F_OX   ((bf16*)(F.ws + WS_OX))
#define F_HMID ((bf16*)(F.ws + WS_HMID))
#define F_Y    ((bf16*)(F.ws + WS_Y))
#define F_Q    ((bf16*)(F.ws + WS_Q))
#define F_KB   ((bf16*)(F.ws + WS_K))
#define F_VB   ((bf16*)(F.ws + WS_V))
#define F_AG   ((bf16*)(F.ws + WS_AG))
#define F_SB   ((bf16*)(F.ws + WS_S))
#define F_U    ((bf16*)(F.ws + WS_U))
#define F_GB   ((bf16*)(F.ws + WS_GB))
__device__ __forceinline__ bool ctx_in_l(int l) { return l <= 2; }
__device__ __forceinline__ bool ctx_out_l(int l) { return l < 2; }

__device__ __forceinline__ int rowmap(int n, int mode) {
    if (mode == 0) return n;
    if (mode == 1 || mode == 2) return 256 * (n >> 7) + (n & 127) + (mode == 2 ? 128 : 0);
    if (mode == 3) {
        if (n < 768) { const int d = n & 63, hh = (n >> 6) & 3; return (n & ~255) + 128 * (d >> 5) + 32 * hh + (d & 31); }
        if (n < 1280) { const int o = n - 768; return 768 + 256 * (o >> 7) + (o & 127); }
        const int o = n - 1280; return 768 + 256 * (o >> 7) + 128 + (o & 127);
    }
    if (n < 1024) return 2048 + n;
    if (n < 2048) { const int o = n - 1024; return 256 * (o >> 7) + (o & 127); }
    { const int o = n - 2048; return 256 * (o >> 7) + 128 + (o & 127); }
}
struct TItem { const float* W; bf16* WT; int K, N, mode, k0, n0; };
__device__ __forceinline__ void titem_set(TItem& t, const float* W, int K, int N, bf16* WT, int mode, int item) { const int nblk = N >> 6; t.W = W; t.WT = WT; t.K = K; t.N = N; t.mode = mode; t.k0 = 64 * (item / nblk); t.n0 = 64 * (item % nblk); }
__device__ __forceinline__ void titem_load(const TItem& t, f32x4 (&v)[16], int lane) {
    const float* p = t.W + (size_t)(t.k0 + (lane >> 4)) * t.N + t.n0 + (lane & 15) * 4;
#pragma unroll
    for (int i = 0; i < 16; ++i) v[i] = __builtin_nontemporal_load((const f32x4*)(p + (size_t)(4 * i) * t.N));
}
__device__ __forceinline__ void titem_store(const TItem& t, const f32x4 (&v)[16], float* scr, int lane) {
#pragma unroll
    for (int i = 0; i < 16; ++i) { const int kk = (lane >> 4) + 4 * i; *(f32x4*)(scr + kk * 64 + (((lane & 15) * 4) ^ (4 * ((kk >> 3) & 7)))) = v[i]; }
    LDS_WAIT(); asm volatile("" ::: "memory");
    const int kc = lane & 7;
#pragma unroll
    for (int j = 0; j < 8; ++j) { const int n = (lane >> 3) + 8 * j; const float* sp = scr + (8 * kc) * 64 + (n ^ (4 * kc));
        u32x4 o; o.x = pk2(sp[0 * 64], sp[1 * 64]); o.y = pk2(sp[2 * 64], sp[3 * 64]); o.z = pk2(sp[4 * 64], sp[5 * 64]); o.w = pk2(sp[6 * 64], sp[7 * 64]);
        *(u32x4*)(t.WT + (size_t)rowmap(t.n0 + n, t.mode) * t.K + t.k0 + 8 * kc) = o; }
    LDS_WAIT(); asm volatile("" ::: "memory");
}
__device__ __forceinline__ void mod_unit(Frame& F, int u) {
    const int l = u / 24, cg = u % 24;
    float* act = (float*)F.ldsg;
    float* red = (float*)(F.ldsg + 36864);
    for (int idx = F.tid; idx < 9 * 1024; idx += NTHR) { const int r = idx >> 10, k = idx & 1023; const float v = (r < 8) ? F_c[r * 1024 + k] : F_c_ctx[k]; act[idx] = v / (1.0f + __expf(-v)); }
    __syncthreads();
    const float* W = F_w_mod + (size_t)l * 1024 * 6144 + cg * 256 + F.lane * 4;
    float acc[9][4];
#pragma unroll
    for (int r = 0; r < 9; ++r)
#pragma unroll
        for (int j = 0; j < 4; ++j) acc[r][j] = 0.f;
    const int k0 = F.wave * 128;
#pragma unroll 16
    for (int kk = 0; kk < 128; ++kk) { const int k = k0 + kk; const f32x4 w = __builtin_nontemporal_load((const f32x4*)(W + (size_t)k * 6144));
#pragma unroll
        for (int r = 0; r < 9; ++r) { const float a = act[r * 1024 + k]; acc[r][0] += a * w[0]; acc[r][1] += a * w[1]; acc[r][2] += a * w[2]; acc[r][3] += a * w[3]; } }
#pragma unroll
    for (int r = 0; r < 9; ++r) *(f32x4*)(red + (F.wave * 9 + r) * 256 + F.lane * 4) = (f32x4){acc[r][0], acc[r][1], acc[r][2], acc[r][3]};
    __syncthreads();
    for (int idx = F.tid; idx < 9 * 256; idx += NTHR) { const int r = idx >> 8, cc = idx & 255; float s = F_b_mod[l * 6144 + cg * 256 + cc];
#pragma unroll
        for (int w = 0; w < 8; ++w) s += red[(w * 9 + r) * 256 + cc];
        F_MOD[(size_t)(l * 9 + r) * 6144 + cg * 256 + cc] = s; }
    __syncthreads();
}
__device__ __forceinline__ void prologue(Frame& F) {
    for (int u = blockIdx.x; u < 96; u += F.G) mod_unit(F, u);
    for (int idx = blockIdx.x * NTHR + F.tid; idx < 128 * 16; idx += F.G * NTHR) { const int pos = idx >> 4, j = idx & 15;
        const float inv = __builtin_amdgcn_exp2f(-(float)j * (13.287712379549449f / 16.0f)); const float ang = (float)pos * inv;
        F_ROPE[idx] = (f32x2){__cosf(ang), __sinf(ang)}; }
    if (blockIdx.x == 0) { for (int i = F.tid; i < D / 2; i += NTHR) ((unsigned*)(F_HB + (size_t)ZROW * D))[i] = 0u; }
    float* scr = (float*)(F.ldsg + F.wave * 16384);
    constexpr int I_EVIN = 16 * (EVIN / 64), I_SQ = 16 * 16, I_ODIN = 16 * (ODIN / 64), I_GU = 16 * 8, I_DN = 8 * 16;
    constexpr int NSMALL = 2 * I_EVIN + 2 * I_SQ + 2 * I_ODIN + 2 * I_SQ;
    constexpr int NITEMS = NSMALL + 64 * (2 * I_GU + I_DN);
#define TDECODE(it, t) do { int r = (it); \
        if (r < 2 * I_EVIN) { const int i = r / I_EVIN; titem_set(t, F_ev_w_in + (size_t)i * D * EVIN, D, EVIN, F_W_EVIN + (size_t)i * EVIN * D, 3, r % I_EVIN); break; } r -= 2 * I_EVIN; \
        if (r < 2 * I_SQ) { const int i = r / I_SQ; titem_set(t, F_ev_w_out + (size_t)i * D * D, D, D, F_W_EVOUT + (size_t)i * D * D, 0, r % I_SQ); break; } r -= 2 * I_SQ; \
        if (r < 2 * I_ODIN) { const int i = r / I_ODIN; titem_set(t, F_od_w_in + (size_t)i * D * ODIN, D, ODIN, F_W_ODIN + (size_t)i * ODIN * D, 4, r % I_ODIN); break; } r -= 2 * I_ODIN; \
        if (r < 2 * I_SQ) { const int i = r / I_SQ; titem_set(t, F_od_w_out + (size_t)i * D * D, D, D, F_W_ODOUT + (size_t)i * D * D, 0, r % I_SQ); break; } r -= 2 * I_SQ; \
        { constexpr int PER = 2 * I_GU + I_DN; const int le = r / PER; int q = r % PER; \
          if (q < I_GU) { titem_set(t, F_w_gate + (size_t)le * D * DE, D, DE, F_W_MOE1 + (size_t)le * D * D, 1, q); break; } q -= I_GU; \
          if (q < I_GU) { titem_set(t, F_w_up + (size_t)le * D * DE, D, DE, F_W_MOE1 + (size_t)le * D * D, 2, q); break; } q -= I_GU; \
          titem_set(t, F_w_down + (size_t)le * DE * D, DE, D, F_W_MOE2 + (size_t)le * D * DE, 0, q); } } while (0)
    int it = F.gw;
    if (it < NITEMS) {
        TItem cur, nxt; f32x4 va[16], vb[16];
        TDECODE(it, cur); titem_load(cur, va, F.lane);
        for (;;) {
            const int itn = it + F.NGW; const bool more = itn < NITEMS;
            if (more) { TDECODE(itn, nxt); titem_load(nxt, vb, F.lane); }
            titem_store(cur, va, scr, F.lane);
            if (!more) break;
            cur = nxt; it = itn;
#pragma unroll
            for (int i = 0; i < 16; ++i) va[i] = vb[i];
        }
    }
#undef TDECODE
}

constexpr int NR = 4;
__device__ __forceinline__ void norm1_phase(Frame& F, int l, bool fin) {
    const int nrows = NLAT + ((!fin && ctx_in_l(l)) ? NCTX : 0);
    const int nch = nrows / NR;
    int pstartv = 0;
    if (l > 0) { const int c = (F.lane < 16) ? (int)__hip_atomic_load(F.ctl + CW_CNT + ((l - 1) * 16 + F.lane) * 64, __ATOMIC_RELAXED, __HIP_MEMORY_SCOPE_AGENT) : 0; const int p = (c + 255) & ~255; int incl = p;
#pragma unroll
        for (int o = 1; o < 16; o <<= 1) { const int t = __shfl_up(incl, o); if (F.lane >= o) incl += t; }
        pstartv = incl - p; }
    for (int ch = F.gw; ch < nch; ch += F.NGW) {
        const int r0 = ch * NR; const bool isz = r0 >= NLAT; const int b = isz ? 8 : (r0 >> 13);
        const float* src; float* dst;
        if (!isz) { src = (l == 0 ? F_x : F.out) + (size_t)r0 * D; dst = F.xw + (size_t)r0 * D; }
        else { const int j = r0 - NLAT; src = (l == 0 ? F_ctx : F_Z) + (size_t)j * D; dst = F_Z + (size_t)j * D; }
        f32x4 v[NR][4];
#pragma unroll
        for (int j = 0; j < NR; ++j)
#pragma unroll
            for (int q = 0; q < 4; ++q) v[j][q] = __builtin_nontemporal_load((const f32x4*)(src + (size_t)j * D + F.lane * 4 + 256 * q));
        if (l > 0) {
            u32x2 dd[NR]; float w0[NR], w1[NR];
#pragma unroll
            for (int j = 0; j < NR; ++j) { const u32x4 rt = F_RT[r0 + j]; w0[j] = __uint_as_float(rt.z); w1[j] = __uint_as_float(rt.w);
                const int e0 = __builtin_amdgcn_readfirstlane((int)(rt.x & 15u)), e1 = __builtin_amdgcn_readfirstlane((int)(rt.y & 15u));
                dd[j].x = (unsigned)__builtin_amdgcn_readlane(pstartv, e0) + (rt.x >> 4); dd[j].y = (unsigned)__builtin_amdgcn_readlane(pstartv, e1) + (rt.y >> 4); }
            const float* gate = F_MOD + (size_t)((l - 1) * 9 + b) * 6144 + 5 * 1024;
            f32x4 g[4];
#pragma unroll
            for (int q = 0; q < 4; ++q) g[q] = *(const f32x4*)(gate + F.lane * 4 + 256 * q);
            u32x2 ya[NR][4], yb[NR][4];
#pragma unroll
            for (int j = 0; j < NR; ++j)
#pragma unroll
                for (int q = 0; q < 4; ++q) { const int col = F.lane * 4 + 256 * q; ya[j][q] = __builtin_nontemporal_load((const u32x2*)(F_Y + (size_t)dd[j].x * D + col)); yb[j][q] = __builtin_nontemporal_load((const u32x2*)(F_Y + (size_t)dd[j].y * D + col)); }
#pragma unroll
            for (int j = 0; j < NR; ++j)
#pragma unroll
                for (int q = 0; q < 4; ++q) { const int col = F.lane * 4 + 256 * q; const u32x2 a = ya[j][q], bq = yb[j][q];
                    v[j][q][0] += g[q][0] * (w0[j] * bflo(a.x) + w1[j] * bflo(bq.x)); v[j][q][1] += g[q][1] * (w0[j] * bfhi(a.x) + w1[j] * bfhi(bq.x));
                    v[j][q][2] += g[q][2] * (w0[j] * bflo(a.y) + w1[j] * bflo(bq.y)); v[j][q][3] += g[q][3] * (w0[j] * bfhi(a.y) + w1[j] * bfhi(bq.y));
                    __builtin_nontemporal_store(v[j][q], (f32x4*)(dst + (size_t)j * D + col)); }
        }
        if (!fin) {
            float rstd[NR];
#pragma unroll
            for (int j = 0; j < NR; ++j) { float ss = 0.f;
#pragma unroll
                for (int q = 0; q < 4; ++q) ss += (v[j][q][0] * v[j][q][0] + v[j][q][1] * v[j][q][1]) + (v[j][q][2] * v[j][q][2] + v[j][q][3] * v[j][q][3]);
                rstd[j] = __builtin_amdgcn_rsqf(wave_sum(ss) * (1.0f / D) + EPS); }
            const float* gm = F_g_mix + l * D; const float* sh = F_MOD + (size_t)(l * 9 + b) * 6144; const float* sc = sh + 1024;
#pragma unroll
            for (int q = 0; q < 4; ++q) { const int col = F.lane * 4 + 256 * q; const f32x4 g = *(const f32x4*)(gm + col), s = *(const f32x4*)(sh + col), cc = *(const f32x4*)(sc + col);
                const f32x4 A = g * (cc + 1.0f);
#pragma unroll
                for (int j = 0; j < NR; ++j) { const f32x4 h = v[j][q] * rstd[j] * A + s;
                    *(u32x2*)(F_HB + (size_t)(r0 + j) * D + col) = (u32x2){pk2(h[0], h[1]), pk2(h[2], h[3])}; } }
        }
    }
}

__device__ __forceinline__ void norm2_phase(Frame& F, int l) {
    float* RWT = (float*)F.ldsg;
    unsigned* wcnt = (unsigned*)(F.ldsg + 65536);
    for (int idx = F.tid; idx < 4096; idx += NTHR) { const f32x4 w = *(const f32x4*)(F_router_w + idx * 4); const int col = idx >> 2, e0 = (idx & 3) * 4;
        RWT[(e0 + 0) * 1024 + col] = w[0]; RWT[(e0 + 1) * 1024 + col] = w[1]; RWT[(e0 + 2) * 1024 + col] = w[2]; RWT[(e0 + 3) * 1024 + col] = w[3]; }
    float rb[16];
#pragma unroll
    for (int e = 0; e < 16; ++e) rb[e] = F_router_b[e];
    __syncthreads();
    unsigned cnt = 0u;
    unsigned* wbase = (unsigned*)(F.ldsg + 66048);
    u32x4* stash = (u32x4*)(F.ldsg + 66560) + F.wave * 96; int nst = 0;
    const int nrows = NLAT + (ctx_out_l(l) ? NCTX : 0);
    const int nch = nrows / NR;
    for (int ch = F.gw; ch < nch; ch += F.NGW) {
        const int r0 = ch * NR; const bool isz = r0 >= NLAT; const int b = isz ? 8 : (r0 >> 13);
        const float* src; float* dst;
        if (!isz) { src = (l == 0 ? F_x : F.out) + (size_t)r0 * D; dst = F.xw + (size_t)r0 * D; }
        else { const int j = r0 - NLAT; src = (l == 0 ? F_ctx : F_Z) + (size_t)j * D; dst = F_Z + (size_t)j * D; }
        const float* mrow = F_MOD + (size_t)(l * 9 + b) * 6144;
        f32x4 v[NR][4]; u32x2 ox[NR][4];
#pragma unroll
        for (int j = 0; j < NR; ++j)
#pragma unroll
            for (int q = 0; q < 4; ++q) { const int col = F.lane * 4 + 256 * q; v[j][q] = __builtin_nontemporal_load((const f32x4*)(src + (size_t)j * D + col)); ox[j][q] = __builtin_nontemporal_load((const u32x2*)(F_OX + (size_t)(r0 + j) * D + col)); }
        float rstd[NR];
        {
            f32x4 g[4];
#pragma unroll
            for (int q = 0; q < 4; ++q) g[q] = *(const f32x4*)(mrow + 2 * 1024 + F.lane * 4 + 256 * q);
#pragma unroll
            for (int j = 0; j < NR; ++j) { float ss = 0.f;
#pragma unroll
                for (int q = 0; q < 4; ++q) { const u32x2 o = ox[j][q];
                    v[j][q][0] += g[q][0] * bflo(o.x); v[j][q][1] += g[q][1] * bfhi(o.x); v[j][q][2] += g[q][2] * bflo(o.y); v[j][q][3] += g[q][3] * bfhi(o.y);
                    __builtin_nontemporal_store(v[j][q], (f32x4*)(dst + (size_t)j * D + F.lane * 4 + 256 * q));
                    ss += (v[j][q][0] * v[j][q][0] + v[j][q][1] * v[j][q][1]) + (v[j][q][2] * v[j][q][2] + v[j][q][3] * v[j][q][3]); }
                rstd[j] = __builtin_amdgcn_rsqf(wave_sum(ss) * (1.0f / D) + EPS); }
        }
        const float* gf = F_g_ffn + l * D;
#pragma unroll
        for (int q = 0; q < 4; ++q) { const int col = F.lane * 4 + 256 * q; const f32x4 g = *(const f32x4*)(gf + col), s = *(const f32x4*)(mrow + 3 * 1024 + col), cc = *(const f32x4*)(mrow + 4 * 1024 + col);
            const f32x4 A = g * (cc + 1.0f);
#pragma unroll
            for (int j = 0; j < NR; ++j) { v[j][q] = v[j][q] * rstd[j] * A + s;
                *(u32x2*)(F_HB + (size_t)(r0 + j) * D + col) = (u32x2){pk2(v[j][q][0], v[j][q][1]), pk2(v[j][q][2], v[j][q][3])}; } }
        float lg[NR * 16];
#pragma unroll
        for (int i = 0; i < NR * 16; ++i) lg[i] = 0.f;
#pragma unroll
        for (int q = 0; q < 4; ++q) { const int col = F.lane * 4 + 256 * q;
#pragma unroll
            for (int e = 0; e < 16; ++e) { const f32x4 w = *(const f32x4*)(RWT + e * 1024 + col);
#pragma unroll
                for (int j = 0; j < NR; ++j) { float t_ = lg[j * 16 + e]; t_ = __builtin_fmaf(v[j][q][0], w[0], t_); t_ = __builtin_fmaf(v[j][q][1], w[1], t_); t_ = __builtin_fmaf(v[j][q][2], w[2], t_); t_ = __builtin_fmaf(v[j][q][3], w[3], t_); lg[j * 16 + e] = t_; }
                if ((e & 3) == 3) asm volatile("" ::: "memory"); } }
#define RS_STEP(N, MASK) do { const bool up_ = (F.lane & (MASK)) != 0; _Pragma("unroll") for (int k = 0; k < (N) / 2; ++k) { const float a_ = lg[k], b_ = lg[k + (N) / 2]; \
            const float send_ = up_ ? a_ : b_, keep_ = up_ ? b_ : a_; lg[k] = keep_ + __shfl_xor(send_, (MASK)); } } while (0)
        RS_STEP(64, 32); RS_STEP(32, 16); RS_STEP(16, 8); RS_STEP(8, 4); RS_STEP(4, 2); RS_STEP(2, 1);
#undef RS_STEP
        const float myv = lg[0];
        float lx[16];
#pragma unroll
        for (int e = 0; e < 16; ++e) lx[e] = __shfl(myv, (F.lane & 48) | e);
        float aff[16], sel[16];
#pragma unroll
        for (int e = 0; e < 16; ++e) { aff[e] = sigmoidf_(lx[e]); sel[e] = aff[e] + rb[e]; }
        float gs[4];
#pragma unroll
        for (int g = 0; g < 4; ++g) { const float a = sel[4 * g], bb = sel[4 * g + 1], c = sel[4 * g + 2], d = sel[4 * g + 3];
            const float hi1 = fmaxf(a, bb), lo1 = fminf(a, bb), hi2 = fmaxf(c, d), lo2 = fminf(c, d);
            gs[g] = fmaxf(hi1, hi2) + fmaxf(fminf(hi1, hi2), fmaxf(lo1, lo2)); }
        int grp = 0; float best = gs[0];
#pragma unroll
        for (int g = 1; g < 4; ++g) if (gs[g] > best) { best = gs[g]; grp = g; }
        float si[4], ai[4];
#pragma unroll
        for (int k = 0; k < 4; ++k) { si[k] = grp == 0 ? sel[k] : grp == 1 ? sel[4 + k] : grp == 2 ? sel[8 + k] : sel[12 + k]; ai[k] = grp == 0 ? aff[k] : grp == 1 ? aff[4 + k] : grp == 2 ? aff[8 + k] : aff[12 + k]; }
        int i0 = 0; float b0 = si[0];
#pragma unroll
        for (int k = 1; k < 4; ++k) if (si[k] > b0) { b0 = si[k]; i0 = k; }
        int i1 = -1; float b1 = -1e30f;
#pragma unroll
        for (int k = 0; k < 4; ++k) if (k != i0 && si[k] > b1) { b1 = si[k]; i1 = k; }
        const float a0 = i0 == 0 ? ai[0] : i0 == 1 ? ai[1] : i0 == 2 ? ai[2] : ai[3];
        const float a1 = i1 == 0 ? ai[0] : i1 == 1 ? ai[1] : i1 == 2 ? ai[2] : ai[3];
        const float inv = fast_rcp(a0 + a1);
        const int e0 = grp * 4 + i0, e1 = grp * 4 + i1;
        unsigned mylr0 = 0u, mylr1 = 0u;
#pragma unroll
        for (int j = 0; j < NR; ++j) {
            const int e0j = __builtin_amdgcn_readlane(e0, 16 * j), e1j = __builtin_amdgcn_readlane(e1, 16 * j);
            const unsigned lr0 = __builtin_amdgcn_readlane(cnt, e0j); cnt += (F.lane == e0j) ? 1u : 0u;
            const unsigned lr1 = __builtin_amdgcn_readlane(cnt, e1j); cnt += (F.lane == e1j) ? 1u : 0u;
            if ((F.lane >> 4) == j) { mylr0 = lr0; mylr1 = lr1; }
        }
        if ((F.lane & 15) == 0) stash[nst + (F.lane >> 4)] = (u32x4){(unsigned)e0 | (mylr0 << 4), (unsigned)e1 | (mylr1 << 4), __float_as_uint(a0 * inv), __float_as_uint(a1 * inv)};
        nst += NR;
    }
    if (F.lane < 16) wcnt[F.wave * 16 + F.lane] = cnt;
    __syncthreads();
    if (F.tid < 16) { const int e = F.tid; unsigned tot = 0u, pre[8];
#pragma unroll
        for (int w = 0; w < 8; ++w) { pre[w] = tot; tot += wcnt[w * 16 + e]; }
        const unsigned base = __hip_atomic_fetch_add(F.ctl + CW_CNT + (l * 16 + e) * 64, tot, __ATOMIC_RELAXED, __HIP_MEMORY_SCOPE_AGENT);
#pragma unroll
        for (int w = 0; w < 8; ++w) wbase[w * 16 + e] = base + pre[w]; }
    __syncthreads();
    for (int i = F.lane; i < nst; i += 64) { const u32x4 st = stash[i]; const int ci = i >> 2, j = i & 3; const unsigned tok = (unsigned)((F.gw + ci * F.NGW) * NR + j);
        const unsigned e0 = st.x & 15u, e1 = st.y & 15u; const unsigned rk0 = wbase[F.wave * 16 + e0] + (st.x >> 4), rk1 = wbase[F.wave * 16 + e1] + (st.y >> 4);
        F_ROWTOK[(size_t)e0 * VCAP + rk0] = tok; F_ROWTOK[(size_t)e1 * VCAP + rk1] = tok;
        F_RT[tok] = (u32x4){e0 | (rk0 << 4), e1 | (rk1 << 4), st.z, st.w}; }
    __syncthreads();
}

__device__ __forceinline__ int moe_prefix(Frame& F, int l, LAS int* pend, LAS int* pstart, LAS int* pcnt) {
    if (F.tid < 64) {
        const int c = (F.lane < 16) ? (int)__hip_atomic_load(F.ctl + CW_CNT + (l * 16 + F.lane) * 64, __ATOMIC_RELAXED, __HIP_MEMORY_SCOPE_AGENT) : 0;
        const int p = (c + 255) & ~255; int incl = p;
#pragma unroll
        for (int o = 1; o < 16; o <<= 1) { const int t = __shfl_up(incl, o); if (F.lane >= o) incl += t; }
        if (F.lane < 16) { pend[F.lane] = incl; pstart[F.lane] = incl - p; pcnt[F.lane] = c; }
    }
    __syncthreads();
    return __builtin_amdgcn_readfirstlane(pend[15] >> 8);
}

__device__ __forceinline__ void attn_phase(Frame& F, int l) {
    const int bx = blockIdx.x; const int vcu = (F.G % 8 == 0) ? (bx % 8) * (F.G / 8) + bx / 8 : bx;
    char* shm = (char*)F.ldsg;
    for (int U = vcu; U < NB * NH * (SEQ / 256); U += F.G) {
        const int h = U >> 8, b = (U & 255) >> 5, qb = U & 31;
        const size_t qrow = (size_t)b * SEQ + (size_t)qb * 256;
        attn_body::attn_unit<8>(F_Q + qrow * AW + h * 64, F_KB + (size_t)b * KVS * KVW + (h >> 2) * 64, F_VB + (size_t)b * KVS * KVW + (h >> 2) * 64, F_CAT + qrow * D + h * 64, KVS / 64, shm, F.tid);
    }
    if (ctx_out_l(l)) {
        for (int V = vcu; V < 8 * 32; V += F.G) {
            const int b = V >> 5, h = V & 31; if (h >= NH) continue;
            const size_t qrow = (size_t)NLAT + (size_t)b * CTXL; const size_t kv0 = (size_t)b * KVS + SEQ;
            attn_body::attn_unit<8>(F_Q + qrow * AW + h * 64, F_KB + kv0 * KVW + (h >> 2) * 64, F_VB + kv0 * KVW + (h >> 2) * 64, F_CAT + qrow * D + h * 64, CTXL / 64, shm, F.tid);
        }
    }
}
__device__ __forceinline__ float cv_ld(const bf16* AG, int s0, int len, int p, int ch) {
    const bool ok = p >= 0 && p < len; const int pc = p < 0 ? 0 : (p >= len ? len - 1 : p);
    const bf16* rp = AG + (size_t)(s0 + pc) * CAW; asm volatile("" : "+s"(rp));
    const float v = __uint_as_float((unsigned)((const GAS bf16*)rp)[ch] << 16);
    return ok ? v : 0.f;
}
__device__ __forceinline__ void conv_unit(Frame& F, const float* dw, const float* db, const float* lg, const float* lb, int s0, int len, int t0, int nchunk) {
    const int ch = F.wave * 64 + F.lane;
    float* ytile = (float*)F.ldsg;
    float w[31];
#pragma unroll
    for (int k = 0; k < 31; ++k) w[k] = dw[k * CAW + ch];
    const float bias = db[ch];
    const bf16* agb = F_AG;
#define CV_LD(p) cv_ld(agb, s0, len, (p), ch)
    float lo[32], hi[32];
#pragma unroll
    for (int i = 0; i < 32; ++i) { lo[i] = CV_LD(t0 - 16 + i); hi[i] = CV_LD(t0 + 16 + i); }
    const f32x4 g0 = *(const f32x4*)(lg + F.lane * 4), g1 = *(const f32x4*)(lg + 256 + F.lane * 4), b0 = *(const f32x4*)(lb + F.lane * 4), b1 = *(const f32x4*)(lb + 256 + F.lane * 4);
    for (int c = 0; c < nchunk; ++c) {
        const int T = t0 + 32 * c;
        float* yb = ytile + (c & 1) * (32 * 512);
#pragma unroll
        for (int u = 0; u < 32; ++u) { float acc = bias;
#pragma unroll
            for (int k = 0; k < 31; ++k) { const int e = u + k + 1; acc += w[k] * (e < 32 ? lo[e & 31] : hi[e & 31]); }
            yb[u * 512 + ch] = acc; }
#pragma unroll
        for (int i = 0; i < 32; ++i) { lo[i] = hi[i]; hi[i] = CV_LD(T + 48 + i); }
        __syncthreads();
#pragma unroll
        for (int rr = 0; rr < 4; ++rr) { const int u = F.wave * 4 + rr; const size_t row = (size_t)s0 + T + u;
            f32x4 y0 = *(const f32x4*)(yb + u * 512 + F.lane * 4), y1 = *(const f32x4*)(yb + u * 512 + 256 + F.lane * 4);
            const float mean = wave_sum((y0[0] + y0[1]) + (y0[2] + y0[3]) + (y1[0] + y1[1]) + (y1[2] + y1[3])) * (1.0f / CAW);
            y0 = y0 - mean; y1 = y1 - mean;
            const float rstd = __builtin_amdgcn_rsqf(wave_sum((y0[0] * y0[0] + y0[1] * y0[1]) + (y0[2] * y0[2] + y0[3] * y0[3]) + (y1[0] * y1[0] + y1[1] * y1[1]) + (y1[2] * y1[2] + y1[3] * y1[3])) * (1.0f / CAW) + EPS);
            y0 = y0 * rstd * g0 + b0; y1 = y1 * rstd * g1 + b1;
            *(u32x2*)(F_CAT + row * D + AW + F.lane * 4) = (u32x2){pk2(siluf_(y0[0]), siluf_(y0[1])), pk2(siluf_(y0[2]), siluf_(y0[3]))};
            *(u32x2*)(F_CAT + row * D + AW + 256 + F.lane * 4) = (u32x2){pk2(siluf_(y1[0]), siluf_(y1[1])), pk2(siluf_(y1[2]), siluf_(y1[3]))}; }
    }
#undef CV_LD
    __syncthreads();
}
__device__ __forceinline__ void conv_phase(Frame& F, int l) {
    const int i = l >> 1;
    const float* dw = F_ev_dw_w + (size_t)i * 31 * CAW; const float* db = F_ev_dw_b + i * CAW; const float* lg = F_ev_ln_g + i * CAW; const float* lb = F_ev_ln_b + i * CAW;
    const int nu = NLAT / 128 + (ctx_out_l(l) ? NCTX / 128 : 0);
    for (int U = blockIdx.x; U < nu; U += F.G) {
        int s0, len, t0;
        if (U < NLAT / 128) { s0 = (U >> 6) * SEQ; len = SEQ; t0 = (U & 63) * 128; } else { const int V = U - NLAT / 128; s0 = NLAT + (V >> 1) * CTXL; len = CTXL; t0 = (V & 1) * 128; }
        conv_unit(F, dw, db, lg, lb, s0, len, t0, 4);
    }
}
__device__ __forceinline__ void sconv_phase(Frame& F, int l) {
    const int i = l >> 1; const int nrows = NLAT + (ctx_out_l(l) ? NCTX : 0);
    const float* cw = F_od_conv_w + (size_t)i * 3 * D;
    const int c0 = F.lane * 8, c1 = 512 + F.lane * 8;
    f32x4 w[3][4];
#pragma unroll
    for (int k = 0; k < 3; ++k) { w[k][0] = *(const f32x4*)(cw + k * D + c0); w[k][1] = *(const f32x4*)(cw + k * D + c0 + 4); w[k][2] = *(const f32x4*)(cw + k * D + c1); w[k][3] = *(const f32x4*)(cw + k * D + c1 + 4); }
    for (int r = F.gw * 2; r < nrows; r += F.NGW * 2) {
        int s0, len; if (r < NLAT) { s0 = r & ~(SEQ - 1); len = SEQ; } else { s0 = NLAT + ((r - NLAT) & ~255); len = CTXL; }
        const int pos = r - s0;
        u32x4 uu[4][2], gb[2][2];
#pragma unroll
        for (int k = 0; k < 4; ++k) { const int p = pos + k - 1; const int pc = p < 0 ? 0 : (p >= len ? len - 1 : p); const bf16* ur = F_U + (size_t)(s0 + pc) * D;
            uu[k][0] = __builtin_nontemporal_load((const u32x4*)(ur + c0)); uu[k][1] = __builtin_nontemporal_load((const u32x4*)(ur + c1)); }
#pragma unroll
        for (int j = 0; j < 2; ++j) { gb[j][0] = __builtin_nontemporal_load((const u32x4*)(F_GB + (size_t)(r + j) * D + c0)); gb[j][1] = __builtin_nontemporal_load((const u32x4*)(F_GB + (size_t)(r + j) * D + c1)); }
        float uf[4][16];
#pragma unroll
        for (int k = 0; k < 4; ++k) { const int p = pos + k - 1; const bool ok = p >= 0 && p < len; unpack8(uu[k][0], uf[k]); unpack8(uu[k][1], uf[k] + 8);
            if (!ok) {
#pragma unroll
                for (int c = 0; c < 16; ++c) uf[k][c] = 0.f; } }
#pragma unroll
        for (int j = 0; j < 2; ++j) { float g[16], y[16]; unpack8(gb[j][0], g); unpack8(gb[j][1], g + 8);
#pragma unroll
            for (int c = 0; c < 16; ++c) { const int q = c >> 2, e = c & 3; y[c] = g[c] * (w[0][q][e] * uf[j][c] + w[1][q][e] * uf[j + 1][c] + w[2][q][e] * uf[j + 2][c]); }
            *(u32x4*)(F_SB + (size_t)(r + j) * D + c0) = pack8(y); *(u32x4*)(F_SB + (size_t)(r + j) * D + c1) = pack8(y + 8); }
    }
}

#ifndef PROBE
#define PROBE (-1)
#endif
#ifndef ONLY
#define ONLY (-1)
#endif
constexpr int PPL = 9, NPH = 1 + DEPTH * PPL + 1;
__global__ void __launch_bounds__(NTHR, 2) fwd(Args args) {
    extern __shared__ __attribute__((aligned(16))) unsigned char lds_[];
    Frame F;
    F.lds = (LAS unsigned char*)lds_; F.ldsg = lds_;
    F.MISC = (volatile LAS unsigned*)(F.lds + MISC_OFF);
    F.tid = threadIdx.x; F.lane = F.tid & 63; F.wave = __builtin_amdgcn_readfirstlane(F.tid >> 6);
    const int wave0 = F.wave;
#define MY_TID() (wave0 * 64 + (int)__builtin_amdgcn_mbcnt_hi(~0u, __builtin_amdgcn_mbcnt_lo(~0u, opaque_zero())))
    F.G = gridDim.x; F.gw = blockIdx.x * NWAVES + F.wave; F.NGW = F.G * NWAVES;
    F.ws = args.ws; F.ctl = (unsigned*)(args.ws + WS_CTL); F.out = args.out; F.in = args.in;
    for (int u = F.tid; u < (LDS_BYTES - LDSCTL_OFF) / 4; u += NTHR) ((LAS unsigned*)(F.lds + LDSCTL_OFF))[u] = 0u;
    __syncthreads();
    const int lo = args.ph_lo, hi = args.ph_hi;
    const int bar_off = args.dry ? 16384 : CW_BAR;
    XcdBarrier bar; bar.bar = F.ctl + bar_off; bar.x = 0; bar.st = F.MISC + 8;
    if (hi - lo > 1) bar = xcd_barrier_post(F.ctl + bar_off, F.MISC + 8, F.tid);
#define IN(k) (lo <= (k) && (k) < hi)
#define EN(id) (ONLY < 0 || ONLY == (id))
#define PH(id, k) for (int rp_ = 0; rp_ < ((PROBE == (id)) ? 2 : 1); ++rp_) if (EN(id) && IN(k))
#define PB() do { if (rp_) __syncthreads(); int t_ = MY_TID(); asm volatile("" : "+v"(t_)); F.tid = t_; F.lane = t_ & 63; F.wave = __builtin_amdgcn_readfirstlane(t_ >> 6); F.gw = blockIdx.x * NWAVES + F.wave; \
    F.ws = args.ws; F.in = args.in; F.out = args.out; { unsigned long long w_ = rfl64((unsigned long long)F.ws), o_ = rfl64((unsigned long long)F.out); asm volatile("" : "+s"(w_), "+s"(o_)); w_ = rfl64(w_); o_ = rfl64(o_); F.ws = (unsigned char*)(GAS unsigned char*)w_; F.out = (float*)(GAS float*)o_; F.xw = args.dry ? (float*)(F.ws + WS_Q) : F.out; } F.ctl = (unsigned*)(F.ws + WS_CTL); } while (0)
#define SEAM(k) do { if (IN(k) && IN((k) + 1)) { unsigned long long b_ = rfl64((unsigned long long)((unsigned*)(args.ws + WS_CTL) + bar_off)); asm volatile("" : "+s"(b_)); bar.bar = (unsigned*)(GAS unsigned*)rfl64(b_); xcd_barrier(bar, MY_TID()); if (PROBE == 200) xcd_barrier(bar, MY_TID()); } } while (0)

#if PROBE >= 300 && PROBE < 400
    {
        int rp_ = 0; PB();
        float* dstp = (float*)(F.ws + WS_P);
        const float* srcp = (const float*)(F.ws + WS_Q);
#if PROBE == 300
        for (int ch = F.gw; ch < NLAT / 4; ch += F.NGW) { f32x4 v[4][4];
#pragma unroll
            for (int j = 0; j < 4; ++j)
#pragma unroll
                for (int q = 0; q < 4; ++q) v[j][q] = __builtin_nontemporal_load((const f32x4*)(srcp + (size_t)(ch * 4 + j) * D + F.lane * 4 + 256 * q));
#pragma unroll
            for (int j = 0; j < 4; ++j)
#pragma unroll
                for (int q = 0; q < 4; ++q) __builtin_nontemporal_store(v[j][q], (f32x4*)(dstp + (size_t)(ch * 4 + j) * D + F.lane * 4 + 256 * q)); }
#elif PROBE == 301
        for (int ch = F.gw; ch < NLAT / 8; ch += F.NGW) { f32x4 v[8][4];
#pragma unroll
            for (int j = 0; j < 8; ++j)
#pragma unroll
                for (int q = 0; q < 4; ++q) v[j][q] = __builtin_nontemporal_load((const f32x4*)(srcp + (size_t)(ch * 8 + j) * D + F.lane * 4 + 256 * q));
#pragma unroll
            for (int j = 0; j < 8; ++j)
#pragma unroll
                for (int q = 0; q < 4; ++q) __builtin_nontemporal_store(v[j][q], (f32x4*)(dstp + (size_t)(ch * 8 + j) * D + F.lane * 4 + 256 * q)); }
#elif PROBE == 302
        for (int ch = F.gw; ch < NLAT / 4; ch += F.NGW) { f32x4 v[4][4];
#pragma unroll
            for (int j = 0; j < 4; ++j)
#pragma unroll
                for (int q = 0; q < 4; ++q) v[j][q] = *(const f32x4*)(srcp + (size_t)(ch * 4 + j) * D + F.lane * 4 + 256 * q);
#pragma unroll
            for (int j = 0; j < 4; ++j)
#pragma unroll
                for (int q = 0; q < 4; ++q) *(f32x4*)(dstp + (size_t)(ch * 4 + j) * D + F.lane * 4 + 256 * q) = v[j][q]; }
#elif PROBE == 303
        { f32x4 acc = {0.f, 0.f, 0.f, 0.f};
        for (int ch = F.gw; ch < NLAT / 4; ch += F.NGW) { f32x4 v[4][4];
#pragma unroll
            for (int j = 0; j < 4; ++j)
#pragma unroll
                for (int q = 0; q < 4; ++q) v[j][q] = __builtin_nontemporal_load((const f32x4*)(srcp + (size_t)(ch * 4 + j) * D + F.lane * 4 + 256 * q));
#pragma unroll
            for (int j = 0; j < 4; ++j)
#pragma unroll
                for (int q = 0; q < 4; ++q) acc += v[j][q]; }
        *(f32x4*)(dstp + (size_t)F.gw * 256 + F.lane * 4) = acc; }
#endif
        __syncthreads();
    }
#endif
    PH(100, 0) { PB(); prologue(F); }
    SEAM(0);
    for (int l = 0; l < DEPTH; ++l) {
        const int pb = 1 + l * PPL; const bool even = !(l & 1); const int li = l >> 1;
        for (int rp_ = 0; rp_ < ((PROBE == 10 && l == 0) ? 2 : 1); ++rp_) if (EN(10) && IN(pb + 0)) { PB(); norm1_phase(F, l, false); }
        SEAM(pb + 0);
        PH(1, pb + 1) {
            PB();
            if (even) {
                pg8::EvenInOrder S; S.d.init(NLAT, EVIN, D, F_W_EVIN + (size_t)li * EVIN * D, F.G, (int)blockIdx.x); S.kvonly = !ctx_out_l(l);
                pg8::EpiEvenIn E{F_Q, F_KB, F_VB, F_AG, F_ev_qg + li * 64, F_ev_kg + li * 64, F_ROPE};
                pg8::gemm_phase<pg8::EpiEvenIn, pg8::EvenInOrder>(F.lds, F_HB, D, S, E, F.tid);
            } else {
                const int M = NLAT + (ctx_out_l(l) ? NCTX : 0);
                pg8::DenseOrder S; S.init(M, ODIN, D, F_W_ODIN + (size_t)li * ODIN * D, F.G, (int)blockIdx.x);
                pg8::EpiOddIn E{F_U, F_GB};
                pg8::gemm_phase<pg8::EpiOddIn, pg8::DenseOrder>(F.lds, F_HB, D, S, E, F.tid);
            }
        }
        if (IN(pb + 1) && IN(pb + 3)) { unsigned long long b_ = rfl64((unsigned long long)((unsigned*)(args.ws + WS_CTL) + bar_off)); asm volatile("" : "+s"(b_)); bar.bar = (unsigned*)(GAS unsigned*)rfl64(b_); xcd_barrier(bar, MY_TID()); if (PROBE == 200) xcd_barrier(bar, MY_TID()); }
        if (even) {
            PH(30, pb + 3) { PB(); attn_phase(F, l); }
            PH(31, pb + 3) { PB(); conv_phase(F, l); }
        } else {
            PH(32, pb + 3) { PB(); sconv_phase(F, l); }
        }
        SEAM(pb + 3);
        PH(4, pb + 4) {
            PB();
            const int M = NLAT + (ctx_out_l(l) ? NCTX : 0);
            pg8::DenseOrder S; S.init(M, D, D, even ? F_W_EVOUT + (size_t)li * D * D : F_W_ODOUT + (size_t)li * D * D, F.G, (int)blockIdx.x);
            pg8::EpiPlain E{F_OX, D};
            pg8::gemm_phase<pg8::EpiPlain, pg8::DenseOrder>(F.lds, even ? F_CAT : F_SB, D, S, E, F.tid);
        }
        SEAM(pb + 4);
        PH(5, pb + 5) { PB(); norm2_phase(F, l); }
        if (IN(pb + 5) && IN(pb + 7)) { unsigned long long b_ = rfl64((unsigned long long)((unsigned*)(args.ws + WS_CTL) + bar_off)); asm volatile("" : "+s"(b_)); bar.bar = (unsigned*)(GAS unsigned*)rfl64(b_); xcd_barrier(bar, MY_TID()); }
        PH(7, pb + 7) {
            PB();
            LAS int* pend = (LAS int*)(F.lds + LDSCTL_OFF); LAS int* pstart = pend + 16; LAS int* pcnt = pend + 32;
            const int nblk = moe_prefix(F, l, pend, pstart, pcnt);
            pg8::MoeOrder<true> S; S.nblk = nblk; S.G = F.G; S.c = (F.G % 8 == 0) ? (int)((blockIdx.x % 8) * (F.G / 8) + blockIdx.x / 8) : (int)blockIdx.x;     S.K = D; S.Bt = F_W_MOE1 + (size_t)l * NE * D * D; S.estride = (size_t)D * D * 2; S.pend = pend; S.rowtok = F_ROWTOK;
            pg8::EpiSwiGLU E{F_HMID};
            pg8::gemm_phase<pg8::EpiSwiGLU, pg8::MoeOrder<true>>(F.lds, F_HB, D, S, E, F.tid);
        }
        SEAM(pb + 7);
        PH(8, pb + 8) {
            PB();
            LAS int* pend = (LAS int*)(F.lds + LDSCTL_OFF); LAS int* pstart = pend + 16; LAS int* pcnt = pend + 32;
            const int nblk = moe_prefix(F, l, pend, pstart, pcnt);
            pg8::MoeOrder<false> S; S.nblk = nblk; S.G = F.G; S.c = (F.G % 8 == 0) ? (int)((blockIdx.x % 8) * (F.G / 8) + blockIdx.x / 8) : (int)blockIdx.x;     S.K = DE; S.Bt = F_W_MOE2 + (size_t)l * NE * D * DE; S.estride = (size_t)D * DE * 2; S.pend = pend; S.rowtok = nullptr;
            pg8::EpiPlain E{F_Y, D};
            pg8::gemm_phase<pg8::EpiPlain, pg8::MoeOrder<false>>(F.lds, F_HMID, DE, S, E, F.tid);
        }
        SEAM(pb + 8);
    }
    PH(11, NPH - 1) { PB(); norm1_phase(F, DEPTH, true); }
#undef IN
#undef SEAM
}

extern "C" void kernel_launch(void* const* d_in, const int* in_sizes, int n_in, void* d_out, int out_size, void* d_ws, size_t ws_size, hipStream_t stream) {
    static int grid = 0;
    if (grid == 0) {
        if (n_in != 24 || in_sizes[0] != NLAT * D || out_size != NLAT * D || ws_size < WS_END) { fprintf(stderr, "kernel_launch: unexpected shapes (n_in %d, in0 %d, out %d, ws %zu); nothing launched\n", n_in, n_in > 0 ? in_sizes[0] : -1, out_size, ws_size); grid = -1; return; }
        int dev = 0, cus = 0, per_cu = 0;
        if (hipGetDevice(&dev) != hipSuccess || hipDeviceGetAttribute(&cus, hipDeviceAttributeMultiprocessorCount, dev) != hipSuccess) { grid = -1; return; }
        if (hipFuncSetAttribute((const void*)fwd, hipFuncAttributeMaxDynamicSharedMemorySize, LDS_BYTES) != hipSuccess) { fprintf(stderr, "kernel_launch: hipFuncSetAttribute failed\n"); grid = -1; return; }
        if (hipOccupancyMaxActiveBlocksPerMultiprocessor(&per_cu, (const void*)fwd, NTHR, LDS_BYTES) != hipSuccess || per_cu < 1) fprintf(stderr, "kernel_launch: occupancy query reports %d\n", per_cu);
        (void)hipGetLastError();
        grid = cus;
    }
    if (grid < 0) return;
    if (hipMemsetAsync((char*)d_ws + WS_CTL, 0, CTL_ZERO_BYTES, stream) != hipSuccess) return;
    Args a{};
    for (int i = 0; i < 24; ++i) a.in[i] = (const float*)d_in[i];
    a.out = (float*)d_out; a.ws = (unsigned char*)d_ws;
#if MK_ONE_LAUNCH
#if defined(PROBE_CUM)
    a.ph_lo = 0; a.ph_hi = PROBE_CUM;
    hipLaunchKernelGGL(fwd, dim3(grid), dim3(NTHR), LDS_BYTES, stream, a);
    if (hipMemsetAsync((char*)d_ws + WS_CTL, 0, CTL_ZERO_BYTES, stream) != hipSuccess) return;
#endif
    a.ph_lo = 0; a.ph_hi = NPH;
    hipLaunchKernelGGL(fwd, dim3(grid), dim3(NTHR), LDS_BYTES, stream, a);
#if defined(PROBE_DRY)
#ifndef PROBE_DRY_N
#define PROBE_DRY_N 1
#endif
    a.ph_lo = PROBE_DRY; a.ph_hi = PROBE_DRY + PROBE_DRY_N; a.dry = 1;
    hipLaunchKernelGGL(fwd, dim3(grid), dim3(NTHR), LDS_BYTES, stream, a);
#endif
#else
    for (int p = 0; p < NPH; ++p) {
        if (p >= 1 && p < NPH - 1) { const int l = (p - 1) / PPL, k = (p - 1) % PPL; (void)l; if (k == 2 || k == 6) continue; }
        a.ph_lo = p; a.ph_hi = p + 1;
        hipLaunchKernelGGL(fwd, dim3(grid), dim3(NTHR), LDS_BYTES, stream, a);
    }
#endif
}
```

```cpp
#include <hip/hip_runtime.h>
#include <cstdio>
#include <cstdint>

#ifndef MK_ONE_LAUNCH
#define MK_ONE_LAUNCH 1
#endif

#define LAS __attribute__((address_space(3)))
#define GAS __attribute__((address_space(1)))
typedef unsigned short bf16;
typedef short bf16x8 __attribute__((ext_vector_type(8)));
typedef float f32x4 __attribute__((ext_vector_type(4)));
typedef float f32x2 __attribute__((ext_vector_type(2)));
typedef unsigned u32x4 __attribute__((ext_vector_type(4)));
typedef unsigned u32x2 __attribute__((ext_vector_type(2)));
typedef __bf16 bf16x2_t __attribute__((ext_vector_type(2)));

constexpr int D = 1024, NB = 8, SEQ = 8192, NLAT = NB * SEQ, CTXL = 256, NCTX = NB * CTXL, TALL = NLAT + NCTX, ZROW = TALL;
constexpr int KVS = SEQ + CTXL;
constexpr int NH = 8, NKVH = 2, HD = 64, AW = 512, KVW = 128, CAW = 512, EVIN = 1792, ODIN = 3072;
constexpr int NE = 16, DE = 512, MAXBLK = 544, MAXROWS = MAXBLK * 256, VCAP = 2 * TALL;
constexpr int DEPTH = 4;
constexpr float EPS = 1e-6f;
constexpr float C2 = 0.125f * 1.4426950408889634f;

constexpr size_t MiB = 1u << 20;
constexpr size_t WS_CTL = 0, CTL_ZERO_BYTES = 128 * 1024;
constexpr size_t WS_MOD = 1 * MiB;
constexpr size_t WS_ROPE = 2 * MiB;
constexpr size_t WS_RT = 3 * MiB;
constexpr size_t WS_DEST = 5 * MiB;
constexpr size_t WS_WB = 6 * MiB;
constexpr size_t WS_ROWTOK = 931 * MiB;
constexpr size_t WS_Z = 8 * MiB;
constexpr size_t WS_W_EVIN = 16 * MiB, WS_W_EVOUT = 23 * MiB, WS_W_ODIN = 27 * MiB, WS_W_ODOUT = 39 * MiB, WS_W_MOE1 = 43 * MiB, WS_W_MOE2 = 171 * MiB;
constexpr size_t WS_HB = 236 * MiB;
constexpr size_t WS_BIG = 369 * MiB;
constexpr size_t WS_P = WS_BIG, WS_CAT = WS_BIG, WS_OX = 501 * MiB, WS_HMID = WS_BIG, WS_Y = 505 * MiB;
constexpr size_t WS_Q = 765 * MiB, WS_K = 831 * MiB, WS_V = 848 * MiB, WS_AG = 865 * MiB, WS_S = 765 * MiB;
constexpr size_t WS_U = WS_BIG, WS_GB = 633 * MiB;
constexpr size_t WS_END = 940 * MiB;
constexpr int CW_TMO = 0, CW_CODE = 1, CW_BAR = 4096, CW_CNT = 8192;

constexpr int RING_BYTES = 131072, LDSCTL_OFF = RING_BYTES, MISC_OFF = LDSCTL_OFF + 320, LDS_BYTES = 147456;
constexpr int NWAVES = 8, NTHR = 512;

__device__ __forceinline__ unsigned pk2(float lo, float hi) { f32x2 v = {lo, hi}; bf16x2_t b = __builtin_convertvector(v, bf16x2_t); return __builtin_bit_cast(unsigned, b); }
__device__ __forceinline__ float bflo(unsigned w) { return __uint_as_float(w << 16); }
__device__ __forceinline__ float bfhi(unsigned w) { return __uint_as_float(w & 0xffff0000u); }
__device__ __forceinline__ void unpack8(const u32x4 w, float* f) { f[0] = bflo(w.x); f[1] = bfhi(w.x); f[2] = bflo(w.y); f[3] = bfhi(w.y); f[4] = bflo(w.z); f[5] = bfhi(w.z); f[6] = bflo(w.w); f[7] = bfhi(w.w); }
__device__ __forceinline__ u32x4 pack8(const float* f) { u32x4 w; w.x = pk2(f[0], f[1]); w.y = pk2(f[2], f[3]); w.z = pk2(f[4], f[5]); w.w = pk2(f[6], f[7]); return w; }
__device__ __forceinline__ float wave_sum(float v) {
#pragma unroll
    for (int o = 1; o < 64; o <<= 1) v += __shfl_xor(v, o);
    return v;
}
__device__ __forceinline__ float fast_exp2(float x) { return __builtin_amdgcn_exp2f(x); }
__device__ __forceinline__ float fast_rcp(float x) { return __builtin_amdgcn_rcpf(x); }
__device__ __forceinline__ float sigmoidf_(float x) { return fast_rcp(1.0f + fast_exp2(-1.4426950408889634f * x)); }
__device__ __forceinline__ float siluf_(float x) { return x * sigmoidf_(x); }
__device__ __forceinline__ unsigned opaque_zero() { unsigned z = 0u; asm volatile("" : "+v"(z)); return z; }
__device__ __forceinline__ unsigned long long rfl64(unsigned long long v) { const unsigned lo = __builtin_amdgcn_readfirstlane((unsigned)v), hi = __builtin_amdgcn_readfirstlane((unsigned)(v >> 32)); return ((unsigned long long)hi << 32) | lo; }
#define LDS_WAIT() asm volatile("s_waitcnt lgkmcnt(0)" ::: "memory")

namespace pg8 {
constexpr int BM = 256, BK = 64, HALF = 128, HTB = HALF * BK * 2, STAGE_BYTES = 8 * HTB, NXCD = 8, WGM = 8;
__host__ __device__ __forceinline__ int lds_byte(int r, int c) { const int st = (r >> 4) * 2 + (c >> 5), rr = r & 15, cc = c & 31, ob = rr * 64 + cc * 2; return st * 1024 + (ob ^ (((ob >> 9) & 1) << 5)); }
__host__ __device__ __forceinline__ void stage_rc(int b, int& R, int& C) { const int st = b / 1024, sb = b % 1024, swz = sb ^ (((sb >> 9) & 1) << 5); R = (st >> 1) * 16 + swz / 64; C = (st & 1) * 32 + (swz % 64) / 2; }
__host__ __device__ __forceinline__ int perm32(int rho) { const int n = rho >> 4, i = rho & 15; return 8 * (i >> 2) + 4 * n + (i & 3); }

struct Unit { int pm, pn, e; };

struct DenseOrder {
    int nM, nN, nwg, G, c, K; const bf16* Bt;
    __device__ void init(int M, int N, int K_, const bf16* Bt_, int G_, int c_) { nM = M / BM; nN = N / BM; nwg = nM * nN; G = G_; c = c_; K = K_; Bt = Bt_; }
    __device__ bool next(int i, Unit& u) const {
        const long L = (long)i * G + c; if (L >= nwg) return false;
        int wgid = (int)L; { const int q = nwg / NXCD, r = nwg % NXCD, xcd = wgid % NXCD, off = wgid / NXCD; wgid = (xcd < r ? xcd * (q + 1) : r * (q + 1) + (xcd - r) * q) + off; }
        const int nig = WGM * nN, gid = wgid / nig, fm = gid * WGM, gsz = (nM - fm) < WGM ? (nM - fm) : WGM;
        u.pm = fm + ((wgid % nig) % gsz); u.pn = (wgid % nig) / gsz; u.e = 0; return true;
    }
    __device__ __forceinline__ const char* bbase(const Unit& u) const { return (const char*)Bt + (size_t)u.pn * 256 * K * 2; }
    __device__ __forceinline__ void aoffs(const Unit& u, const int (&Rr)[2], const int (&Cc)[2], unsigned (&a)[2][2]) const {
#pragma unroll
        for (int h = 0; h < 2; ++h)
#pragma unroll
            for (int i = 0; i < 2; ++i) a[h][i] = (unsigned)((u.pm * 256 + h * 128 + Rr[i]) * K + Cc[i]) * 2u;
    }
    __device__ __forceinline__ void tok_load(const Unit&, const int (&)[2], unsigned (&)[2][2]) const {}
    __device__ __forceinline__ void aoffs_from(const Unit& u, const int (&Rr)[2], const int (&Cc)[2], const unsigned (&)[2][2], unsigned (&a)[2][2]) const { aoffs(u, Rr, Cc, a); }
};
template <bool GATHER> struct MoeOrder {
    int nblk, G, c, K; const bf16* Bt; size_t estride; const LAS int* pend; const unsigned* rowtok;
    __device__ bool next(int i, Unit& u) const {
        const long L = (long)i * G + c; if (L >= (long)nblk * 4) return false;
        u.pm = (int)(L >> 2); u.pn = (int)(L & 3); const int r0 = u.pm * 256; int e = 0;
#pragma unroll
        for (int j = 0; j < 15; ++j) e += (r0 >= pend[j]) ? 1 : 0;
        u.e = __builtin_amdgcn_readfirstlane(e); return true;
    }
    __device__ __forceinline__ const char* bbase(const Unit& u) const { return (const char*)Bt + (size_t)u.e * estride + (size_t)u.pn * 256 * K * 2; }
    __device__ __forceinline__ void tok_load(const Unit& u, const int (&Rr)[2], unsigned (&raw)[2][2]) const {
#pragma unroll
        for (int h = 0; h < 2; ++h)
#pragma unroll
            for (int i = 0; i < 2; ++i) { const int row = u.pm * 256 + h * 128 + Rr[i]; unsigned src = (unsigned)row;
                if (GATHER) { const int rin = row - pend[16 + u.e]; const unsigned tk = rowtok[(size_t)u.e * VCAP + rin]; src = rin < pend[32 + u.e] ? tk : (unsigned)ZROW; }
                raw[h][i] = src; }
    }
    __device__ __forceinline__ void aoffs_from(const Unit&, const int (&)[2], const int (&Cc)[2], const unsigned (&raw)[2][2], unsigned (&a)[2][2]) const {
#pragma unroll
        for (int h = 0; h < 2; ++h)
#pragma unroll
            for (int i = 0; i < 2; ++i) a[h][i] = (raw[h][i] * (unsigned)K + (unsigned)Cc[i]) * 2u;
    }
    __device__ __forceinline__ void aoffs(const Unit& u, const int (&Rr)[2], const int (&Cc)[2], unsigned (&a)[2][2]) const { unsigned raw[2][2]; tok_load(u, Rr, raw); aoffs_from(u, Rr, Cc, raw, a); }
};

struct EpiPlain {
    bf16* O; int ldc;
    __device__ __forceinline__ void operator()(const f32x4 (&acc)[2][2][4][2], const Unit& u, int wr, int wc, int fr, int fq) const {
        const int row0 = u.pm * BM + wr * 64 + fr, col0 = u.pn * BM + wc * 32 + 8 * fq;
#pragma unroll
        for (int ai = 0; ai < 2; ++ai)
#pragma unroll
            for (int m = 0; m < 4; ++m) { bf16* rowp = O + (size_t)(row0 + ai * HALF + m * 16) * ldc + col0;
#pragma unroll
                for (int bj = 0; bj < 2; ++bj) { const f32x4 v0 = acc[ai][bj][m][0], v1 = acc[ai][bj][m][1];
                    u32x4 w; w.x = pk2(v0[0], v0[1]); w.y = pk2(v0[2], v0[3]); w.z = pk2(v1[0], v1[1]); w.w = pk2(v1[2], v1[3]);
                    *(u32x4*)(rowp + bj * HALF) = w; } }
    }
};
struct EpiSwiGLU {
    bf16* H;
    __device__ __forceinline__ void operator()(const f32x4 (&acc)[2][2][4][2], const Unit& u, int wr, int wc, int fr, int fq) const {
        const int row0 = u.pm * BM + wr * 64 + fr, col0 = u.pn * 128 + wc * 32 + 8 * fq;
#pragma unroll
        for (int ai = 0; ai < 2; ++ai)
#pragma unroll
            for (int m = 0; m < 4; ++m) { bf16* rowp = H + (size_t)(row0 + ai * HALF + m * 16) * DE + col0;
                float o[8];
#pragma unroll
                for (int n = 0; n < 2; ++n)
#pragma unroll
                    for (int j = 0; j < 4; ++j) { const float g = acc[ai][0][m][n][j], up = acc[ai][1][m][n][j]; o[n * 4 + j] = siluf_(g) * up; }
                *(u32x4*)rowp = pack8(o); }
    }
};

struct EpiEvenIn {
    bf16 *Q, *KB, *VB, *AG; const float* qg; const float* kg; const f32x2* rope;
    __device__ __forceinline__ void operator()(const f32x4 (&acc)[2][2][4][2], const Unit& u, int wr, int wc, int fr, int fq) const {
        const int row0 = u.pm * BM + wr * 64 + fr;
        if (u.pn >= 3) {
            const int col0 = (u.pn - 3) * 128 + wc * 32 + 8 * fq;
#pragma unroll
            for (int ai = 0; ai < 2; ++ai)
#pragma unroll
                for (int m = 0; m < 4; ++m) { float o[8];
#pragma unroll
                    for (int n = 0; n < 2; ++n)
#pragma unroll
                        for (int j = 0; j < 4; ++j) o[n * 4 + j] = acc[ai][0][m][n][j] * sigmoidf_(acc[ai][1][m][n][j]);
                    *(u32x4*)(AG + (size_t)(row0 + ai * HALF + m * 16) * CAW + col0) = pack8(o); }
            return;
        }
        if (u.pn == 2 && wc >= 2) {
#pragma unroll
            for (int ai = 0; ai < 2; ++ai)
#pragma unroll
                for (int m = 0; m < 4; ++m) { const int row = row0 + ai * HALF + m * 16;
                    const size_t kvrow = row < NLAT ? (size_t)(row >> 13) * KVS + (row & (SEQ - 1)) : (size_t)((row - NLAT) >> 8) * KVS + SEQ + ((row - NLAT) & 255);
#pragma unroll
                    for (int bj = 0; bj < 2; ++bj) { float o[8];
#pragma unroll
                        for (int n = 0; n < 2; ++n)
#pragma unroll
                            for (int j = 0; j < 4; ++j) o[n * 4 + j] = acc[ai][bj][m][n][j];
                        *(u32x4*)(VB + kvrow * KVW + (wc - 2) * 64 + 32 * bj + 8 * fq) = pack8(o); } }
            return;
        }
        const bool isq = u.pn < 2; const float* g = isq ? qg : kg; const float post = isq ? C2 : 1.0f;
        f32x4 gv[2][2];
#pragma unroll
        for (int bj = 0; bj < 2; ++bj)
#pragma unroll
            for (int n = 0; n < 2; ++n) gv[bj][n] = *(const f32x4*)(g + 32 * bj + 8 * fq + 4 * n);
#pragma unroll
        for (int ai = 0; ai < 2; ++ai)
#pragma unroll
            for (int m = 0; m < 4; ++m) { const int row = row0 + ai * HALF + m * 16;
                float ss = 0.f;
#pragma unroll
                for (int bj = 0; bj < 2; ++bj)
#pragma unroll
                    for (int n = 0; n < 2; ++n) { const f32x4 x = acc[ai][bj][m][n]; ss += (x[0] * x[0] + x[1] * x[1]) + (x[2] * x[2] + x[3] * x[3]); }
                ss += __shfl_xor(ss, 16); ss += __shfl_xor(ss, 32);
                const float rstd = __builtin_amdgcn_rsqf(ss * (1.0f / 64.0f) + EPS);
                const bool isx = row < NLAT; const int pos = row & (SEQ - 1);
                bf16* dst; if (isq) dst = Q + (size_t)row * AW + (u.pn * 4 + wc) * 64;
                else { const size_t kvrow = isx ? (size_t)(row >> 13) * KVS + pos : (size_t)((row - NLAT) >> 8) * KVS + SEQ + ((row - NLAT) & 255); dst = KB + kvrow * KVW + wc * 64; }
#pragma unroll
                for (int bj = 0; bj < 2; ++bj) { float o[8];
                    const int ps = bj ? (pos & 63) : (pos >> 6);
#pragma unroll
                    for (int n = 0; n < 2; ++n) { f32x4 f = acc[ai][bj][m][n] * rstd * gv[bj][n];
                        if (isx) { const f32x4 cs = *(const f32x4*)(rope + ps * 16 + 4 * fq + 2 * n);
                            const float x0 = f[0], x1 = f[1], x2 = f[2], x3 = f[3];
                            f[0] = x0 * cs[0] - x1 * cs[1]; f[1] = x0 * cs[1] + x1 * cs[0]; f[2] = x2 * cs[2] - x3 * cs[3]; f[3] = x2 * cs[3] + x3 * cs[2]; }
                        o[n * 4 + 0] = f[0] * post; o[n * 4 + 1] = f[1] * post; o[n * 4 + 2] = f[2] * post; o[n * 4 + 3] = f[3] * post; }
                    *(u32x4*)(dst + 32 * bj + 8 * fq) = pack8(o); } }
    }
};
struct EpiOddIn {
    bf16 *U, *GB;
    __device__ __forceinline__ void operator()(const f32x4 (&acc)[2][2][4][2], const Unit& u, int wr, int wc, int fr, int fq) const {
        const int row0 = u.pm * BM + wr * 64 + fr;
#pragma unroll
        for (int ai = 0; ai < 2; ++ai)
#pragma unroll
            for (int m = 0; m < 4; ++m) { const size_t row = (size_t)(row0 + ai * HALF + m * 16);
                if (u.pn < 8) { float o[8];
#pragma unroll
                    for (int n = 0; n < 2; ++n)
#pragma unroll
                        for (int j = 0; j < 4; ++j) o[n * 4 + j] = acc[ai][0][m][n][j] * acc[ai][1][m][n][j];
                    *(u32x4*)(U + row * D + u.pn * 128 + wc * 32 + 8 * fq) = pack8(o);
                } else {
#pragma unroll
                    for (int bj = 0; bj < 2; ++bj) { float o[8];
#pragma unroll
                        for (int n = 0; n < 2; ++n)
#pragma unroll
                            for (int j = 0; j < 4; ++j) o[n * 4 + j] = acc[ai][bj][m][n][j];
                        *(u32x4*)(GB + row * D + (u.pn - 8) * 256 + bj * HALF + wc * 32 + 8 * fq) = pack8(o); } } }
    }
};
struct EvenInOrder {
    DenseOrder d; bool kvonly;
    __device__ bool next(int i, Unit& u) const {
        const long L = (long)i * d.G + d.c; const int nx = d.nwg;
        if (L < nx) return d.next(i, u);
        const int j = (int)(L - nx); const int nextra = kvonly ? (NCTX / 256) : (NCTX / 256) * 7; if (j >= nextra) return false;
        if (kvonly) { u.pm = NLAT / 256 + j; u.pn = 2; } else { u.pm = NLAT / 256 + j / 7; u.pn = j % 7; }
        u.e = 0; return true;
    }
    __device__ __forceinline__ const char* bbase(const Unit& u) const { return d.bbase(u); }
    __device__ __forceinline__ void aoffs(const Unit& u, const int (&Rr)[2], const int (&Cc)[2], unsigned (&a)[2][2]) const { d.aoffs(u, Rr, Cc, a); }
    __device__ __forceinline__ void tok_load(const Unit&, const int (&)[2], unsigned (&)[2][2]) const {}
    __device__ __forceinline__ void aoffs_from(const Unit& u, const int (&Rr)[2], const int (&Cc)[2], const unsigned (&)[2][2], unsigned (&a)[2][2]) const { d.aoffs(u, Rr, Cc, a); }
};

template <class Epi, class Sched>
__device__ __forceinline__ void gemm_phase(LAS unsigned char* lds, const bf16* A, const int K, const Sched& S, const Epi& E, const int tid) {
    const int wid = __builtin_amdgcn_readfirstlane(tid >> 6), lane = tid & 63, wr = wid >> 2, wc = wid & 3, fr = lane & 15, fq = lane >> 4;
    const int nt = K / BK;
    int Rr[2], Cc[2]; unsigned voffB[2];
#pragma unroll
    for (int i = 0; i < 2; ++i) { int R, C; stage_rc(tid * 16 + i * 8192, R, C); const int Rb = (R & ~31) + perm32(R & 31); Rr[i] = R; Cc[i] = C; voffB[i] = (unsigned)(Rb * K + C) * 2u; }
    const size_t kstep = (size_t)(BK * 2);
    const size_t hstep = (size_t)HALF * K * 2;
    const unsigned ldsw = (unsigned)wid * 1024u;
    const int aoff = lds_byte(wr * 64 + fr, fq * 8), boff = lds_byte(wc * 32 + fr, fq * 8);
    const char* Ab = (const char*)A;
#define PG8_SA(b, h) (((b) * 2 + (h)) * HTB)
#define PG8_SB(b, h) ((4 + (b) * 2 + (h)) * HTB)
#define PG8_STAGE_B(bufoff, gbase) do { const char* _ub = (const char*)(gbase); asm volatile("" : "+s"(_ub)); _Pragma("unroll") for (int _i = 0; _i < 2; ++_i) \
        __builtin_amdgcn_global_load_lds((const unsigned*)(_ub + voffB[_i]), (LAS unsigned*)(lds + (bufoff) + ldsw + _i * 8192), 16, 0, 0); } while (0)
#define PG8_STAGE_A(bufoff, kb, offs) do { const char* _ub = Ab + (size_t)(kb); asm volatile("" : "+s"(_ub)); _Pragma("unroll") for (int _i = 0; _i < 2; ++_i) \
        __builtin_amdgcn_global_load_lds((const unsigned*)(_ub + (offs)[_i]), (LAS unsigned*)(lds + (bufoff) + ldsw + _i * 8192), 16, 0, 0); } while (0)
#define PG8_LDA(dst, b, h) do { _Pragma("unroll") for (int m = 0; m < 4; ++m) _Pragma("unroll") for (int k = 0; k < 2; ++k) dst[m][k] = *(const LAS bf16x8*)(lds + PG8_SA(b, h) + aoff + m * 2048 + k * 1024); } while (0)
#define PG8_LDB(dst, b, h) do { _Pragma("unroll") for (int n = 0; n < 2; ++n) _Pragma("unroll") for (int k = 0; k < 2; ++k) dst[n][k] = *(const LAS bf16x8*)(lds + PG8_SB(b, h) + boff + n * 2048 + k * 1024); } while (0)
#define PG8_MMA(ai, bj, At, Bt) do { __builtin_amdgcn_s_setprio(1); _Pragma("unroll") for (int m = 0; m < 4; ++m) _Pragma("unroll") for (int n = 0; n < 2; ++n) _Pragma("unroll") for (int k = 0; k < 2; ++k) \
        acc[ai][bj][m][n] = __builtin_amdgcn_mfma_f32_16x16x32_bf16(Bt[n][k], At[m][k], acc[ai][bj][m][n], 0, 0, 0); __builtin_amdgcn_s_setprio(0); } while (0)
#define PG8_WAIT_V(n) asm volatile("s_waitcnt vmcnt(" #n ")" ::: "memory")
#define PG8_WAIT_L(n) asm volatile("s_waitcnt lgkmcnt(" #n ")" ::: "memory")
#define PG8_BAR __builtin_amdgcn_s_barrier()
#define PG8_SCHED __builtin_amdgcn_sched_barrier(0)
    Unit cur, nxt; int ui = 0;
    if (!S.next(0, cur)) return;
    f32x4 acc[2][2][4][2];
#pragma unroll
    for (int a = 0; a < 2; ++a)
#pragma unroll
        for (int b = 0; b < 2; ++b)
#pragma unroll
            for (int m = 0; m < 4; ++m)
#pragma unroll
                for (int n = 0; n < 2; ++n) acc[a][b][m][n] = (f32x4){0.f, 0.f, 0.f, 0.f};
    bf16x8 At[4][2], B0[2][2], B1[2][2];
    unsigned aC[2][2], aN[2][2], rawN[2][2];
    S.aoffs(cur, Rr, Cc, aC);
    const char* cB = S.bbase(cur);
    Unit nn; bool has_next = S.next(1, nxt);
    if (has_next) S.tok_load(nxt, Rr, rawN);
    PG8_STAGE_B(PG8_SB(0, 0), cB); PG8_STAGE_B(PG8_SB(0, 1), cB + hstep); PG8_STAGE_A(PG8_SA(0, 0), 0, aC[0]); PG8_STAGE_A(PG8_SA(0, 1), 0, aC[1]);
    if (wr == 1) PG8_BAR;
    PG8_WAIT_V(2); PG8_BAR;
    PG8_STAGE_B(PG8_SB(1, 0), cB + kstep); PG8_STAGE_A(PG8_SA(1, 0), kstep, aC[0]); PG8_STAGE_B(PG8_SB(1, 1), cB + hstep + kstep);
    PG8_WAIT_V(6); PG8_BAR;
    for (;;) {
        const char* nB = has_next ? S.bbase(nxt) : cB;
        if (has_next) S.aoffs_from(nxt, Rr, Cc, rawN, aN);
        else {
#pragma unroll
            for (int h = 0; h < 2; ++h)
#pragma unroll
                for (int i = 0; i < 2; ++i) aN[h][i] = aC[h][i];
        }
#pragma unroll 1
        for (int t = 0; t < nt; t += 2) {
            const bool last = (t == nt - 2);
            const size_t kb1 = (size_t)(t + 1) * kstep;
            const size_t kb2 = last ? (size_t)0 : (size_t)(t + 2) * kstep, kb3 = kb2 + kstep;
            const char* b2 = last ? nB : cB + (size_t)(t + 2) * kstep; const char* b3 = b2 + kstep;
            unsigned x2[2][2];
#pragma unroll
            for (int h = 0; h < 2; ++h)
#pragma unroll
                for (int i = 0; i < 2; ++i) x2[h][i] = last ? aN[h][i] : aC[h][i];
            PG8_LDB(B0, 0, 0); PG8_LDB(B1, 0, 1); PG8_SCHED; PG8_LDA(At, 0, 0); PG8_STAGE_A(PG8_SA(1, 1), kb1, aC[1]);
            PG8_WAIT_V(8); PG8_WAIT_L(0); PG8_BAR; PG8_MMA(0, 0, At, B0); PG8_MMA(0, 1, At, B1); PG8_BAR; PG8_SCHED;
            PG8_LDA(At, 0, 1); PG8_STAGE_B(PG8_SB(0, 0), b2); PG8_STAGE_B(PG8_SB(0, 1), b2 + hstep); PG8_STAGE_A(PG8_SA(0, 0), kb2, x2[0]);
            PG8_WAIT_V(8); PG8_WAIT_L(0); PG8_BAR; PG8_MMA(1, 0, At, B0); PG8_MMA(1, 1, At, B1); PG8_BAR; PG8_SCHED;
            PG8_LDB(B0, 1, 0); PG8_LDB(B1, 1, 1); PG8_SCHED; PG8_LDA(At, 1, 0); PG8_STAGE_A(PG8_SA(0, 1), kb2, x2[1]);
            PG8_WAIT_V(8); PG8_WAIT_L(0); PG8_BAR; PG8_MMA(0, 0, At, B0); PG8_MMA(0, 1, At, B1); PG8_BAR; PG8_SCHED;
            PG8_LDA(At, 1, 1); PG8_STAGE_B(PG8_SB(1, 0), b3); PG8_STAGE_B(PG8_SB(1, 1), b3 + hstep); PG8_STAGE_A(PG8_SA(1, 0), kb3, x2[0]);
            PG8_WAIT_V(8); PG8_WAIT_L(0); PG8_BAR; PG8_MMA(1, 0, At, B0); PG8_MMA(1, 1, At, B1); PG8_BAR; PG8_SCHED;
        }
        const bool has_nn = has_next && S.next(ui + 2, nn);
        if (has_nn) S.tok_load(nn, Rr, rawN);
        if (wr == 0) PG8_BAR;
        E(acc, cur, wr, wc, fr, fq);
        if (!has_next) break;
#pragma unroll
        for (int a = 0; a < 2; ++a)
#pragma unroll
            for (int b = 0; b < 2; ++b)
#pragma unroll
                for (int m = 0; m < 4; ++m)
#pragma unroll
                    for (int n = 0; n < 2; ++n) acc[a][b][m][n] = (f32x4){0.f, 0.f, 0.f, 0.f};
        cur = nxt; cB = nB; ++ui; nxt = nn; has_next = has_nn;
#pragma unroll
        for (int h = 0; h < 2; ++h)
#pragma unroll
            for (int i = 0; i < 2; ++i) aC[h][i] = aN[h][i];
        if (wr == 1) PG8_BAR;
    }
    PG8_WAIT_V(0);
    PG8_BAR;
#undef PG8_SA
#undef PG8_SB
#undef PG8_STAGE_A
#undef PG8_STAGE_B
#undef PG8_LDA
#undef PG8_LDB
#undef PG8_MMA
#undef PG8_WAIT_V
#undef PG8_WAIT_L
#undef PG8_BAR
#undef PG8_SCHED
}
}

#ifndef ATTN_STORE16
#define ATTN_STORE16(p,v) (*(u32x4*)(p)=(v))
#endif
namespace attn_body {
using bf16=unsigned short;
using bf16x8=__attribute__((ext_vector_type(8)))short;
using s16x4=__attribute__((ext_vector_type(4)))short;
using f32x16=__attribute__((ext_vector_type(16)))float;
using u32x4=__attribute__((ext_vector_type(4)))unsigned;
constexpr int D=64,QP=512,KP=128,OP=1024;
constexpr int NW=8,QBLK=32,QB=QBLK*NW,KVBLK=64;
constexpr int ATTN_UNIT_ROWS=QB;
__device__ __forceinline__ int crow(int r,int hi){return (r&3)+8*(r>>2)+4*hi;}
#define SBAR() __builtin_amdgcn_sched_barrier(0)
constexpr int NSLOT=3, SLOTB=8192;
constexpr int LDS_K=0, LDS_V=NSLOT*SLOTB, LDS_WS=2*NSLOT*SLOTB, LDS_OST=LDS_WS+NW*64*4, LDS_BYTES=LDS_OST+NW*4096;
constexpr float C2=0.125f*1.4426950408889634f;
__device__ __forceinline__ void glds16(const void*sbase,unsigned voff,unsigned lds_dst){unsigned keep;
  asm volatile("s_mov_b32 %0, m0\n\ts_mov_b32 m0, %3\n\ts_nop 0\n\tglobal_load_lds_dwordx4 %1, %2\n\ts_mov_b32 m0, %0":"=&s"(keep):"v"(voff),"s"(sbase),"s"(lds_dst):"memory");}
__device__ __forceinline__ float max3f(float a,float b,float c){float r;asm("v_max3_f32 %0, %1, %2, %3":"=v"(r):"v"(a),"v"(b),"v"(c));return r;}
__device__ __forceinline__ float max2f(float a,float b){float r;asm("v_max_f32_e32 %0, %1, %2":"=v"(r):"v"(a),"v"(b));return r;}
__device__ __forceinline__ float fadd_s(float a,float b){float r;asm("v_add_f32_e32 %0, %1, %2":"=v"(r):"v"(a),"v"(b));return r;}
__device__ __forceinline__ float fsub_s(float a,float b){float r;asm("v_sub_f32_e32 %0, %1, %2":"=v"(r):"v"(a),"v"(b));return r;}
typedef float f32x2_t __attribute__((ext_vector_type(2))); typedef __bf16 bf16x2_t __attribute__((ext_vector_type(2)));
__device__ __forceinline__ unsigned cvtpk_s(float lo,float hi){f32x2_t v={lo,hi};bf16x2_t b=__builtin_convertvector(v,bf16x2_t);return __builtin_bit_cast(unsigned,b);}
#define WAIT_BAR(N) asm volatile("s_waitcnt vmcnt(" #N ") lgkmcnt(0)\n\ts_barrier":::"memory")

__device__ __forceinline__ void qkt(f32x16&p0,f32x16&p1,const char*Kslot,const bf16x8*qr,const f32x16&negm,int r32,int hi){
  const char*kb=Kslot+hi*1024+r32*16;
  #pragma unroll
  for(int d0=0;d0<4;++d0){
    const bf16x8 b0=*reinterpret_cast<const bf16x8*>(kb+d0*2048);
    const bf16x8 b1=*reinterpret_cast<const bf16x8*>(kb+d0*2048+512);
    if(d0==0){p0=__builtin_amdgcn_mfma_f32_32x32x16_bf16(b0,qr[0],negm,0,0,0);p1=__builtin_amdgcn_mfma_f32_32x32x16_bf16(b1,qr[0],negm,0,0,0);}
    else{p0=__builtin_amdgcn_mfma_f32_32x32x16_bf16(b0,qr[d0],p0,0,0,0);p1=__builtin_amdgcn_mfma_f32_32x32x16_bf16(b1,qr[d0],p1,0,0,0);}}
}
typedef __attribute__((address_space(3))) const char* lds_cptr;
typedef short v4i16_t __attribute__((ext_vector_type(4)));
__device__ __forceinline__ void kload8(bf16x8*kf,lds_cptr kp){
  kf[0]=*(const __attribute__((address_space(3))) bf16x8*)(kp);      kf[1]=*(const __attribute__((address_space(3))) bf16x8*)(kp+512);
  kf[2]=*(const __attribute__((address_space(3))) bf16x8*)(kp+2048); kf[3]=*(const __attribute__((address_space(3))) bf16x8*)(kp+2560);
  kf[4]=*(const __attribute__((address_space(3))) bf16x8*)(kp+4096); kf[5]=*(const __attribute__((address_space(3))) bf16x8*)(kp+4608);
  kf[6]=*(const __attribute__((address_space(3))) bf16x8*)(kp+6144); kf[7]=*(const __attribute__((address_space(3))) bf16x8*)(kp+6656);
}
__device__ __forceinline__ void kload2(bf16x8*kf,lds_cptr kp,int j){ kf[2*j]=*(const __attribute__((address_space(3))) bf16x8*)(kp+j*2048); kf[2*j+1]=*(const __attribute__((address_space(3))) bf16x8*)(kp+j*2048+512); }
__device__ __forceinline__ s16x4 vtr(lds_cptr p){ return __builtin_bit_cast(s16x4,__builtin_amdgcn_ds_read_tr16_b64_v4i16((__attribute__((address_space(3))) v4i16_t*)p)); }
__device__ __forceinline__ float rowmax(const f32x16&p0,const f32x16&p1){
  float a=max3f(p0[0],p0[1],p1[0]),b=max3f(p0[2],p0[3],p1[1]);a=max3f(a,p1[2],p1[3]);
  #pragma unroll
  for(int r=4;r<16;r+=4){a=max3f(a,p0[r],p0[r+1]);b=max3f(b,p0[r+2],p0[r+3]);a=max3f(a,p1[r],p1[r+1]);b=max3f(b,p1[r+2],p1[r+3]);}
  const float m=max2f(a,b);
  auto rr=__builtin_amdgcn_permlane32_swap(__float_as_uint(m),__float_as_uint(m),false,false);
  return max2f(__uint_as_float(rr[0]),__uint_as_float(rr[1]));
}
__device__ __forceinline__ void pv(f32x16*o,int vb,bf16x8 pa0,bf16x8 pa1,bf16x8 pa2,bf16x8 pa3){
  #pragma unroll
  for(int d0=0;d0<2;++d0){s16x4 lo[4],hi[4];
    #pragma unroll
    for(int ks=0;ks<4;++ks){
      asm volatile("ds_read_b64_tr_b16 %0,%1 offset:%c2":"=&v"(lo[ks]):"v"(vb),"i"(d0*4096+ks*1024):"memory");
      asm volatile("ds_read_b64_tr_b16 %0,%1 offset:%c2":"=&v"(hi[ks]):"v"(vb),"i"(d0*4096+ks*1024+512):"memory");}
    asm volatile("s_waitcnt lgkmcnt(0)":::"memory");SBAR();
    #define PK(k) (bf16x8){lo[k][0],lo[k][1],lo[k][2],lo[k][3],hi[k][0],hi[k][1],hi[k][2],hi[k][3]}
    o[d0]=__builtin_amdgcn_mfma_f32_32x32x16_bf16(pa0,PK(0),o[d0],0,0,0);
    o[d0]=__builtin_amdgcn_mfma_f32_32x32x16_bf16(pa1,PK(1),o[d0],0,0,0);
    o[d0]=__builtin_amdgcn_mfma_f32_32x32x16_bf16(pa2,PK(2),o[d0],0,0,0);
    o[d0]=__builtin_amdgcn_mfma_f32_32x32x16_bf16(pa3,PK(3),o[d0],0,0,0);
    #undef PK
  }
}

__device__ __forceinline__ unsigned short f2bf_(float x){f32x2_t v={x,0.f};bf16x2_t bb=__builtin_convertvector(v,bf16x2_t);return (unsigned short)(__builtin_bit_cast(unsigned,bb)&0xffffu);}
template<int THRL> __device__ __forceinline__ void attn_unit(const bf16*Qb,const bf16*__restrict__ Kh,const bf16*__restrict__ Vh,bf16*Ob,const int NT,char*shm,const int tid){
  const int lane=tid&63,r32=lane&31,hi=lane>>5; const int wid=__builtin_amdgcn_readfirstlane(tid>>6);
  const bf16*Qw=Qb+(long)(wid*QBLK)*QP;
  const unsigned lds0=(unsigned)(uintptr_t)shm;
  float*wsf=(float*)(shm+LDS_WS)+wid*64;
  const unsigned ksrc=(unsigned)(lane*KP+wid*8)*2u;
  const unsigned vsrc=(unsigned)((16*(wid&3)+(lane>>2))*KP+(wid>>2)*32+(lane&3)*8)*2u;
  const unsigned kdst=lds0+LDS_K+wid*1024, vdst=lds0+LDS_V+wid*1024;
  #define DMA_K(t,slot) glds16(Kh+(long)(t)*KVBLK*KP,ksrc,(unsigned)__builtin_amdgcn_readfirstlane(kdst+(slot)))
  #define DMA_V(t,slot) glds16(Vh+(long)(t)*KVBLK*KP,vsrc,(unsigned)__builtin_amdgcn_readfirstlane(vdst+(slot)))
  const int vb0=(int)(lds0+LDS_V)+((lane>>4)&1)*32+(lane&3)*8+(4*hi+((lane&15)>>2))*64;
  const char*Kbase=shm+LDS_K; bf16x8 kf[8];
  const lds_cptr shm3=(lds_cptr)shm; const lds_cptr kp0=shm3+LDS_K+hi*1024+r32*16; const lds_cptr vp0=shm3+LDS_V+((lane>>4)&1)*32+(lane&3)*8+(4*hi+((lane&15)>>2))*64;
  DMA_K(0,0);DMA_V(0,0);DMA_K(1,SLOTB);
  bf16x8 qr[4];
  #pragma unroll
  for(int d0=0;d0<4;++d0)qr[d0]=*reinterpret_cast<const bf16x8*>(&Qw[(long)r32*QP+d0*16+hi*8]);
  float mhat=0.f,l_reg=0.f;f32x16 o[2];o[0]=f32x16{};o[1]=f32x16{};f32x16 negm=f32x16{};asm volatile("":"+v"(negm));
  #define CMASK(P0,P1,t) do{}while(0)
  bool resc=false;
  #define START(P0,P1) do{ const float rm=rowmax(P0,P1); resc=false; \
    { const float dl=rm; mhat=fadd_s(mhat,dl); \
      _Pragma("unroll") for(int r=0;r<16;++r){P0[r]=fsub_s(P0[r],dl);P1[r]=fsub_s(P1[r],dl);} \
      _Pragma("unroll") for(int r=0;r<16;++r)negm[r]=-mhat; asm volatile("":"+v"(negm)); } \
    _Pragma("unroll") for(int r=0;r<16;++r)P0[r]=__builtin_amdgcn_exp2f(P0[r]); }while(0)
  #define RESC() do{ if(resc){ asm volatile("s_waitcnt lgkmcnt(0)":::"memory"); \
      _Pragma("unroll") for(int d_=0;d_<2;++d_) _Pragma("unroll") for(int r=0;r<16;++r)o[d_][r]*=wsf[crow(r,hi)]; } }while(0)
  f32x16 pA0,pA1,pB0,pB1;
  int sl_prev=0,sl_cur=0,sl_next=SLOTB;
  #define ROT() do{sl_prev=sl_cur;sl_cur=sl_next;sl_next=(sl_next==(NSLOT-1)*SLOTB)?0:sl_next+SLOTB;}while(0)
  DMA_K(2,2*SLOTB);
  WAIT_BAR(3);
  qkt(pA0,pA1,Kbase,qr,negm,r32,hi);asm volatile("s_nop 15\n\ts_nop 7":"+v"(pA0),"+v"(pA1));CMASK(pA0,pA1,0);
  START(pA0,pA1);
  _Pragma("unroll") for(int r=0;r<16;++r)pA1[r]=__builtin_amdgcn_exp2f(pA1[r]);
  WAIT_BAR(0);
  DMA_K(3,0);DMA_V(1,SLOTB);
  ROT();
  kload8(kf,kp0+sl_cur);
  WAIT_BAR(2);
  s16x4 vlo[8],vhi[8]; u32x4 pw0,pw1,pw2,pw3;
  #define PKW(P,B) cvtpk_s(P[B],P[B+1])
  #define PAF(k) __builtin_bit_cast(bf16x8,pw##k)
  #define VFR(i) (bf16x8){vlo[i][0],vlo[i][1],vlo[i][2],vlo[i][3],vhi[i][0],vhi[i][1],vhi[i][2],vhi[i][3]}
  #define PIN(x) asm volatile("":"+v"(x))
  #define MX3(a,b,c) __builtin_fmaxf(__builtin_fmaxf((a),(b)),(c))
  #define GAPA(MF,A0,A1,A2,A3,W0,W1,PW) do{ MF; sacc+=A0; sacc+=A1; sacc+=A2; sacc+=A3; PIN(sacc); W0; W1; PIN(PW); SBAR(); }while(0)
  #define EX(v) __builtin_amdgcn_exp2f(v)
  #define GAPB(MF,X,B) do{ MF; X[B]=EX(X[B]); X[B+1]=EX(X[B+1]); X[B+2]=EX(X[B+2]); X[B+3]=EX(X[B+3]); PIN(X); SBAR(); }while(0)
  #define VRD(i) do{ vlo[i]=vtr(vp_+(((i)>>2)*4096+((i)&3)*1024)); vhi[i]=vtr(vp_+(((i)>>2)*4096+((i)&3)*1024+512)); }while(0)
  #define KRD(G,j) do{ if(G){ kload2(kf,kp0+sl_next,j); SBAR(); } }while(0)
  #define STEP(C0,C1,P0,P1,t,GK,GV,GL) do{ SBAR(); \
    const lds_cptr vp_=vp0+sl_prev; \
    VRD(0); SBAR(); float sacc=(P0[0]+P0[1]); \
    GAPA(C0=__builtin_amdgcn_mfma_f32_32x32x16_bf16(kf[0],qr[0],negm,0,0,0), P0[2],P0[3],P0[4],P0[5],     pw0[0]=PKW(P0,0), pw0[1]=PKW(P0,2), pw0); \
    VRD(4); SBAR(); GAPA(C1=__builtin_amdgcn_mfma_f32_32x32x16_bf16(kf[1],qr[0],negm,0,0,0), P0[6],P0[7],P0[8],P0[9],     pw0[2]=PKW(P0,4), pw0[3]=PKW(P0,6), pw0); \
    VRD(1); SBAR(); GAPA(C0=__builtin_amdgcn_mfma_f32_32x32x16_bf16(kf[2],qr[1],C0,0,0,0),   P0[10],P0[11],P0[12],P0[13], pw1[0]=PKW(P0,8), pw1[1]=PKW(P0,10), pw1); \
    VRD(5); SBAR(); GAPA(C1=__builtin_amdgcn_mfma_f32_32x32x16_bf16(kf[3],qr[1],C1,0,0,0),   P0[14],P0[15],P1[0],P1[1],   pw1[2]=PKW(P0,12),pw1[3]=PKW(P0,14), pw1); \
    VRD(2); SBAR(); GAPA(C0=__builtin_amdgcn_mfma_f32_32x32x16_bf16(kf[4],qr[2],C0,0,0,0),   P1[2],P1[3],P1[4],P1[5],     pw2[0]=PKW(P1,0), pw2[1]=PKW(P1,2), pw2); \
    VRD(6); SBAR(); GAPA(C1=__builtin_amdgcn_mfma_f32_32x32x16_bf16(kf[5],qr[2],C1,0,0,0),   P1[6],P1[7],P1[8],P1[9],     pw2[2]=PKW(P1,4), pw2[3]=PKW(P1,6), pw2); \
    VRD(3); SBAR(); GAPA(C0=__builtin_amdgcn_mfma_f32_32x32x16_bf16(kf[6],qr[3],C0,0,0,0),   P1[10],P1[11],P1[12],P1[13], pw3[0]=PKW(P1,8), pw3[1]=PKW(P1,10), pw3); \
    VRD(7); SBAR(); GAPA(C1=__builtin_amdgcn_mfma_f32_32x32x16_bf16(kf[7],qr[3],C1,0,0,0),   P1[14],P1[15],0.f,0.f,       pw3[2]=PKW(P1,12),pw3[3]=PKW(P1,14), pw3); \
    l_reg+=sacc; \
    if(GK){DMA_K((t)+3,sl_cur);} if(GV){DMA_V((t)+1,sl_next);} \
    CMASK(C0,C1,t); \
    { float a=MX3(C0[0],C0[1],C1[0]),b=MX3(C0[2],C0[3],C1[1]); a=MX3(a,C1[2],C1[3]); \
      _Pragma("unroll") for(int r=4;r<16;r+=4){a=MX3(a,C0[r],C0[r+1]);b=MX3(b,C0[r+2],C0[r+3]);a=MX3(a,C1[r],C1[r+1]);b=MX3(b,C1[r+2],C1[r+3]);} \
      float rm=__builtin_fmaxf(a,b); { auto rr=__builtin_amdgcn_permlane32_swap(__float_as_uint(rm),__float_as_uint(rm),false,false); rm=__builtin_fmaxf(__uint_as_float(rr[0]),__uint_as_float(rr[1])); } \
      resc=false; \
      if(__builtin_expect(__any(rm>(float)THRL),0)){ const float dl=__builtin_fmaxf(rm,0.f); mhat+=dl; \
        _Pragma("unroll") for(int r=0;r<16;++r){C0[r]-=dl;C1[r]-=dl;} \
        _Pragma("unroll") for(int r=0;r<16;++r)negm[r]=-mhat; asm volatile("":"+v"(negm)); \
        const float f=__builtin_amdgcn_exp2f(-dl); l_reg*=f; if(hi==0)wsf[r32]=f; resc=true; } } \
    SBAR(); \
    GAPB(o[0]=__builtin_amdgcn_mfma_f32_32x32x16_bf16(PAF(0),VFR(0),o[0],0,0,0), C0,0); \
    GAPB(o[1]=__builtin_amdgcn_mfma_f32_32x32x16_bf16(PAF(0),VFR(4),o[1],0,0,0), C0,4); \
    KRD(GL,0); GAPB(o[0]=__builtin_amdgcn_mfma_f32_32x32x16_bf16(PAF(1),VFR(1),o[0],0,0,0), C0,8); \
    KRD(GL,1); GAPB(o[1]=__builtin_amdgcn_mfma_f32_32x32x16_bf16(PAF(1),VFR(5),o[1],0,0,0), C0,12); \
    KRD(GL,2); GAPB(o[0]=__builtin_amdgcn_mfma_f32_32x32x16_bf16(PAF(2),VFR(2),o[0],0,0,0), C1,0); \
    KRD(GL,3); GAPB(o[1]=__builtin_amdgcn_mfma_f32_32x32x16_bf16(PAF(2),VFR(6),o[1],0,0,0), C1,4); \
    GAPB(o[0]=__builtin_amdgcn_mfma_f32_32x32x16_bf16(PAF(3),VFR(3),o[0],0,0,0), C1,8); \
    GAPB(o[1]=__builtin_amdgcn_mfma_f32_32x32x16_bf16(PAF(3),VFR(7),o[1],0,0,0), C1,12); \
    }while(0)
  int t=1;
  #undef CMASK
  #define CMASK(P0,P1,t) do{}while(0)
  for(;t+5<NT;t+=2){
    STEP(pB0,pB1,pA0,pA1,t,true,true,true);     WAIT_BAR(2); RESC(); ROT();
    STEP(pA0,pA1,pB0,pB1,t+1,true,true,true);   WAIT_BAR(2); RESC(); ROT();
  }
  #undef CMASK
  #define CMASK(P0,P1,t) do{}while(0)
  #define ENDW(tt) do{ if((tt)+3<NT){WAIT_BAR(2);} else if((tt)+2<NT){WAIT_BAR(1);} else {WAIT_BAR(0);} }while(0)
  for(;t+1<NT;t+=2){
    STEP(pB0,pB1,pA0,pA1,t,(t+3<NT),(t+1<NT),(t+1<NT));       ENDW(t);   RESC(); ROT();
    STEP(pA0,pA1,pB0,pB1,t+1,(t+4<NT),(t+2<NT),(t+2<NT));     ENDW(t+1); RESC(); ROT();
  }
  STEP(pB0,pB1,pA0,pA1,NT-1,false,false,false); RESC();
  { float sacc=pB0[0]+pB0[1]; _Pragma("unroll") for(int r=2;r<16;++r)sacc+=pB0[r]; _Pragma("unroll") for(int r=0;r<16;++r)sacc+=pB1[r]; l_reg+=sacc;
    pw0=(u32x4){PKW(pB0,0),PKW(pB0,2),PKW(pB0,4),PKW(pB0,6)};pw1=(u32x4){PKW(pB0,8),PKW(pB0,10),PKW(pB0,12),PKW(pB0,14)};pw2=(u32x4){PKW(pB1,0),PKW(pB1,2),PKW(pB1,4),PKW(pB1,6)};pw3=(u32x4){PKW(pB1,8),PKW(pB1,10),PKW(pB1,12),PKW(pB1,14)};
    SBAR(); pv(o,vb0+sl_cur,PAF(0),PAF(1),PAF(2),PAF(3)); }
  #undef PKW
  #undef PAF
  #undef VFR
  #undef PIN
  #undef MX3
  #undef GAPA
  #undef GAPB
  #undef EX
  #undef VRD
  #undef KRD
  #undef STEP
  #undef ENDW
  {auto rr=__builtin_amdgcn_permlane32_swap(__float_as_uint(l_reg),__float_as_uint(l_reg),false,false);l_reg=__uint_as_float(rr[0])+__uint_as_float(rr[1]);}
  if(hi==0)wsf[32+r32]=l_reg;asm volatile("s_waitcnt lgkmcnt(0)":::"memory");
  float rli[16];
  #pragma unroll
  for(int r=0;r<16;++r)rli[r]=__builtin_amdgcn_rcpf(wsf[32+crow(r,hi)]);
  bf16*Ow=Ob+(long)(wid*QBLK)*OP;
  { bf16*stg=(bf16*)(shm+LDS_OST)+wid*2048;
    #pragma unroll
    for(int r=0;r<16;++r){const int orow=crow(r,hi);
      #pragma unroll
      for(int d0=0;d0<2;++d0)stg[orow*64+d0*32+r32]=f2bf_(o[d0][r]*rli[r]);}
    asm volatile("s_waitcnt lgkmcnt(0)":::"memory");
    #pragma unroll
    for(int i=0;i<4;++i){const int row=i*8+(lane>>3),ch=lane&7; const u32x4 v=*(const u32x4*)(stg+row*64+ch*8); ATTN_STORE16(Ow+(long)row*OP+ch*8,v);} }
  asm volatile("s_waitcnt lgkmcnt(0)\n\ts_barrier":::"memory");
  #undef DMA_K
  #undef DMA_V
  #undef CMASK
  #undef START
  #undef RESC
  #undef ROT
}
constexpr int ATTN_LDS_BYTES=LDS_BYTES;
#undef SBAR
#undef WAIT_BAR
}

#define XB_TMO      128
#define XB_XCNT(j)  (256  + 64 * (j))
#define XB_XSUB(j)  (1280 + 64 * (j))
#define XB_XGEN(j)  (2304 + 64 * (j))
#define XB_TOP      3328
#define XB_TOPGEN   3392
#define XCD_BAR_WORDS 3456
#define XB_SPIN_CAP (1u << 22)
__device__ __forceinline__ unsigned xb_ld(unsigned* p)              { return __hip_atomic_load(p, __ATOMIC_RELAXED, __HIP_MEMORY_SCOPE_AGENT); }
__device__ __forceinline__ unsigned xb_add(unsigned* p, unsigned v) { return __hip_atomic_fetch_add(p, v, __ATOMIC_RELAXED, __HIP_MEMORY_SCOPE_AGENT); }
__device__ __forceinline__ unsigned xb_xcc_id() { return (unsigned)__builtin_amdgcn_s_getreg((3 << 11) | 20) & 0xFu; }
#define XB_SPIN(cond, bar) do { unsigned _sp = 0; while (cond) { __builtin_amdgcn_s_sleep(1); \
    if ((++_sp & 255u) == 0u) { if (xb_ld(&(bar)[XB_TMO])) break; if (_sp > XB_SPIN_CAP) { atomicAdd(&(bar)[XB_TMO], 1u); break; } } } } while (0)
struct XcdBarrier { unsigned* bar; unsigned x; volatile LAS unsigned* st; };
__device__ __forceinline__ XcdBarrier xcd_barrier_post(unsigned* bar, volatile LAS unsigned* st, const int tid) {
    XcdBarrier b; b.bar = bar; b.x = xb_xcc_id(); b.st = st;
    if (tid == 0) (void)xb_add(&bar[XB_XCNT(b.x)], 1u);
    return b;
}
__device__ __forceinline__ void xcd_barrier_complete(unsigned* bar, unsigned x, unsigned& nloc, unsigned& nx) {
    const unsigned G = gridDim.x * gridDim.y * gridDim.z;
    unsigned sum, cnt, mine, sp = 0u;
    for (;;) {
        sum = 0u; cnt = 0u; mine = 0u;
#pragma unroll
        for (unsigned j = 0; j < 16; ++j) { const unsigned c = xb_ld(&bar[XB_XCNT(j)]); sum += c; cnt += (c > 0u) ? 1u : 0u; mine = (j == x) ? c : mine; }
        if (sum == G) break;
        __builtin_amdgcn_s_sleep(1);
        if ((++sp & 255u) == 0u) { if (xb_ld(&bar[XB_TMO])) break; if (sp > XB_SPIN_CAP) { atomicAdd(&bar[XB_TMO], 1u); break; } }
    }
    nloc = mine > 0u ? mine : 1u; nx = cnt > 0u ? cnt : 1u;
}
__device__ __forceinline__ void xcd_barrier(const XcdBarrier& b, const int tid) {
    asm volatile("s_waitcnt vmcnt(0)" ::: "memory");
    __syncthreads();
    if (tid == 0) {
        unsigned* bar = b.bar;
        __builtin_amdgcn_s_waitcnt(0);
        unsigned nloc = b.st[0], nx = b.st[1];
        if (nloc == 0u) { xcd_barrier_complete(bar, b.x, nloc, nx); b.st[0] = nloc; b.st[1] = nx; }
        const unsigned old = xb_add(&bar[XB_XSUB(b.x)], 1u);
        const unsigned gen = old / nloc;
        if (old + 1u == (gen + 1u) * nloc) {
            __builtin_amdgcn_fence(__ATOMIC_RELEASE, "agent");
            asm volatile("s_waitcnt vmcnt(0)" ::: "memory");
            const unsigned og = xb_add(&bar[XB_TOP], 1u);
            const unsigned tg = og / nx;
            if (og + 1u == (tg + 1u) * nx) xb_add(&bar[XB_TOPGEN], 1u);
            else XB_SPIN(xb_ld(&bar[XB_TOPGEN]) == tg, bar);
            __builtin_amdgcn_fence(__ATOMIC_ACQUIRE, "agent");
            xb_add(&bar[XB_XGEN(b.x)], 1u);
            asm volatile("s_waitcnt vmcnt(0)" ::: "memory");
        } else {
            XB_SPIN(xb_ld(&bar[XB_XGEN(b.x)]) == gen, bar);
            __builtin_amdgcn_fence(__ATOMIC_ACQUIRE, "agent");
            asm volatile("s_waitcnt vmcnt(0)" ::: "memory");
        }
    }
    __syncthreads();
}

struct Args { const float* in[24]; float* out; unsigned char* ws; int ph_lo, ph_hi, dry, pad; };
struct Frame {
    LAS unsigned char* lds;
    unsigned char* ldsg;
    volatile LAS unsigned* MISC;
    unsigned* ctl;
    unsigned char* ws; float* out; float* xw; const float* const* in;
    int tid, lane, wave, G, gw, NGW;
};
__device__ __forceinline__ const float* inp(const float* p) { unsigned long long v = (unsigned long long)p; asm volatile("" : "+s"(v)); return (const float*)(const GAS float*)v; }
#define F_x (inp(F.in[0]))
#define F_c (inp(F.in[1]))
#define F_ctx (inp(F.in[2]))
#define F_c_ctx (inp(F.in[3]))
#define F_w_mod (inp(F.in[4]))
#define F_b_mod (inp(F.in[5]))
#define F_g_mix (inp(F.in[6]))
#define F_g_ffn (inp(F.in[7]))
#define F_ev_w_in (inp(F.in[8]))
#define F_ev_qg (inp(F.in[9]))
#define F_ev_kg (inp(F.in[10]))
#define F_ev_dw_w (inp(F.in[11]))
#define F_ev_dw_b (inp(F.in[12]))
#define F_ev_ln_g (inp(F.in[13]))
#define F_ev_ln_b (inp(F.in[14]))
#define F_ev_w_out (inp(F.in[15]))
#define F_od_w_in (inp(F.in[16]))
#define F_od_conv_w (inp(F.in[17]))
#define F_od_w_out (inp(F.in[18]))
#define F_router_w (inp(F.in[19]))
#define F_router_b (inp(F.in[20]))
#define F_w_gate (inp(F.in[21]))
#define F_w_up (inp(F.in[22]))
#define F_w_down (inp(F.in[23]))
#define F_MOD    ((float*)(F.ws + WS_MOD))
#define F_ROPE   ((f32x2*)(F.ws + WS_ROPE))
#define F_RT     ((u32x4*)(F.ws + WS_RT))
#define F_ROWTOK ((unsigned*)(F.ws + WS_ROWTOK))
#define F_Z      ((float*)(F.ws + WS_Z))
#define F_W_EVIN  ((bf16*)(F.ws + WS_W_EVIN))
#define F_W_EVOUT ((bf16*)(F.ws + WS_W_EVOUT))
#define F_W_ODIN  ((bf16*)(F.ws + WS_W_ODIN))
#define F_W_ODOUT ((bf16*)(F.ws + WS_W_ODOUT))
#define F_W_MOE1  ((bf16*)(F.ws + WS_W_MOE1))
#define F_W_MOE2  ((bf16*)(F.ws + WS_W_MOE2))
#define F_HB   ((bf16*)(F.ws + WS_HB))
#define F_CAT  ((bf16*)(F.ws + WS_CAT))
#define F_OX   ((bf16*)(F.ws + WS_OX))
#define F_HMID ((bf16*)(F.ws + WS_HMID))
#define F_Y    ((bf16*)(F.ws + WS_Y))
#define F_Q    ((bf16*)(F.ws + WS_Q))
#define F_KB   ((bf16*)(F.ws + WS_K))
#define F_VB   ((bf16*)(F.ws + WS_V))
#define F_AG   ((bf16*)(F.ws + WS_AG))
#define F_SB   ((bf16*)(F.ws + WS_S))
#define F_U    ((bf16*)(F.ws + WS_U))
#define F_GB   ((bf16*)(F.ws + WS_GB))
__device__ __forceinline__ bool ctx_in_l(int l) { return l <= 2; }
__device__ __forceinline__ bool ctx_out_l(int l) { return l < 2; }

__device__ __forceinline__ int rowmap(int n, int mode) {
    if (mode == 0) return n;
    if (mode == 1 || mode == 2) return 256 * (n >> 7) + (n & 127) + (mode == 2 ? 128 : 0);
    if (mode == 3) {
        if (n < 768) { const int d = n & 63, hh = (n >> 6) & 3; return (n & ~255) + 128 * (d >> 5) + 32 * hh + (d & 31); }
        if (n < 1280) { const int o = n - 768; return 768 + 256 * (o >> 7) + (o & 127); }
        const int o = n - 1280; return 768 + 256 * (o >> 7) + 128 + (o & 127);
    }
    if (n < 1024) return 2048 + n;
    if (n < 2048) { const int o = n - 1024; return 256 * (o >> 7) + (o & 127); }
    { const int o = n - 2048; return 256 * (o >> 7) + 128 + (o & 127); }
}
struct TItem { const float* W; bf16* WT; int K, N, mode, k0, n0; };
__device__ __forceinline__ void titem_set(TItem& t, const float* W, int K, int N, bf16* WT, int mode, int item) { const int nblk = N >> 6; t.W = W; t.WT = WT; t.K = K; t.N = N; t.mode = mode; t.k0 = 64 * (item / nblk); t.n0 = 64 * (item % nblk); }
__device__ __forceinline__ void titem_load(const TItem& t, f32x4 (&v)[16], int lane) {
    const float* p = t.W + (size_t)(t.k0 + (lane >> 4)) * t.N + t.n0 + (lane & 15) * 4;
#pragma unroll
    for (int i = 0; i < 16; ++i) v[i] = __builtin_nontemporal_load((const f32x4*)(p + (size_t)(4 * i) * t.N));
}
__device__ __forceinline__ void titem_store(const TItem& t, const f32x4 (&v)[16], float* scr, int lane) {
#pragma unroll
    for (int i = 0; i < 16; ++i) { const int kk = (lane >> 4) + 4 * i; *(f32x4*)(scr + kk * 64 + (((lane & 15) * 4) ^ (4 * ((kk >> 3) & 7)))) = v[i]; }
    LDS_WAIT(); asm volatile("" ::: "memory");
    const int kc = lane & 7;
#pragma unroll
    for (int j = 0; j < 8; ++j) { const int n = (lane >> 3) + 8 * j; const float* sp = scr + (8 * kc) * 64 + (n ^ (4 * kc));
        u32x4 o; o.x = pk2(sp[0 * 64], sp[1 * 64]); o.y = pk2(sp[2 * 64], sp[3 * 64]); o.z = pk2(sp[4 * 64], sp[5 * 64]); o.w = pk2(sp[6 * 64], sp[7 * 64]);
        *(u32x4*)(t.WT + (size_t)rowmap(t.n0 + n, t.mode) * t.K + t.k0 + 8 * kc) = o; }
    LDS_WAIT(); asm volatile("" ::: "memory");
}
__device__ __forceinline__ void mod_unit(Frame& F, int u) {
    const int l = u / 24, cg = u % 24;
    float* act = (float*)F.ldsg;
    float* red = (float*)(F.ldsg + 36864);
    for (int idx = F.tid; idx < 9 * 1024; idx += NTHR) { const int r = idx >> 10, k = idx & 1023; const float v = (r < 8) ? F_c[r * 1024 + k] : F_c_ctx[k]; act[idx] = v / (1.0f + __expf(-v)); }
    __syncthreads();
    const float* W = F_w_mod + (size_t)l * 1024 * 6144 + cg * 256 + F.lane * 4;
    float acc[9][4];
#pragma unroll
    for (int r = 0; r < 9; ++r)
#pragma unroll
        for (int j = 0; j < 4; ++j) acc[r][j] = 0.f;
    const int k0 = F.wave * 128;
#pragma unroll 16
    for (int kk = 0; kk < 128; ++kk) { const int k = k0 + kk; const f32x4 w = __builtin_nontemporal_load((const f32x4*)(W + (size_t)k * 6144));
#pragma unroll
        for (int r = 0; r < 9; ++r) { const float a = act[r * 1024 + k]; acc[r][0] += a * w[0]; acc[r][1] += a * w[1]; acc[r][2] += a * w[2]; acc[r][3] += a * w[3]; } }
#pragma unroll
    for (int r = 0; r < 9; ++r) *(f32x4*)(red + (F.wave * 9 + r) * 256 + F.lane * 4) = (f32x4){acc[r][0], acc[r][1], acc[r][2], acc[r][3]};
    __syncthreads();
    for (int idx = F.tid; idx < 9 * 256; idx += NTHR) { const int r = idx >> 8, cc = idx & 255; float s = F_b_mod[l * 6144 + cg * 256 + cc];
#pragma unroll
        for (int w = 0; w < 8; ++w) s += red[(w * 9 + r) * 256 + cc];
        F_MOD[(size_t)(l * 9 + r) * 6144 + cg * 256 + cc] = s; }
    __syncthreads();
}
__device__ __forceinline__ void prologue(Frame& F) {
    for (int u = blockIdx.x; u < 96; u += F.G) mod_unit(F, u);
    for (int idx = blockIdx.x * NTHR + F.tid; idx < 128 * 16; idx += F.G * NTHR) { const int pos = idx >> 4, j = idx & 15;
        const float inv = __builtin_amdgcn_exp2f(-(float)j * (13.287712379549449f / 16.0f)); const float ang = (float)pos * inv;
        F_ROPE[idx] = (f32x2){__cosf(ang), __sinf(ang)}; }
    if (blockIdx.x == 0) { for (int i = F.tid; i < D / 2; i += NTHR) ((unsigned*)(F_HB + (size_t)ZROW * D))[i] = 0u; }
    float* scr = (float*)(F.ldsg + F.wave * 16384);
    constexpr int I_EVIN = 16 * (EVIN / 64), I_SQ = 16 * 16, I_ODIN = 16 * (ODIN / 64), I_GU = 16 * 8, I_DN = 8 * 16;
    constexpr int NSMALL = 2 * I_EVIN + 2 * I_SQ + 2 * I_ODIN + 2 * I_SQ;
    constexpr int NITEMS = NSMALL + 64 * (2 * I_GU + I_DN);
#define TDECODE(it, t) do { int r = (it); \
        if (r < 2 * I_EVIN) { const int i = r / I_EVIN; titem_set(t, F_ev_w_in + (size_t)i * D * EVIN, D, EVIN, F_W_EVIN + (size_t)i * EVIN * D, 3, r % I_EVIN); break; } r -= 2 * I_EVIN; \
        if (r < 2 * I_SQ) { const int i = r / I_SQ; titem_set(t, F_ev_w_out + (size_t)i * D * D, D, D, F_W_EVOUT + (size_t)i * D * D, 0, r % I_SQ); break; } r -= 2 * I_SQ; \
        if (r < 2 * I_ODIN) { const int i = r / I_ODIN; titem_set(t, F_od_w_in + (size_t)i * D * ODIN, D, ODIN, F_W_ODIN + (size_t)i * ODIN * D, 4, r % I_ODIN); break; } r -= 2 * I_ODIN; \
        if (r < 2 * I_SQ) { const int i = r / I_SQ; titem_set(t, F_od_w_out + (size_t)i * D * D, D, D, F_W_ODOUT + (size_t)i * D * D, 0, r % I_SQ); break; } r -= 2 * I_SQ; \
        { constexpr int PER = 2 * I_GU + I_DN; const int le = r / PER; int q = r % PER; \
          if (q < I_GU) { titem_set(t, F_w_gate + (size_t)le * D * DE, D, DE, F_W_MOE1 + (size_t)le * D * D, 1, q); break; } q -= I_GU; \
          if (q < I_GU) { titem_set(t, F_w_up + (size_t)le * D * DE, D, DE, F_W_MOE1 + (size_t)le * D * D, 2, q); break; } q -= I_GU; \
          titem_set(t, F_w_down + (size_t)le * DE * D, DE, D, F_W_MOE2 + (size_t)le * D * DE, 0, q); } } while (0)
    int it = F.gw;
    if (it < NITEMS) {
        TItem cur, nxt; f32x4 va[16], vb[16];
        TDECODE(it, cur); titem_load(cur, va, F.lane);
        for (;;) {
            const int itn = it + F.NGW; const bool more = itn < NITEMS;
            if (more) { TDECODE(itn, nxt); titem_load(nxt, vb, F.lane); }
            titem_store(cur, va, scr, F.lane);
            if (!more) break;
            cur = nxt; it = itn;
#pragma unroll
            for (int i = 0; i < 16; ++i) va[i] = vb[i];
        }
    }
#undef TDECODE
}

constexpr int NR = 4;
__device__ __forceinline__ void norm1_phase(Frame& F, int l, bool fin) {
    const int nrows = NLAT + ((!fin && ctx_in_l(l)) ? NCTX : 0);
    const int nch = nrows / NR;
    int pstartv = 0;
    if (l > 0) { const int c = (F.lane < 16) ? (int)__hip_atomic_load(F.ctl + CW_CNT + ((l - 1) * 16 + F.lane) * 64, __ATOMIC_RELAXED, __HIP_MEMORY_SCOPE_AGENT) : 0; const int p = (c + 255) & ~255; int incl = p;
#pragma unroll
        for (int o = 1; o < 16; o <<= 1) { const int t = __shfl_up(incl, o); if (F.lane >= o) incl += t; }
        pstartv = incl - p; }
    for (int ch = F.gw; ch < nch; ch += F.NGW) {
        const int r0 = ch * NR; const bool isz = r0 >= NLAT; const int b = isz ? 8 : (r0 >> 13);
        const float* src; float* dst;
        if (!isz) { src = (l == 0 ? F_x : F.out) + (size_t)r0 * D; dst = F.xw + (size_t)r0 * D; }
        else { const int j = r0 - NLAT; src = (l == 0 ? F_ctx : F_Z) + (size_t)j * D; dst = F_Z + (size_t)j * D; }
        f32x4 v[NR][4];
#pragma unroll
        for (int j = 0; j < NR; ++j)
#pragma unroll
            for (int q = 0; q < 4; ++q) v[j][q] = __builtin_nontemporal_load((const f32x4*)(src + (size_t)j * D + F.lane * 4 + 256 * q));
        if (l > 0) {
            u32x2 dd[NR]; float w0[NR], w1[NR];
#pragma unroll
            for (int j = 0; j < NR; ++j) { const u32x4 rt = F_RT[r0 + j]; w0[j] = __uint_as_float(rt.z); w1[j] = __uint_as_float(rt.w);
                const int e0 = __builtin_amdgcn_readfirstlane((int)(rt.x & 15u)), e1 = __builtin_amdgcn_readfirstlane((int)(rt.y & 15u));
                dd[j].x = (unsigned)__builtin_amdgcn_readlane(pstartv, e0) + (rt.x >> 4); dd[j].y = (unsigned)__builtin_amdgcn_readlane(pstartv, e1) + (rt.y >> 4); }
            const float* gate = F_MOD + (size_t)((l - 1) * 9 + b) * 6144 + 5 * 1024;
            f32x4 g[4];
#pragma unroll
            for (int q = 0; q < 4; ++q) g[q] = *(const f32x4*)(gate + F.lane * 4 + 256 * q);
            u32x2 ya[NR][4], yb[NR][4];
#pragma unroll
            for (int j = 0; j < NR; ++j)
#pragma unroll
                for (int q = 0; q < 4; ++q) { const int col = F.lane * 4 + 256 * q; ya[j][q] = __builtin_nontemporal_load((const u32x2*)(F_Y + (size_t)dd[j].x * D + col)); yb[j][q] = __builtin_nontemporal_load((const u32x2*)(F_Y + (size_t)dd[j].y * D + col)); }
#pragma unroll
            for (int j = 0; j < NR; ++j)
#pragma unroll
                for (int q = 0; q < 4; ++q) { const int col = F.lane * 4 + 256 * q; const u32x2 a = ya[j][q], bq = yb[j][q];
                    v[j][q][0] += g[q][0] * (w0[j] * bflo(a.x) + w1[j] * bflo(bq.x)); v[j][q][1] += g[q][1] * (w0[j] * bfhi(a.x) + w1[j] * bfhi(bq.x));
                    v[j][q][2] += g[q][2] * (w0[j] * bflo(a.y) + w1[j] * bflo(bq.y)); v[j][q][3] += g[q][3] * (w0[j] * bfhi(a.y) + w1[j] * bfhi(bq.y));
                    __builtin_nontemporal_store(v[j][q], (f32x4*)(dst + (size_t)j * D + col)); }
        }
        if (!fin) {
            float rstd[NR];
#pragma unroll
            for (int j = 0; j < NR; ++j) { float ss = 0.f;
#pragma unroll
                for (int q = 0; q < 4; ++q) ss += (v[j][q][0] * v[j][q][0] + v[j][q][1] * v[j][q][1]) + (v[j][q][2] * v[j][q][2] + v[j][q][3] * v[j][q][3]);
                rstd[j] = __builtin_amdgcn_rsqf(wave_sum(ss) * (1.0f / D) + EPS); }
            const float* gm = F_g_mix + l * D; const float* sh = F_MOD + (size_t)(l * 9 + b) * 6144; const float* sc = sh + 1024;
#pragma unroll
            for (int q = 0; q < 4; ++q) { const int col = F.lane * 4 + 256 * q; const f32x4 g = *(const f32x4*)(gm + col), s = *(const f32x4*)(sh + col), cc = *(const f32x4*)(sc + col);
                const f32x4 A = g * (cc + 1.0f);
#pragma unroll
                for (int j = 0; j < NR; ++j) { const f32x4 h = v[j][q] * rstd[j] * A + s;
                    *(u32x2*)(F_HB + (size_t)(r0 + j) * D + col) = (u32x2){pk2(h[0], h[1]), pk2(h[2], h[3])}; } }
        }
    }
}

__device__ __forceinline__ void norm2_phase(Frame& F, int l) {
    float* RWT = (float*)F.ldsg;
    unsigned* wcnt = (unsigned*)(F.ldsg + 65536);
    for (int idx = F.tid; idx < 4096; idx += NTHR) { const f32x4 w = *(const f32x4*)(F_router_w + idx * 4); const int col = idx >> 2, e0 = (idx & 3) * 4;
        RWT[(e0 + 0) * 1024 + col] = w[0]; RWT[(e0 + 1) * 1024 + col] = w[1]; RWT[(e0 + 2) * 1024 + col] = w[2]; RWT[(e0 + 3) * 1024 + col] = w[3]; }
    float rb[16];
#pragma unroll
    for (int e = 0; e < 16; ++e) rb[e] = F_router_b[e];
    __syncthreads();
    unsigned cnt = 0u;
    unsigned* wbase = (unsigned*)(F.ldsg + 66048);
    u32x4* stash = (u32x4*)(F.ldsg + 66560) + F.wave * 96; int nst = 0;
    const int nrows = NLAT + (ctx_out_l(l) ? NCTX : 0);
    const int nch = nrows / NR;
    for (int ch = F.gw; ch < nch; ch += F.NGW) {
        const int r0 = ch * NR; const bool isz = r0 >= NLAT; const int b = isz ? 8 : (r0 >> 13);
        const float* src; float* dst;
        if (!isz) { src = (l == 0 ? F_x : F.out) + (size_t)r0 * D; dst = F.xw + (size_t)r0 * D; }
        else { const int j = r0 - NLAT; src = (l == 0 ? F_ctx : F_Z) + (size_t)j * D; dst = F_Z + (size_t)j * D; }
        const float* mrow = F_MOD + (size_t)(l * 9 + b) * 6144;
        f32x4 v[NR][4]; u32x2 ox[NR][4];
#pragma unroll
        for (int j = 0; j < NR; ++j)
#pragma unroll
            for (int q = 0; q < 4; ++q) { const int col = F.lane * 4 + 256 * q; v[j][q] = __builtin_nontemporal_load((const f32x4*)(src + (size_t)j * D + col)); ox[j][q] = __builtin_nontemporal_load((const u32x2*)(F_OX + (size_t)(r0 + j) * D + col)); }
        float rstd[NR];
        {
            f32x4 g[4];
#pragma unroll
            for (int q = 0; q < 4; ++q) g[q] = *(const f32x4*)(mrow + 2 * 1024 + F.lane * 4 + 256 * q);
#pragma unroll
            for (int j = 0; j < NR; ++j) { float ss = 0.f;
#pragma unroll
                for (int q = 0; q < 4; ++q) { const u32x2 o = ox[j][q];
                    v[j][q][0] += g[q][0] * bflo(o.x); v[j][q][1] += g[q][1] * bfhi(o.x); v[j][q][2] += g[q][2] * bflo(o.y); v[j][q][3] += g[q][3] * bfhi(o.y);
                    __builtin_nontemporal_store(v[j][q], (f32x4*)(dst + (size_t)j * D + F.lane * 4 + 256 * q));
                    ss += (v[j][q][0] * v[j][q][0] + v[j][q][1] * v[j][q][1]) + (v[j][q][2] * v[j][q][2] + v[j][q][3] * v[j][q][3]); }
                rstd[j] = __builtin_amdgcn_rsqf(wave_sum(ss) * (1.0f / D) + EPS); }
        }
        const float* gf = F_g_ffn + l * D;
#pragma unroll
        for (int q = 0; q < 4; ++q) { const int col = F.lane * 4 + 256 * q; const f32x4 g = *(const f32x4*)(gf + col), s = *(const f32x4*)(mrow + 3 * 1024 + col), cc = *(const f32x4*)(mrow + 4 * 1024 + col);
            const f32x4 A = g * (cc + 1.0f);
#pragma unroll
            for (int j = 0; j < NR; ++j) { v[j][q] = v[j][q] * rstd[j] * A + s;
                *(u32x2*)(F_HB + (size_t)(r0 + j) * D + col) = (u32x2){pk2(v[j][q][0], v[j][q][1]), pk2(v[j][q][2], v[j][q][3])}; } }
        float lg[NR * 16];
#pragma unroll
        for (int i = 0; i < NR * 16; ++i) lg[i] = 0.f;
#pragma unroll
        for (int q = 0; q < 4; ++q) { const int col = F.lane * 4 + 256 * q;
#pragma unroll
            for (int e = 0; e < 16; ++e) { const f32x4 w = *(const f32x4*)(RWT + e * 1024 + col);
#pragma unroll
                for (int j = 0; j < NR; ++j) { float t_ = lg[j * 16 + e]; t_ = __builtin_fmaf(v[j][q][0], w[0], t_); t_ = __builtin_fmaf(v[j][q][1], w[1], t_); t_ = __builtin_fmaf(v[j][q][2], w[2], t_); t_ = __builtin_fmaf(v[j][q][3], w[3], t_); lg[j * 16 + e] = t_; }
                if ((e & 3) == 3) asm volatile("" ::: "memory"); } }
#define RS_STEP(N, MASK) do { const bool up_ = (F.lane & (MASK)) != 0; _Pragma("unroll") for (int k = 0; k < (N) / 2; ++k) { const float a_ = lg[k], b_ = lg[k + (N) / 2]; \
            const float send_ = up_ ? a_ : b_, keep_ = up_ ? b_ : a_; lg[k] = keep_ + __shfl_xor(send_, (MASK)); } } while (0)
        RS_STEP(64, 32); RS_STEP(32, 16); RS_STEP(16, 8); RS_STEP(8, 4); RS_STEP(4, 2); RS_STEP(2, 1);
#undef RS_STEP
        const float myv = lg[0];
        float lx[16];
#pragma unroll
        for (int e = 0; e < 16; ++e) lx[e] = __shfl(myv, (F.lane & 48) | e);
        float aff[16], sel[16];
#pragma unroll
        for (int e = 0; e < 16; ++e) { aff[e] = sigmoidf_(lx[e]); sel[e] = aff[e] + rb[e]; }
        float gs[4];
#pragma unroll
        for (int g = 0; g < 4; ++g) { const float a = sel[4 * g], bb = sel[4 * g + 1], c = sel[4 * g + 2], d = sel[4 * g + 3];
            const float hi1 = fmaxf(a, bb), lo1 = fminf(a, bb), hi2 = fmaxf(c, d), lo2 = fminf(c, d);
            gs[g] = fmaxf(hi1, hi2) + fmaxf(fminf(hi1, hi2), fmaxf(lo1, lo2)); }
        int grp = 0; float best = gs[0];
#pragma unroll
        for (int g = 1; g < 4; ++g) if (gs[g] > best) { best = gs[g]; grp = g; }
        float si[4], ai[4];
#pragma unroll
        for (int k = 0; k < 4; ++k) { si[k] = grp == 0 ? sel[k] : grp == 1 ? sel[4 + k] : grp == 2 ? sel[8 + k] : sel[12 + k]; ai[k] = grp == 0 ? aff[k] : grp == 1 ? aff[4 + k] : grp == 2 ? aff[8 + k] : aff[12 + k]; }
        int i0 = 0; float b0 = si[0];
#pragma unroll
        for (int k = 1; k < 4; ++k) if (si[k] > b0) { b0 = si[k]; i0 = k; }
        int i1 = -1; float b1 = -1e30f;
#pragma unroll
        for (int k = 0; k < 4; ++k) if (k != i0 && si[k] > b1) { b1 = si[k]; i1 = k; }
        const float a0 = i0 == 0 ? ai[0] : i0 == 1 ? ai[1] : i0 == 2 ? ai[2] : ai[3];
        const float a1 = i1 == 0 ? ai[0] : i1 == 1 ? ai[1] : i1 == 2 ? ai[2] : ai[3];
        const float inv = fast_rcp(a0 + a1);
        const int e0 = grp * 4 + i0, e1 = grp * 4 + i1;
        unsigned mylr0 = 0u, mylr1 = 0u;
#pragma unroll
        for (int j = 0; j < NR; ++j) {
            const int e0j = __builtin_amdgcn_readlane(e0, 16 * j), e1j = __builtin_amdgcn_readlane(e1, 16 * j);
            const unsigned lr0 = __builtin_amdgcn_readlane(cnt, e0j); cnt += (F.lane == e0j) ? 1u : 0u;
            const unsigned lr1 = __builtin_amdgcn_readlane(cnt, e1j); cnt += (F.lane == e1j) ? 1u : 0u;
            if ((F.lane >> 4) == j) { mylr0 = lr0; mylr1 = lr1; }
        }
        if ((F.lane & 15) == 0) stash[nst + (F.lane >> 4)] = (u32x4){(unsigned)e0 | (mylr0 << 4), (unsigned)e1 | (mylr1 << 4), __float_as_uint(a0 * inv), __float_as_uint(a1 * inv)};
        nst += NR;
    }
    if (F.lane < 16) wcnt[F.wave * 16 + F.lane] = cnt;
    __syncthreads();
    if (F.tid < 16) { const int e = F.tid; unsigned tot = 0u, pre[8];
#pragma unroll
        for (int w = 0; w < 8; ++w) { pre[w] = tot; tot += wcnt[w * 16 + e]; }
        const unsigned base = __hip_atomic_fetch_add(F.ctl + CW_CNT + (l * 16 + e) * 64, tot, __ATOMIC_RELAXED, __HIP_MEMORY_SCOPE_AGENT);
#pragma unroll
        for (int w = 0; w < 8; ++w) wbase[w * 16 + e] = base + pre[w]; }
    __syncthreads();
    for (int i = F.lane; i < nst; i += 64) { const u32x4 st = stash[i]; const int ci = i >> 2, j = i & 3; const unsigned tok = (unsigned)((F.gw + ci * F.NGW) * NR + j);
        const unsigned e0 = st.x & 15u, e1 = st.y & 15u; const unsigned rk0 = wbase[F.wave * 16 + e0] + (st.x >> 4), rk1 = wbase[F.wave * 16 + e1] + (st.y >> 4);
        F_ROWTOK[(size_t)e0 * VCAP + rk0] = tok; F_ROWTOK[(size_t)e1 * VCAP + rk1] = tok;
        F_RT[tok] = (u32x4){e0 | (rk0 << 4), e1 | (rk1 << 4), st.z, st.w}; }
    __syncthreads();
}

__device__ __forceinline__ int moe_prefix(Frame& F, int l, LAS int* pend, LAS int* pstart, LAS int* pcnt) {
    if (F.tid < 64) {
        const int c = (F.lane < 16) ? (int)__hip_atomic_load(F.ctl + CW_CNT + (l * 16 + F.lane) * 64, __ATOMIC_RELAXED, __HIP_MEMORY_SCOPE_AGENT) : 0;
        const int p = (c + 255) & ~255; int incl = p;
#pragma unroll
        for (int o = 1; o < 16; o <<= 1) { const int t = __shfl_up(incl, o); if (F.lane >= o) incl += t; }
        if (F.lane < 16) { pend[F.lane] = incl; pstart[F.lane] = incl - p; pcnt[F.lane] = c; }
    }
    __syncthreads();
    return __builtin_amdgcn_readfirstlane(pend[15] >> 8);
}

__device__ __forceinline__ void attn_phase(Frame& F, int l) {
    const int bx = blockIdx.x; const int vcu = (F.G % 8 == 0) ? (bx % 8) * (F.G / 8) + bx / 8 : bx;
    char* shm = (char*)F.ldsg;
    for (int U = vcu; U < NB * NH * (SEQ / 256); U += F.G) {
        const int h = U >> 8, b = (U & 255) >> 5, qb = U & 31;
        const size_t qrow = (size_t)b * SEQ + (size_t)qb * 256;
        attn_body::attn_unit<8>(F_Q + qrow * AW + h * 64, F_KB + (size_t)b * KVS * KVW + (h >> 2) * 64, F_VB + (size_t)b * KVS * KVW + (h >> 2) * 64, F_CAT + qrow * D + h * 64, KVS / 64, shm, F.tid);
    }
    if (ctx_out_l(l)) {
        for (int V = vcu; V < 8 * 32; V += F.G) {
            const int b = V >> 5, h = V & 31; if (h >= NH) continue;
            const size_t qrow = (size_t)NLAT + (size_t)b * CTXL; const size_t kv0 = (size_t)b * KVS + SEQ;
            attn_body::attn_unit<8>(F_Q + qrow * AW + h * 64, F_KB + kv0 * KVW + (h >> 2) * 64, F_VB + kv0 * KVW + (h >> 2) * 64, F_CAT + qrow * D + h * 64, CTXL / 64, shm, F.tid);
        }
    }
}
__device__ __forceinline__ float cv_ld(const bf16* AG, int s0, int len, int p, int ch) {
    const bool ok = p >= 0 && p < len; const int pc = p < 0 ? 0 : (p >= len ? len - 1 : p);
    const bf16* rp = AG + (size_t)(s0 + pc) * CAW; asm volatile("" : "+s"(rp));
    const float v = __uint_as_float((unsigned)((const GAS bf16*)rp)[ch] << 16);
    return ok ? v : 0.f;
}
__device__ __forceinline__ void conv_unit(Frame& F, const float* dw, const float* db, const float* lg, const float* lb, int s0, int len, int t0, int nchunk) {
    const int ch = F.wave * 64 + F.lane;
    float* ytile = (float*)F.ldsg;
    float w[31];
#pragma unroll
    for (int k = 0; k < 31; ++k) w[k] = dw[k * CAW + ch];
    const float bias = db[ch];
    const bf16* agb = F_AG;
#define CV_LD(p) cv_ld(agb, s0, len, (p), ch)
    float lo[32], hi[32];
#pragma unroll
    for (int i = 0; i < 32; ++i) { lo[i] = CV_LD(t0 - 16 + i); hi[i] = CV_LD(t0 + 16 + i); }
    const f32x4 g0 = *(const f32x4*)(lg + F.lane * 4), g1 = *(const f32x4*)(lg + 256 + F.lane * 4), b0 = *(const f32x4*)(lb + F.lane * 4), b1 = *(const f32x4*)(lb + 256 + F.lane * 4);
    for (int c = 0; c < nchunk; ++c) {
        const int T = t0 + 32 * c;
        float* yb = ytile + (c & 1) * (32 * 512);
#pragma unroll
        for (int u = 0; u < 32; ++u) { float acc = bias;
#pragma unroll
            for (int k = 0; k < 31; ++k) { const int e = u + k + 1; acc += w[k] * (e < 32 ? lo[e & 31] : hi[e & 31]); }
            yb[u * 512 + ch] = acc; }
#pragma unroll
        for (int i = 0; i < 32; ++i) { lo[i] = hi[i]; hi[i] = CV_LD(T + 48 + i); }
        __syncthreads();
#pragma unroll
        for (int rr = 0; rr < 4; ++rr) { const int u = F.wave * 4 + rr; const size_t row = (size_t)s0 + T + u;
            f32x4 y0 = *(const f32x4*)(yb + u * 512 + F.lane * 4), y1 = *(const f32x4*)(yb + u * 512 + 256 + F.lane * 4);
            const float mean = wave_sum((y0[0] + y0[1]) + (y0[2] + y0[3]) + (y1[0] + y1[1]) + (y1[2] + y1[3])) * (1.0f / CAW);
            y0 = y0 - mean; y1 = y1 - mean;
            const float rstd = __builtin_amdgcn_rsqf(wave_sum((y0[0] * y0[0] + y0[1] * y0[1]) + (y0[2] * y0[2] + y0[3] * y0[3]) + (y1[0] * y1[0] + y1[1] * y1[1]) + (y1[2] * y1[2] + y1[3] * y1[3])) * (1.0f / CAW) + EPS);
            y0 = y0 * rstd * g0 + b0; y1 = y1 * rstd * g1 + b1;
            *(u32x2*)(F_CAT + row * D + AW + F.lane * 4) = (u32x2){pk2(siluf_(y0[0]), siluf_(y0[1])), pk2(siluf_(y0[2]), siluf_(y0[3]))};
            *(u32x2*)(F_CAT + row * D + AW + 256 + F.lane * 4) = (u32x2){pk2(siluf_(y1[0]), siluf_(y1[1])), pk2(siluf_(y1[2]), siluf_(y1[3]))}; }
    }
#undef CV_LD
    __syncthreads();
}
__device__ __forceinline__ void conv_phase(Frame& F, int l) {
    const int i = l >> 1;
    const float* dw = F_ev_dw_w + (size_t)i * 31 * CAW; const float* db = F_ev_dw_b + i * CAW; const float* lg = F_ev_ln_g + i * CAW; const float* lb = F_ev_ln_b + i * CAW;
    const int nu = NLAT / 128 + (ctx_out_l(l) ? NCTX / 128 : 0);
    for (int U = blockIdx.x; U < nu; U += F.G) {
        int s0, len, t0;
        if (U < NLAT / 128) { s0 = (U >> 6) * SEQ; len = SEQ; t0 = (U & 63) * 128; } else { const int V = U - NLAT / 128; s0 = NLAT + (V >> 1) * CTXL; len = CTXL; t0 = (V & 1) * 128; }
        conv_unit(F, dw, db, lg, lb, s0, len, t0, 4);
    }
}
__device__ __forceinline__ void sconv_phase(Frame& F, int l) {
    const int i = l >> 1; const int nrows = NLAT + (ctx_out_l(l) ? NCTX : 0);
    const float* cw = F_od_conv_w + (size_t)i * 3 * D;
    const int c0 = F.lane * 8, c1 = 512 + F.lane * 8;
    f32x4 w[3][4];
#pragma unroll
    for (int k = 0; k < 3; ++k) { w[k][0] = *(const f32x4*)(cw + k * D + c0); w[k][1] = *(const f32x4*)(cw + k * D + c0 + 4); w[k][2] = *(const f32x4*)(cw + k * D + c1); w[k][3] = *(const f32x4*)(cw + k * D + c1 + 4); }
    for (int r = F.gw * 2; r < nrows; r += F.NGW * 2) {
        int s0, len; if (r < NLAT) { s0 = r & ~(SEQ - 1); len = SEQ; } else { s0 = NLAT + ((r - NLAT) & ~255); len = CTXL; }
        const int pos = r - s0;
        u32x4 uu[4][2], gb[2][2];
#pragma unroll
        for (int k = 0; k < 4; ++k) { const int p = pos + k - 1; const int pc = p < 0 ? 0 : (p >= len ? len - 1 : p); const bf16* ur = F_U + (size_t)(s0 + pc) * D;
            uu[k][0] = __builtin_nontemporal_load((const u32x4*)(ur + c0)); uu[k][1] = __builtin_nontemporal_load((const u32x4*)(ur + c1)); }
#pragma unroll
        for (int j = 0; j < 2; ++j) { gb[j][0] = __builtin_nontemporal_load((const u32x4*)(F_GB + (size_t)(r + j) * D + c0)); gb[j][1] = __builtin_nontemporal_load((const u32x4*)(F_GB + (size_t)(r + j) * D + c1)); }
        float uf[4][16];
#pragma unroll
        for (int k = 0; k < 4; ++k) { const int p = pos + k - 1; const bool ok = p >= 0 && p < len; unpack8(uu[k][0], uf[k]); unpack8(uu[k][1], uf[k] + 8);
            if (!ok) {
#pragma unroll
                for (int c = 0; c < 16; ++c) uf[k][c] = 0.f; } }
#pragma unroll
        for (int j = 0; j < 2; ++j) { float g[16], y[16]; unpack8(gb[j][0], g); unpack8(gb[j][1], g + 8);
#pragma unroll
            for (int c = 0; c < 16; ++c) { const int q = c >> 2, e = c & 3; y[c] = g[c] * (w[0][q][e] * uf[j][c] + w[1][q][e] * uf[j + 1][c] + w[2][q][e] * uf[j + 2][c]); }
            *(u32x4*)(F_SB + (size_t)(r + j) * D + c0) = pack8(y); *(u32x4*)(F_SB + (size_t)(r + j) * D + c1) = pack8(y + 8); }
    }
}

#ifndef PROBE
#define PROBE (-1)
#endif
#ifndef ONLY
#define ONLY (-1)
#endif
constexpr int PPL = 9, NPH = 1 + DEPTH * PPL + 1;
__global__ void __launch_bounds__(NTHR, 2) fwd(Args args) {
    extern __shared__ __attribute__((aligned(16))) unsigned char lds_[];
    Frame F;
    F.lds = (LAS unsigned char*)lds_; F.ldsg = lds_;
    F.MISC = (volatile LAS unsigned*)(F.lds + MISC_OFF);
    F.tid = threadIdx.x; F.lane = F.tid & 63; F.wave = __builtin_amdgcn_readfirstlane(F.tid >> 6);
    const int wave0 = F.wave;
#define MY_TID() (wave0 * 64 + (int)__builtin_amdgcn_mbcnt_hi(~0u, __builtin_amdgcn_mbcnt_lo(~0u, opaque_zero())))
    F.G = gridDim.x; F.gw = blockIdx.x * NWAVES + F.wave; F.NGW = F.G * NWAVES;
    F.ws = args.ws; F.ctl = (unsigned*)(args.ws + WS_CTL); F.out = args.out; F.in = args.in;
    for (int u = F.tid; u < (LDS_BYTES - LDSCTL_OFF) / 4; u += NTHR) ((LAS unsigned*)(F.lds + LDSCTL_OFF))[u] = 0u;
    __syncthreads();
    const int lo = args.ph_lo, hi = args.ph_hi;
    const int bar_off = args.dry ? 16384 : CW_BAR;
    XcdBarrier bar; bar.bar = F.ctl + bar_off; bar.x = 0; bar.st = F.MISC + 8;
    if (hi - lo > 1) bar = xcd_barrier_post(F.ctl + bar_off, F.MISC + 8, F.tid);
#define IN(k) (lo <= (k) && (k) < hi)
#define EN(id) (ONLY < 0 || ONLY == (id))
#define PH(id, k) for (int rp_ = 0; rp_ < ((PROBE == (id)) ? 2 : 1); ++rp_) if (EN(id) && IN(k))
#define PB() do { if (rp_) __syncthreads(); int t_ = MY_TID(); asm volatile("" : "+v"(t_)); F.tid = t_; F.lane = t_ & 63; F.wave = __builtin_amdgcn_readfirstlane(t_ >> 6); F.gw = blockIdx.x * NWAVES + F.wave; \
    F.ws = args.ws; F.in = args.in; F.out = args.out; { unsigned long long w_ = rfl64((unsigned long long)F.ws), o_ = rfl64((unsigned long long)F.out); asm volatile("" : "+s"(w_), "+s"(o_)); w_ = rfl64(w_); o_ = rfl64(o_); F.ws = (unsigned char*)(GAS unsigned char*)w_; F.out = (float*)(GAS float*)o_; F.xw = args.dry ? (float*)(F.ws + WS_Q) : F.out; } F.ctl = (unsigned*)(F.ws + WS_CTL); } while (0)
#define SEAM(k) do { if (IN(k) && IN((k) + 1)) { unsigned long long b_ = rfl64((unsigned long long)((unsigned*)(args.ws + WS_CTL) + bar_off)); asm volatile("" : "+s"(b_)); bar.bar = (unsigned*)(GAS unsigned*)rfl64(b_); xcd_barrier(bar, MY_TID()); if (PROBE == 200) xcd_barrier(bar, MY_TID()); } } while (0)

#if PROBE >= 300 && PROBE < 400
    {
        int rp_ = 0; PB();
        float* dstp = (float*)(F.ws + WS_P);
        const float* srcp = (const float*)(F.ws + WS_Q);
#if PROBE == 300
        for (int ch = F.gw; ch < NLAT / 4; ch += F.NGW) { f32x4 v[4][4];
#pragma unroll
            for (int j = 0; j < 4; ++j)
#pragma unroll
                for (int q = 0; q < 4; ++q) v[j][q] = __builtin_nontemporal_load((const f32x4*)(srcp + (size_t)(ch * 4 + j) * D + F.lane * 4 + 256 * q));
#pragma unroll
            for (int j = 0; j < 4; ++j)
#pragma unroll
                for (int q = 0; q < 4; ++q) __builtin_nontemporal_store(v[j][q], (f32x4*)(dstp + (size_t)(ch * 4 + j) * D + F.lane * 4 + 256 * q)); }
#elif PROBE == 301
        for (int ch = F.gw; ch < NLAT / 8; ch += F.NGW) { f32x4 v[8][4];
#pragma unroll
            for (int j = 0; j < 8; ++j)
#pragma unroll
                for (int q = 0; q < 4; ++q) v[j][q] = __builtin_nontemporal_load((const f32x4*)(srcp + (size_t)(ch * 8 + j) * D + F.lane * 4 + 256 * q));
#pragma unroll
            for (int j = 0; j < 8; ++j)
#pragma unroll
                for (int q = 0; q < 4; ++q) __builtin_nontemporal_store(v[j][q], (f32x4*)(dstp + (size_t)(ch * 8 + j) * D + F.lane * 4 + 256 * q)); }
#elif PROBE == 302
        for (int ch = F.gw; ch < NLAT / 4; ch += F.NGW) { f32x4 v[4][4];
#pragma unroll
            for (int j = 0; j < 4; ++j)
#pragma unroll
                for (int q = 0; q < 4; ++q) v[j][q] = *(const f32x4*)(srcp + (size_t)(ch * 4 + j) * D + F.lane * 4 + 256 * q);
#pragma unroll
            for (int j = 0; j < 4; ++j)
#pragma unroll
                for (int q = 0; q < 4; ++q) *(f32x4*)(dstp + (size_t)(ch * 4 + j) * D + F.lane * 4 + 256 * q) = v[j][q]; }
#elif PROBE == 303
        { f32x4 acc = {0.f, 0.f, 0.f, 0.f};
        for (int ch = F.gw; ch < NLAT / 4; ch += F.NGW) { f32x4 v[4][4];
#pragma unroll
            for (int j = 0; j < 4; ++j)
#pragma unroll
                for (int q = 0; q < 4; ++q) v[j][q] = __builtin_nontemporal_load((const f32x4*)(srcp + (size_t)(ch * 4 + j) * D + F.lane * 4 + 256 * q));
#pragma unroll
            for (int j = 0; j < 4; ++j)
#pragma unroll
                for (int q = 0; q < 4; ++q) acc += v[j][q]; }
        *(f32x4*)(dstp + (size_t)F.gw * 256 + F.lane * 4) = acc; }
#endif
        __syncthreads();
    }
#endif
    PH(100, 0) { PB(); prologue(F); }
    SEAM(0);
    for (int l = 0; l < DEPTH; ++l) {
        const int pb = 1 + l * PPL; const bool even = !(l & 1); const int li = l >> 1;
        for (int rp_ = 0; rp_ < ((PROBE == 10 && l == 0) ? 2 : 1); ++rp_) if (EN(10) && IN(pb + 0)) { PB(); norm1_phase(F, l, false); }
        SEAM(pb + 0);
        PH(1, pb + 1) {
            PB();
            if (even) {
                pg8::EvenInOrder S; S.d.init(NLAT, EVIN, D, F_W_EVIN + (size_t)li * EVIN * D, F.G, (int)blockIdx.x); S.kvonly = !ctx_out_l(l);
                pg8::EpiEvenIn E{F_Q, F_KB, F_VB, F_AG, F_ev_qg + li * 64, F_ev_kg + li * 64, F_ROPE};
                pg8::gemm_phase<pg8::EpiEvenIn, pg8::EvenInOrder>(F.lds, F_HB, D, S, E, F.tid);
            } else {
                const int M = NLAT + (ctx_out_l(l) ? NCTX : 0);
                pg8::DenseOrder S; S.init(M, ODIN, D, F_W_ODIN + (size_t)li * ODIN * D, F.G, (int)blockIdx.x);
                pg8::EpiOddIn E{F_U, F_GB};
                pg8::gemm_phase<pg8::EpiOddIn, pg8::DenseOrder>(F.lds, F_HB, D, S, E, F.tid);
            }
        }
        if (IN(pb + 1) && IN(pb + 3)) { unsigned long long b_ = rfl64((unsigned long long)((unsigned*)(args.ws + WS_CTL) + bar_off)); asm volatile("" : "+s"(b_)); bar.bar = (unsigned*)(GAS unsigned*)rfl64(b_); xcd_barrier(bar, MY_TID()); if (PROBE == 200) xcd_barrier(bar, MY_TID()); }
        if (even) {
            PH(30, pb + 3) { PB(); attn_phase(F, l); }
            PH(31, pb + 3) { PB(); conv_phase(F, l); }
        } else {
            PH(32, pb + 3) { PB(); sconv_phase(F, l); }
        }
        SEAM(pb + 3);
        PH(4, pb + 4) {
            PB();
            const int M = NLAT + (ctx_out_l(l) ? NCTX : 0);
            pg8::DenseOrder S; S.init(M, D, D, even ? F_W_EVOUT + (size_t)li * D * D : F_W_ODOUT + (size_t)li * D * D, F.G, (int)blockIdx.x);
            pg8::EpiPlain E{F_OX, D};
            pg8::gemm_phase<pg8::EpiPlain, pg8::DenseOrder>(F.lds, even ? F_CAT : F_SB, D, S, E, F.tid);
        }
        SEAM(pb + 4);
        PH(5, pb + 5) { PB(); norm2_phase(F, l); }
        if (IN(pb + 5) && IN(pb + 7)) { unsigned long long b_ = rfl64((unsigned long long)((unsigned*)(args.ws + WS_CTL) + bar_off)); asm volatile("" : "+s"(b_)); bar.bar = (unsigned*)(GAS unsigned*)rfl64(b_); xcd_barrier(bar, MY_TID()); }
        PH(7, pb + 7) {
            PB();
            LAS int* pend = (LAS int*)(F.lds + LDSCTL_OFF); LAS int* pstart = pend + 16; LAS int* pcnt = pend + 32;
            const int nblk = moe_prefix(F, l, pend, pstart, pcnt);
            pg8::MoeOrder<true> S; S.nblk = nblk; S.G = F.G; S.c = (F.G % 8 == 0) ? (int)((blockIdx.x % 8) * (F.G / 8) + blockIdx.x / 8) : (int)blockIdx.x;     S.K = D; S.Bt = F_W_MOE1 + (size_t)l * NE * D * D; S.estride = (size_t)D * D * 2; S.pend = pend; S.rowtok = F_ROWTOK;
            pg8::EpiSwiGLU E{F_HMID};
            pg8::gemm_phase<pg8::EpiSwiGLU, pg8::MoeOrder<true>>(F.lds, F_HB, D, S, E, F.tid);
        }
        SEAM(pb + 7);
        PH(8, pb + 8) {
            PB();
            LAS int* pend = (LAS int*)(F.lds + LDSCTL_OFF); LAS int* pstart = pend + 16; LAS int* pcnt = pend + 32;
            const int nblk = moe_prefix(F, l, pend, pstart, pcnt);
            pg8::MoeOrder<false> S; S.nblk = nblk; S.G = F.G; S.c = (F.G % 8 == 0) ? (int)((blockIdx.x % 8) * (F.G / 8) + blockIdx.x / 8) : (int)blockIdx.x;     S.K = DE; S.Bt = F_W_MOE2 + (size_t)l * NE * D * DE; S.estride = (size_t)D * DE * 2; S.pend = pend; S.rowtok = nullptr;
            pg8::EpiPlain E{F_Y, D};
            pg8::gemm_phase<pg8::EpiPlain, pg8::MoeOrder<false>>(F.lds, F_HMID, DE, S, E, F.tid);
        }
        SEAM(pb + 8);
    }
    PH(11, NPH - 1) { PB(); norm1_phase(F, DEPTH, true); }
#undef IN
#undef SEAM
}

extern "C" void kernel_launch(void* const* d_in, const int* in_sizes, int n_in, void* d_out, int out_size, void* d_ws, size_t ws_size, hipStream_t stream) {
    static int grid = 0;
    if (grid == 0) {
        if (n_in != 24 || in_sizes[0] != NLAT * D || out_size != NLAT * D || ws_size < WS_END) { fprintf(stderr, "kernel_launch: unexpected shapes (n_in %d, in0 %d, out %d, ws %zu); nothing launched\n", n_in, n_in > 0 ? in_sizes[0] : -1, out_size, ws_size); grid = -1; return; }
        int dev = 0, cus = 0, per_cu = 0;
        if (hipGetDevice(&dev) != hipSuccess || hipDeviceGetAttribute(&cus, hipDeviceAttributeMultiprocessorCount, dev) != hipSuccess) { grid = -1; return; }
        if (hipFuncSetAttribute((const void*)fwd, hipFuncAttributeMaxDynamicSharedMemorySize, LDS_BYTES) != hipSuccess) { fprintf(stderr, "kernel_launch: hipFuncSetAttribute failed\n"); grid = -1; return; }
        if (hipOccupancyMaxActiveBlocksPerMultiprocessor(&per_cu, (const void*)fwd, NTHR, LDS_BYTES) != hipSuccess || per_cu < 1) fprintf(stderr, "kernel_launch: occupancy query reports %d\n", per_cu);
        (void)hipGetLastError();
        grid = cus;
    }
    if (grid < 0) return;
    if (hipMemsetAsync((char*)d_ws + WS_CTL, 0, CTL_ZERO_BYTES, stream) != hipSuccess) return;
    Args a{};
    for (int i = 0; i < 24; ++i) a.in[i] = (const float*)d_in[i];
    a.out = (float*)d_out; a.ws = (unsigned char*)d_ws;
#if MK_ONE_LAUNCH
#if defined(PROBE_CUM)
    a.ph_lo = 0; a.ph_hi = PROBE_CUM;
    hipLaunchKernelGGL(fwd, dim3(grid), dim3(NTHR), LDS_BYTES, stream, a);
    if (hipMemsetAsync((char*)d_ws + WS_CTL, 0, CTL_ZERO_BYTES, stream) != hipSuccess) return;
#endif
    a.ph_lo = 0; a.ph_hi = NPH;
    hipLaunchKernelGGL(fwd, dim3(grid), dim3(NTHR), LDS_BYTES, stream, a);
#if defined(PROBE_DRY)
#ifndef PROBE_DRY_N
#define PROBE_DRY_N 1
#endif
    a.ph_lo = PROBE_DRY; a.ph_hi = PROBE_DRY + PROBE_DRY_N; a.dry = 1;
    hipLaunchKernelGGL(fwd, dim3(grid), dim3(NTHR), LDS_BYTES, stream, a);
#endif
#else
    for (int p = 0; p < NPH; ++p) {
        if (p >= 1 && p < NPH - 1) { const int l = (p - 1) / PPL, k = (p - 1) % PPL; (void)l; if (k == 2 || k == 6) continue; }
        a.ph_lo = p; a.ph_hi = p + 1;
        hipLaunchKernelGGL(fwd, dim3(grid), dim3(NTHR), LDS_BYTES, stream, a);
    }
#endif
}
```

```cpp
#include <hip/hip_runtime.h>
#include <cstdio>
#include <cstdint>

#ifndef MK_ONE_LAUNCH
#define MK_ONE_LAUNCH 1
#endif

#define LAS __attribute__((address_space(3)))
#define GAS __attribute__((address_space(1)))
typedef unsigned short bf16;
typedef short bf16x8 __attribute__((ext_vector_type(8)));
typedef float f32x4 __attribute__((ext_vector_type(4)));
typedef float f32x2 __attribute__((ext_vector_type(2)));
typedef unsigned u32x4 __attribute__((ext_vector_type(4)));
typedef unsigned u32x2 __attribute__((ext_vector_type(2)));
typedef __bf16 bf16x2_t __attribute__((ext_vector_type(2)));

constexpr int D = 1024, NB = 8, SEQ = 8192, NLAT = NB * SEQ, CTXL = 256, NCTX = NB * CTXL, TALL = NLAT + NCTX, ZROW = TALL;
constexpr int KVS = SEQ + CTXL;
constexpr int NH = 8, NKVH = 2, HD = 64, AW = 512, KVW = 128, CAW = 512, EVIN = 1792, ODIN = 3072;
constexpr int NE = 16, DE = 512, MAXBLK = 544, MAXROWS = MAXBLK * 256, VCAP = 2 * TALL;
constexpr int DEPTH = 4;
constexpr float EPS = 1e-6f;
constexpr float C2 = 0.125f * 1.4426950408889634f;

constexpr size_t MiB = 1u << 20;
constexpr size_t WS_CTL = 0, CTL_ZERO_BYTES = 128 * 1024;
constexpr size_t WS_MOD = 1 * MiB;
constexpr size_t WS_ROPE = 2 * MiB;
constexpr size_t WS_RT = 3 * MiB;
constexpr size_t WS_DEST = 5 * MiB;
constexpr size_t WS_WB = 6 * MiB;
constexpr size_t WS_ROWTOK = 931 * MiB;
constexpr size_t WS_Z = 8 * MiB;
constexpr size_t WS_W_EVIN = 16 * MiB, WS_W_EVOUT = 23 * MiB, WS_W_ODIN = 27 * MiB, WS_W_ODOUT = 39 * MiB, WS_W_MOE1 = 43 * MiB, WS_W_MOE2 = 171 * MiB;
constexpr size_t WS_HB = 236 * MiB;
constexpr size_t WS_BIG = 369 * MiB;
constexpr size_t WS_P = WS_BIG, WS_CAT = WS_BIG, WS_OX = 501 * MiB, WS_HMID = WS_BIG, WS_Y = 505 * MiB;
constexpr size_t WS_Q = 765 * MiB, WS_K = 831 * MiB, WS_V = 848 * MiB, WS_AG = 865 * MiB, WS_S = 765 * MiB;
constexpr size_t WS_U = WS_BIG, WS_GB = 633 * MiB;
constexpr size_t WS_END = 940 * MiB;
constexpr int CW_TMO = 0, CW_CODE = 1, CW_BAR = 4096, CW_CNT = 8192;

constexpr int RING_BYTES = 131072, LDSCTL_OFF = RING_BYTES, MISC_OFF = LDSCTL_OFF + 320, LDS_BYTES = 147456;
constexpr int NWAVES = 8, NTHR = 512;

__device__ __forceinline__ unsigned pk2(float lo, float hi) { f32x2 v = {lo, hi}; bf16x2_t b = __builtin_convertvector(v, bf16x2_t); return __builtin_bit_cast(unsigned, b); }
__device__ __forceinline__ float bflo(unsigned w) { return __uint_as_float(w << 16); }
__device__ __forceinline__ float bfhi(unsigned w) { return __uint_as_float(w & 0xffff0000u); }
__device__ __forceinline__ void unpack8(const u32x4 w, float* f) { f[0] = bflo(w.x); f[1] = bfhi(w.x); f[2] = bflo(w.y); f[3] = bfhi(w.y); f[4] = bflo(w.z); f[5] = bfhi(w.z); f[6] = bflo(w.w); f[7] = bfhi(w.w); }
__device__ __forceinline__ u32x4 pack8(const float* f) { u32x4 w; w.x = pk2(f[0], f[1]); w.y = pk2(f[2], f[3]); w.z = pk2(f[4], f[5]); w.w = pk2(f[6], f[7]); return w; }
__device__ __forceinline__ float wave_sum(float v) {
#pragma unroll
    for (int o = 1; o < 64; o <<= 1) v += __shfl_xor(v, o);
    return v;
}
__device__ __forceinline__ float fast_exp2(float x) { return __builtin_amdgcn_exp2f(x); }
__device__ __forceinline__ float fast_rcp(float x) { return __builtin_amdgcn_rcpf(x); }
__device__ __forceinline__ float sigmoidf_(float x) { return fast_rcp(1.0f + fast_exp2(-1.4426950408889634f * x)); }
__device__ __forceinline__ float siluf_(float x) { return x * sigmoidf_(x); }
__device__ __forceinline__ unsigned opaque_zero() { unsigned z = 0u; asm volatile("" : "+v"(z)); return z; }
__device__ __forceinline__ unsigned long long rfl64(unsigned long long v) { const unsigned lo = __builtin_amdgcn_readfirstlane((unsigned)v), hi = __builtin_amdgcn_readfirstlane((unsigned)(v >> 32)); return ((unsigned long long)hi << 32) | lo; }
#define LDS_WAIT() asm volatile("s_waitcnt lgkmcnt(0)" ::: "memory")

namespace pg8 {
constexpr int BM = 256, BK = 64, HALF = 128, HTB = HALF * BK * 2, STAGE_BYTES = 8 * HTB, NXCD = 8, WGM = 8;
__host__ __device__ __forceinline__ int lds_byte(int r, int c) { const int st = (r >> 4) * 2 + (c >> 5), rr = r & 15, cc = c & 31, ob = rr * 64 + cc * 2; return st * 1024 + (ob ^ (((ob >> 9) & 1) << 5)); }
__host__ __device__ __forceinline__ void stage_rc(int b, int& R, int& C) { const int st = b / 1024, sb = b % 1024, swz = sb ^ (((sb >> 9) & 1) << 5); R = (st >> 1) * 16 + swz / 64; C = (st & 1) * 32 + (swz % 64) / 2; }
__host__ __device__ __forceinline__ int perm32(int rho) { const int n = rho >> 4, i = rho & 15; return 8 * (i >> 2) + 4 * n + (i & 3); }

struct Unit { int pm, pn, e; };

struct DenseOrder {
    int nM, nN, nwg, G, c, K; const bf16* Bt;
    __device__ void init(int M, int N, int K_, const bf16* Bt_, int G_, int c_) { nM = M / BM; nN = N / BM; nwg = nM * nN; G = G_; c = c_; K = K_; Bt = Bt_; }
    __device__ bool next(int i, Unit& u) const {
        const long L = (long)i * G + c; if (L >= nwg) return false;
        int wgid = (int)L; { const int q = nwg / NXCD, r = nwg % NXCD, xcd = wgid % NXCD, off = wgid / NXCD; wgid = (xcd < r ? xcd * (q + 1) : r * (q + 1) + (xcd - r) * q) + off; }
        const int nig = WGM * nN, gid = wgid / nig, fm = gid * WGM, gsz = (nM - fm) < WGM ? (nM - fm) : WGM;
        u.pm = fm + ((wgid % nig) % gsz); u.pn = (wgid % nig) / gsz; u.e = 0; return true;
    }
    __device__ __forceinline__ const char* bbase(const Unit& u) const { return (const char*)Bt + (size_t)u.pn * 256 * K * 2; }
    __device__ __forceinline__ void aoffs(const Unit& u, const int (&Rr)[2], const int (&Cc)[2], unsigned (&a)[2][2]) const {
#pragma unroll
        for (int h = 0; h < 2; ++h)
#pragma unroll
            for (int i = 0; i < 2; ++i) a[h][i] = (unsigned)((u.pm * 256 + h * 128 + Rr[i]) * K + Cc[i]) * 2u;
    }
    __device__ __forceinline__ void tok_load(const Unit&, const int (&)[2], unsigned (&)[2][2]) const {}
    __device__ __forceinline__ void aoffs_from(const Unit& u, const int (&Rr)[2], const int (&Cc)[2], const unsigned (&)[2][2], unsigned (&a)[2][2]) const { aoffs(u, Rr, Cc, a); }
};
template <bool GATHER> struct MoeOrder {
    int nblk, G, c, K; const bf16* Bt; size_t estride; const LAS int* pend; const unsigned* rowtok;
    __device__ bool next(int i, Unit& u) const {
        const long L = (long)i * G + c; if (L >= (long)nblk * 4) return false;
        u.pm = (int)(L >> 2); u.pn = (int)(L & 3); const int r0 = u.pm * 256; int e = 0;
#pragma unroll
        for (int j = 0; j < 15; ++j) e += (r0 >= pend[j]) ? 1 : 0;
        u.e = __builtin_amdgcn_readfirstlane(e); return true;
    }
    __device__ __forceinline__ const char* bbase(const Unit& u) const { return (const char*)Bt + (size_t)u.e * estride + (size_t)u.pn * 256 * K * 2; }
    __device__ __forceinline__ void tok_load(const Unit& u, const int (&Rr)[2], unsigned (&raw)[2][2]) const {
#pragma unroll
        for (int h = 0; h < 2; ++h)
#pragma unroll
            for (int i = 0; i < 2; ++i) { const int row = u.pm * 256 + h * 128 + Rr[i];
                raw[h][i] = GATHER ? rowtok[(size_t)u.e * VCAP + (row - pend[16 + u.e])] : (unsigned)row; }
    }
    __device__ __forceinline__ void aoffs_from(const Unit& u, const int (&Rr)[2], const int (&Cc)[2], const unsigned (&raw)[2][2], unsigned (&a)[2][2]) const {
#pragma unroll
        for (int h = 0; h < 2; ++h)
#pragma unroll
            for (int i = 0; i < 2; ++i) { unsigned src = raw[h][i];
                if (GATHER) { const int rin = u.pm * 256 + h * 128 + Rr[i] - pend[16 + u.e]; src = rin < pend[32 + u.e] ? src : (unsigned)ZROW; }
                a[h][i] = (src * (unsigned)K + (unsigned)Cc[i]) * 2u; }
    }
    __device__ __forceinline__ void aoffs(const Unit& u, const int (&Rr)[2], const int (&Cc)[2], unsigned (&a)[2][2]) const { unsigned raw[2][2]; tok_load(u, Rr, raw); aoffs_from(u, Rr, Cc, raw, a); }
};

struct EpiPlain {
    bf16* O; int ldc;
    __device__ __forceinline__ void operator()(const f32x4 (&acc)[2][2][4][2], const Unit& u, int wr, int wc, int fr, int fq) const {
        const int row0 = u.pm * BM + wr * 64 + fr, col0 = u.pn * BM + wc * 32 + 8 * fq;
#pragma unroll
        for (int ai = 0; ai < 2; ++ai)
#pragma unroll
            for (int m = 0; m < 4; ++m) { bf16* rowp = O + (size_t)(row0 + ai * HALF + m * 16) * ldc + col0;
#pragma unroll
                for (int bj = 0; bj < 2; ++bj) { const f32x4 v0 = acc[ai][bj][m][0], v1 = acc[ai][bj][m][1];
                    u32x4 w; w.x = pk2(v0[0], v0[1]); w.y = pk2(v0[2], v0[3]); w.z = pk2(v1[0], v1[1]); w.w = pk2(v1[2], v1[3]);
                    *(u32x4*)(rowp + bj * HALF) = w; } }
    }
};
struct EpiSwiGLU {
    bf16* H;
    __device__ __forceinline__ void operator()(const f32x4 (&acc)[2][2][4][2], const Unit& u, int wr, int wc, int fr, int fq) const {
        const int row0 = u.pm * BM + wr * 64 + fr, col0 = u.pn * 128 + wc * 32 + 8 * fq;
#pragma unroll
        for (int ai = 0; ai < 2; ++ai)
#pragma unroll
            for (int m = 0; m < 4; ++m) { bf16* rowp = H + (size_t)(row0 + ai * HALF + m * 16) * DE + col0;
                float o[8];
#pragma unroll
                for (int n = 0; n < 2; ++n)
#pragma unroll
                    for (int j = 0; j < 4; ++j) { const float g = acc[ai][0][m][n][j], up = acc[ai][1][m][n][j]; o[n * 4 + j] = siluf_(g) * up; }
                *(u32x4*)rowp = pack8(o); }
    }
};

struct EpiEvenIn {
    bf16 *Q, *KB, *VB, *AG; const float* qg; const float* kg; const f32x2* rope;
    __device__ __forceinline__ void operator()(const f32x4 (&acc)[2][2][4][2], const Unit& u, int wr, int wc, int fr, int fq) const {
        const int row0 = u.pm * BM + wr * 64 + fr;
        if (u.pn >= 3) {
            const int col0 = (u.pn - 3) * 128 + wc * 32 + 8 * fq;
#pragma unroll
            for (int ai = 0; ai < 2; ++ai)
#pragma unroll
                for (int m = 0; m < 4; ++m) { float o[8];
#pragma unroll
                    for (int n = 0; n < 2; ++n)
#pragma unroll
                        for (int j = 0; j < 4; ++j) o[n * 4 + j] = acc[ai][0][m][n][j] * sigmoidf_(acc[ai][1][m][n][j]);
                    *(u32x4*)(AG + (size_t)(row0 + ai * HALF + m * 16) * CAW + col0) = pack8(o); }
            return;
        }
        if (u.pn == 2 && wc >= 2) {
#pragma unroll
            for (int ai = 0; ai < 2; ++ai)
#pragma unroll
                for (int m = 0; m < 4; ++m) { const int row = row0 + ai * HALF + m * 16;
                    const size_t kvrow = row < NLAT ? (size_t)(row >> 13) * KVS + (row & (SEQ - 1)) : (size_t)((row - NLAT) >> 8) * KVS + SEQ + ((row - NLAT) & 255);
#pragma unroll
                    for (int bj = 0; bj < 2; ++bj) { float o[8];
#pragma unroll
                        for (int n = 0; n < 2; ++n)
#pragma unroll
                            for (int j = 0; j < 4; ++j) o[n * 4 + j] = acc[ai][bj][m][n][j];
                        *(u32x4*)(VB + kvrow * KVW + (wc - 2) * 64 + 32 * bj + 8 * fq) = pack8(o); } }
            return;
        }
        const bool isq = u.pn < 2; const float* g = isq ? qg : kg; const float post = isq ? C2 : 1.0f;
        f32x4 gv[2][2];
#pragma unroll
        for (int bj = 0; bj < 2; ++bj)
#pragma unroll
            for (int n = 0; n < 2; ++n) gv[bj][n] = *(const f32x4*)(g + 32 * bj + 8 * fq + 4 * n);
#pragma unroll
        for (int ai = 0; ai < 2; ++ai)
#pragma unroll
            for (int m = 0; m < 4; ++m) { const int row = row0 + ai * HALF + m * 16;
                float ss = 0.f;
#pragma unroll
                for (int bj = 0; bj < 2; ++bj)
#pragma unroll
                    for (int n = 0; n < 2; ++n) { const f32x4 x = acc[ai][bj][m][n]; ss += (x[0] * x[0] + x[1] * x[1]) + (x[2] * x[2] + x[3] * x[3]); }
                ss += __shfl_xor(ss, 16); ss += __shfl_xor(ss, 32);
                const float rstd = __builtin_amdgcn_rsqf(ss * (1.0f / 64.0f) + EPS);
                const bool isx = row < NLAT; const int pos = row & (SEQ - 1);
                bf16* dst; if (isq) dst = Q + (size_t)row * AW + (u.pn * 4 + wc) * 64;
                else { const size_t kvrow = isx ? (size_t)(row >> 13) * KVS + pos : (size_t)((row - NLAT) >> 8) * KVS + SEQ + ((row - NLAT) & 255); dst = KB + kvrow * KVW + wc * 64; }
#pragma unroll
                for (int bj = 0; bj < 2; ++bj) { float o[8];
                    const int ps = bj ? (pos & 63) : (pos >> 6);
#pragma unroll
                    for (int n = 0; n < 2; ++n) { f32x4 f = acc[ai][bj][m][n] * rstd * gv[bj][n];
                        if (isx) { const f32x4 cs = *(const f32x4*)(rope + ps * 16 + 4 * fq + 2 * n);
                            const float x0 = f[0], x1 = f[1], x2 = f[2], x3 = f[3];
                            f[0] = x0 * cs[0] - x1 * cs[1]; f[1] = x0 * cs[1] + x1 * cs[0]; f[2] = x2 * cs[2] - x3 * cs[3]; f[3] = x2 * cs[3] + x3 * cs[2]; }
                        o[n * 4 + 0] = f[0] * post; o[n * 4 + 1] = f[1] * post; o[n * 4 + 2] = f[2] * post; o[n * 4 + 3] = f[3] * post; }
                    *(u32x4*)(dst + 32 * bj + 8 * fq) = pack8(o); } }
    }
};
struct EpiOddIn {
    bf16 *U, *GB;
    __device__ __forceinline__ void operator()(const f32x4 (&acc)[2][2][4][2], const Unit& u, int wr, int wc, int fr, int fq) const {
        const int row0 = u.pm * BM + wr * 64 + fr;
#pragma unroll
        for (int ai = 0; ai < 2; ++ai)
#pragma unroll
            for (int m = 0; m < 4; ++m) { const size_t row = (size_t)(row0 + ai * HALF + m * 16);
                if (u.pn < 8) { float o[8];
#pragma unroll
                    for (int n = 0; n < 2; ++n)
#pragma unroll
                        for (int j = 0; j < 4; ++j) o[n * 4 + j] = acc[ai][0][m][n][j] * acc[ai][1][m][n][j];
                    *(u32x4*)(U + row * D + u.pn * 128 + wc * 32 + 8 * fq) = pack8(o);
                } else {
#pragma unroll
                    for (int bj = 0; bj < 2; ++bj) { float o[8];
#pragma unroll
                        for (int n = 0; n < 2; ++n)
#pragma unroll
                            for (int j = 0; j < 4; ++j) o[n * 4 + j] = acc[ai][bj][m][n][j];
                        *(u32x4*)(GB + row * D + (u.pn - 8) * 256 + bj * HALF + wc * 32 + 8 * fq) = pack8(o); } } }
    }
};
struct EvenInOrder {
    DenseOrder d; bool kvonly;
    __device__ bool next(int i, Unit& u) const {
        const long L = (long)i * d.G + d.c; const int nx = d.nwg;
        if (L < nx) return d.next(i, u);
        const int j = (int)(L - nx); const int nextra = kvonly ? (NCTX / 256) : (NCTX / 256) * 7; if (j >= nextra) return false;
        if (kvonly) { u.pm = NLAT / 256 + j; u.pn = 2; } else { u.pm = NLAT / 256 + j / 7; u.pn = j % 7; }
        u.e = 0; return true;
    }
    __device__ __forceinline__ const char* bbase(const Unit& u) const { return d.bbase(u); }
    __device__ __forceinline__ void aoffs(const Unit& u, const int (&Rr)[2], const int (&Cc)[2], unsigned (&a)[2][2]) const { d.aoffs(u, Rr, Cc, a); }
    __device__ __forceinline__ void tok_load(const Unit&, const int (&)[2], unsigned (&)[2][2]) const {}
    __device__ __forceinline__ void aoffs_from(const Unit& u, const int (&Rr)[2], const int (&Cc)[2], const unsigned (&)[2][2], unsigned (&a)[2][2]) const { d.aoffs(u, Rr, Cc, a); }
};

template <class Epi, class Sched>
__device__ __forceinline__ void gemm_phase(LAS unsigned char* lds, const bf16* A, const int K, const Sched& S, const Epi& E, const int tid) {
    const int wid = __builtin_amdgcn_readfirstlane(tid >> 6), lane = tid & 63, wr = wid >> 2, wc = wid & 3, fr = lane & 15, fq = lane >> 4;
    const int nt = K / BK;
    int Rr[2], Cc[2]; unsigned voffB[2];
#pragma unroll
    for (int i = 0; i < 2; ++i) { int R, C; stage_rc(tid * 16 + i * 8192, R, C); const int Rb = (R & ~31) + perm32(R & 31); Rr[i] = R; Cc[i] = C; voffB[i] = (unsigned)(Rb * K + C) * 2u; }
    const size_t kstep = (size_t)(BK * 2);
    const size_t hstep = (size_t)HALF * K * 2;
    const unsigned ldsw = (unsigned)wid * 1024u;
    const int aoff = lds_byte(wr * 64 + fr, fq * 8), boff = lds_byte(wc * 32 + fr, fq * 8);
    const char* Ab = (const char*)A;
#define PG8_SA(b, h) (((b) * 2 + (h)) * HTB)
#define PG8_SB(b, h) ((4 + (b) * 2 + (h)) * HTB)
#define PG8_STAGE_B(bufoff, gbase) do { const char* _ub = (const char*)(gbase); asm volatile("" : "+s"(_ub)); _Pragma("unroll") for (int _i = 0; _i < 2; ++_i) \
        __builtin_amdgcn_global_load_lds((const unsigned*)(_ub + voffB[_i]), (LAS unsigned*)(lds + (bufoff) + ldsw + _i * 8192), 16, 0, 0); } while (0)
#define PG8_STAGE_A(bufoff, kb, offs) do { const char* _ub = Ab + (size_t)(kb); asm volatile("" : "+s"(_ub)); _Pragma("unroll") for (int _i = 0; _i < 2; ++_i) \
        __builtin_amdgcn_global_load_lds((const unsigned*)(_ub + (offs)[_i]), (LAS unsigned*)(lds + (bufoff) + ldsw + _i * 8192), 16, 0, 0); } while (0)
#define PG8_LDA(dst, b, h) do { _Pragma("unroll") for (int m = 0; m < 4; ++m) _Pragma("unroll") for (int k = 0; k < 2; ++k) dst[m][k] = *(const LAS bf16x8*)(lds + PG8_SA(b, h) + aoff + m * 2048 + k * 1024); } while (0)
#define PG8_LDB(dst, b, h) do { _Pragma("unroll") for (int n = 0; n < 2; ++n) _Pragma("unroll") for (int k = 0; k < 2; ++k) dst[n][k] = *(const LAS bf16x8*)(lds + PG8_SB(b, h) + boff + n * 2048 + k * 1024); } while (0)
#define PG8_MMA(ai, bj, At, Bt) do { __builtin_amdgcn_s_setprio(1); _Pragma("unroll") for (int m = 0; m < 4; ++m) _Pragma("unroll") for (int n = 0; n < 2; ++n) _Pragma("unroll") for (int k = 0; k < 2; ++k) \
        acc[ai][bj][m][n] = __builtin_amdgcn_mfma_f32_16x16x32_bf16(Bt[n][k], At[m][k], acc[ai][bj][m][n], 0, 0, 0); __builtin_amdgcn_s_setprio(0); } while (0)
#define PG8_WAIT_V(n) asm volatile("s_waitcnt vmcnt(" #n ")" ::: "memory")
#define PG8_WAIT_L(n) asm volatile("s_waitcnt lgkmcnt(" #n ")" ::: "memory")
#define PG8_BAR __builtin_amdgcn_s_barrier()
#define PG8_SCHED __builtin_amdgcn_sched_barrier(0)
    Unit cur, nxt; int ui = 0;
    if (!S.next(0, cur)) return;
    f32x4 acc[2][2][4][2];
#pragma unroll
    for (int a = 0; a < 2; ++a)
#pragma unroll
        for (int b = 0; b < 2; ++b)
#pragma unroll
            for (int m = 0; m < 4; ++m)
#pragma unroll
                for (int n = 0; n < 2; ++n) acc[a][b][m][n] = (f32x4){0.f, 0.f, 0.f, 0.f};
    bf16x8 At[4][2], B0[2][2], B1[2][2];
    unsigned aC[2][2], aN[2][2], rawN[2][2];
    S.aoffs(cur, Rr, Cc, aC);
    const char* cB = S.bbase(cur);
    Unit nn; bool has_next = S.next(1, nxt);
    if (has_next) S.tok_load(nxt, Rr, rawN);
    PG8_STAGE_B(PG8_SB(0, 0), cB); PG8_STAGE_B(PG8_SB(0, 1), cB + hstep); PG8_STAGE_A(PG8_SA(0, 0), 0, aC[0]); PG8_STAGE_A(PG8_SA(0, 1), 0, aC[1]);
    if (wr == 1) PG8_BAR;
    PG8_WAIT_V(2); PG8_BAR;
    PG8_STAGE_B(PG8_SB(1, 0), cB + kstep); PG8_STAGE_A(PG8_SA(1, 0), kstep, aC[0]); PG8_STAGE_B(PG8_SB(1, 1), cB + hstep + kstep);
    PG8_WAIT_V(6); PG8_BAR;
    for (;;) {
        const char* nB = has_next ? S.bbase(nxt) : cB;
        if (has_next) S.aoffs_from(nxt, Rr, Cc, rawN, aN);
        else {
#pragma unroll
            for (int h = 0; h < 2; ++h)
#pragma unroll
                for (int i = 0; i < 2; ++i) aN[h][i] = aC[h][i];
        }
#pragma unroll 1
        for (int t = 0; t < nt; t += 2) {
            const bool last = (t == nt - 2);
            const size_t kb1 = (size_t)(t + 1) * kstep;
            const size_t kb2 = last ? (size_t)0 : (size_t)(t + 2) * kstep, kb3 = kb2 + kstep;
            const char* b2 = last ? nB : cB + (size_t)(t + 2) * kstep; const char* b3 = b2 + kstep;
            unsigned x2[2][2];
#pragma unroll
            for (int h = 0; h < 2; ++h)
#pragma unroll
                for (int i = 0; i < 2; ++i) x2[h][i] = last ? aN[h][i] : aC[h][i];
            PG8_LDB(B0, 0, 0); PG8_LDB(B1, 0, 1); PG8_SCHED; PG8_LDA(At, 0, 0); PG8_STAGE_A(PG8_SA(1, 1), kb1, aC[1]);
            PG8_WAIT_V(8); PG8_WAIT_L(0); PG8_BAR; PG8_MMA(0, 0, At, B0); PG8_MMA(0, 1, At, B1); PG8_BAR; PG8_SCHED;
            PG8_LDA(At, 0, 1); PG8_STAGE_B(PG8_SB(0, 0), b2); PG8_STAGE_B(PG8_SB(0, 1), b2 + hstep); PG8_STAGE_A(PG8_SA(0, 0), kb2, x2[0]);
            PG8_WAIT_V(8); PG8_WAIT_L(0); PG8_BAR; PG8_MMA(1, 0, At, B0); PG8_MMA(1, 1, At, B1); PG8_BAR; PG8_SCHED;
            PG8_LDB(B0, 1, 0); PG8_LDB(B1, 1, 1); PG8_SCHED; PG8_LDA(At, 1, 0); PG8_STAGE_A(PG8_SA(0, 1), kb2, x2[1]);
            PG8_WAIT_V(8); PG8_WAIT_L(0); PG8_BAR; PG8_MMA(0, 0, At, B0); PG8_MMA(0, 1, At, B1); PG8_BAR; PG8_SCHED;
            PG8_LDA(At, 1, 1); PG8_STAGE_B(PG8_SB(1, 0), b3); PG8_STAGE_B(PG8_SB(1, 1), b3 + hstep); PG8_STAGE_A(PG8_SA(1, 0), kb3, x2[0]);
            PG8_WAIT_V(8); PG8_WAIT_L(0); PG8_BAR; PG8_MMA(1, 0, At, B0); PG8_MMA(1, 1, At, B1); PG8_BAR; PG8_SCHED;
        }
        const bool has_nn = has_next && S.next(ui + 2, nn);
        if (has_nn) S.tok_load(nn, Rr, rawN);
        if (wr == 0) PG8_BAR;
        E(acc, cur, wr, wc, fr, fq);
        if (!has_next) break;
#pragma unroll
        for (int a = 0; a < 2; ++a)
#pragma unroll
            for (int b = 0; b < 2; ++b)
#pragma unroll
                for (int m = 0; m < 4; ++m)
#pragma unroll
                    for (int n = 0; n < 2; ++n) acc[a][b][m][n] = (f32x4){0.f, 0.f, 0.f, 0.f};
        cur = nxt; cB = nB; ++ui; nxt = nn; has_next = has_nn;
#pragma unroll
        for (int h = 0; h < 2; ++h)
#pragma unroll
            for (int i = 0; i < 2; ++i) aC[h][i] = aN[h][i];
        if (wr == 1) PG8_BAR;
    }
    PG8_WAIT_V(0);
    PG8_BAR;
#undef PG8_SA
#undef PG8_SB
#undef PG8_STAGE_A
#undef PG8_STAGE_B
#undef PG8_LDA
#undef PG8_LDB
#undef PG8_MMA
#undef PG8_WAIT_V
#undef PG8_WAIT_L
#undef PG8_BAR
#undef PG8_SCHED
}
}

#ifndef ATTN_STORE16
#define ATTN_STORE16(p,v) (*(u32x4*)(p)=(v))
#endif
namespace attn_body {
using bf16=unsigned short;
using bf16x8=__attribute__((ext_vector_type(8)))short;
using s16x4=__attribute__((ext_vector_type(4)))short;
using f32x16=__attribute__((ext_vector_type(16)))float;
using u32x4=__attribute__((ext_vector_type(4)))unsigned;
constexpr int D=64,QP=512,KP=128,OP=1024;
constexpr int NW=8,QBLK=32,QB=QBLK*NW,KVBLK=64;
constexpr int ATTN_UNIT_ROWS=QB;
__device__ __forceinline__ int crow(int r,int hi){return (r&3)+8*(r>>2)+4*hi;}
#define SBAR() __builtin_amdgcn_sched_barrier(0)
constexpr int NSLOT=3, SLOTB=8192;
constexpr int LDS_K=0, LDS_V=NSLOT*SLOTB, LDS_WS=2*NSLOT*SLOTB, LDS_OST=LDS_WS+NW*64*4, LDS_BYTES=LDS_OST+NW*4096;
constexpr float C2=0.125f*1.4426950408889634f;
__device__ __forceinline__ void glds16(const void*sbase,unsigned voff,unsigned lds_dst){unsigned keep;
  asm volatile("s_mov_b32 %0, m0\n\ts_mov_b32 m0, %3\n\ts_nop 0\n\tglobal_load_lds_dwordx4 %1, %2\n\ts_mov_b32 m0, %0":"=&s"(keep):"v"(voff),"s"(sbase),"s"(lds_dst):"memory");}
__device__ __forceinline__ float max3f(float a,float b,float c){float r;asm("v_max3_f32 %0, %1, %2, %3":"=v"(r):"v"(a),"v"(b),"v"(c));return r;}
__device__ __forceinline__ float max2f(float a,float b){float r;asm("v_max_f32_e32 %0, %1, %2":"=v"(r):"v"(a),"v"(b));return r;}
__device__ __forceinline__ float fadd_s(float a,float b){float r;asm("v_add_f32_e32 %0, %1, %2":"=v"(r):"v"(a),"v"(b));return r;}
__device__ __forceinline__ float fsub_s(float a,float b){float r;asm("v_sub_f32_e32 %0, %1, %2":"=v"(r):"v"(a),"v"(b));return r;}
typedef float f32x2_t __attribute__((ext_vector_type(2))); typedef __bf16 bf16x2_t __attribute__((ext_vector_type(2)));
__device__ __forceinline__ unsigned cvtpk_s(float lo,float hi){f32x2_t v={lo,hi};bf16x2_t b=__builtin_convertvector(v,bf16x2_t);return __builtin_bit_cast(unsigned,b);}
#define WAIT_BAR(N) asm volatile("s_waitcnt vmcnt(" #N ") lgkmcnt(0)\n\ts_barrier":::"memory")

__device__ __forceinline__ void qkt(f32x16&p0,f32x16&p1,const char*Kslot,const bf16x8*qr,const f32x16&negm,int r32,int hi){
  const char*kb=Kslot+hi*1024+r32*16;
  #pragma unroll
  for(int d0=0;d0<4;++d0){
    const bf16x8 b0=*reinterpret_cast<const bf16x8*>(kb+d0*2048);
    const bf16x8 b1=*reinterpret_cast<const bf16x8*>(kb+d0*2048+512);
    if(d0==0){p0=__builtin_amdgcn_mfma_f32_32x32x16_bf16(b0,qr[0],negm,0,0,0);p1=__builtin_amdgcn_mfma_f32_32x32x16_bf16(b1,qr[0],negm,0,0,0);}
    else{p0=__builtin_amdgcn_mfma_f32_32x32x16_bf16(b0,qr[d0],p0,0,0,0);p1=__builtin_amdgcn_mfma_f32_32x32x16_bf16(b1,qr[d0],p1,0,0,0);}}
}
typedef __attribute__((address_space(3))) const char* lds_cptr;
typedef short v4i16_t __attribute__((ext_vector_type(4)));
__device__ __forceinline__ void kload8(bf16x8*kf,lds_cptr kp){
  kf[0]=*(const __attribute__((address_space(3))) bf16x8*)(kp);      kf[1]=*(const __attribute__((address_space(3))) bf16x8*)(kp+512);
  kf[2]=*(const __attribute__((address_space(3))) bf16x8*)(kp+2048); kf[3]=*(const __attribute__((address_space(3))) bf16x8*)(kp+2560);
  kf[4]=*(const __attribute__((address_space(3))) bf16x8*)(kp+4096); kf[5]=*(const __attribute__((address_space(3))) bf16x8*)(kp+4608);
  kf[6]=*(const __attribute__((address_space(3))) bf16x8*)(kp+6144); kf[7]=*(const __attribute__((address_space(3))) bf16x8*)(kp+6656);
}
__device__ __forceinline__ void kload2(bf16x8*kf,lds_cptr kp,int j){ kf[2*j]=*(const __attribute__((address_space(3))) bf16x8*)(kp+j*2048); kf[2*j+1]=*(const __attribute__((address_space(3))) bf16x8*)(kp+j*2048+512); }
__device__ __forceinline__ s16x4 vtr(lds_cptr p){ return __builtin_bit_cast(s16x4,__builtin_amdgcn_ds_read_tr16_b64_v4i16((__attribute__((address_space(3))) v4i16_t*)p)); }
__device__ __forceinline__ float rowmax(const f32x16&p0,const f32x16&p1){
  float a=max3f(p0[0],p0[1],p1[0]),b=max3f(p0[2],p0[3],p1[1]);a=max3f(a,p1[2],p1[3]);
  #pragma unroll
  for(int r=4;r<16;r+=4){a=max3f(a,p0[r],p0[r+1]);b=max3f(b,p0[r+2],p0[r+3]);a=max3f(a,p1[r],p1[r+1]);b=max3f(b,p1[r+2],p1[r+3]);}
  const float m=max2f(a,b);
  auto rr=__builtin_amdgcn_permlane32_swap(__float_as_uint(m),__float_as_uint(m),false,false);
  return max2f(__uint_as_float(rr[0]),__uint_as_float(rr[1]));
}
__device__ __forceinline__ void pv(f32x16*o,int vb,bf16x8 pa0,bf16x8 pa1,bf16x8 pa2,bf16x8 pa3){
  #pragma unroll
  for(int d0=0;d0<2;++d0){s16x4 lo[4],hi[4];
    #pragma unroll
    for(int ks=0;ks<4;++ks){
      asm volatile("ds_read_b64_tr_b16 %0,%1 offset:%c2":"=&v"(lo[ks]):"v"(vb),"i"(d0*4096+ks*1024):"memory");
      asm volatile("ds_read_b64_tr_b16 %0,%1 offset:%c2":"=&v"(hi[ks]):"v"(vb),"i"(d0*4096+ks*1024+512):"memory");}
    asm volatile("s_waitcnt lgkmcnt(0)":::"memory");SBAR();
    #define PK(k) (bf16x8){lo[k][0],lo[k][1],lo[k][2],lo[k][3],hi[k][0],hi[k][1],hi[k][2],hi[k][3]}
    o[d0]=__builtin_amdgcn_mfma_f32_32x32x16_bf16(pa0,PK(0),o[d0],0,0,0);
    o[d0]=__builtin_amdgcn_mfma_f32_32x32x16_bf16(pa1,PK(1),o[d0],0,0,0);
    o[d0]=__builtin_amdgcn_mfma_f32_32x32x16_bf16(pa2,PK(2),o[d0],0,0,0);
    o[d0]=__builtin_amdgcn_mfma_f32_32x32x16_bf16(pa3,PK(3),o[d0],0,0,0);
    #undef PK
  }
}

__device__ __forceinline__ unsigned short f2bf_(float x){f32x2_t v={x,0.f};bf16x2_t bb=__builtin_convertvector(v,bf16x2_t);return (unsigned short)(__builtin_bit_cast(unsigned,bb)&0xffffu);}
template<int THRL> __device__ __forceinline__ void attn_unit(const bf16*Qb,const bf16*__restrict__ Kh,const bf16*__restrict__ Vh,bf16*Ob,const int NT,char*shm,const int tid){
  const int lane=tid&63,r32=lane&31,hi=lane>>5; const int wid=__builtin_amdgcn_readfirstlane(tid>>6);
  const bf16*Qw=Qb+(long)(wid*QBLK)*QP;
  const unsigned lds0=(unsigned)(uintptr_t)shm;
  float*wsf=(float*)(shm+LDS_WS)+wid*64;
  const unsigned ksrc=(unsigned)(lane*KP+wid*8)*2u;
  const unsigned vsrc=(unsigned)((16*(wid&3)+(lane>>2))*KP+(wid>>2)*32+(lane&3)*8)*2u;
  const unsigned kdst=lds0+LDS_K+wid*1024, vdst=lds0+LDS_V+wid*1024;
  #define DMA_K(t,slot) glds16(Kh+(long)(t)*KVBLK*KP,ksrc,(unsigned)__builtin_amdgcn_readfirstlane(kdst+(slot)))
  #define DMA_V(t,slot) glds16(Vh+(long)(t)*KVBLK*KP,vsrc,(unsigned)__builtin_amdgcn_readfirstlane(vdst+(slot)))
  const int vb0=(int)(lds0+LDS_V)+((lane>>4)&1)*32+(lane&3)*8+(4*hi+((lane&15)>>2))*64;
  const char*Kbase=shm+LDS_K; bf16x8 kf[8];
  const lds_cptr shm3=(lds_cptr)shm; const lds_cptr kp0=shm3+LDS_K+hi*1024+r32*16; const lds_cptr vp0=shm3+LDS_V+((lane>>4)&1)*32+(lane&3)*8+(4*hi+((lane&15)>>2))*64;
  DMA_K(0,0);DMA_V(0,0);DMA_K(1,SLOTB);
  bf16x8 qr[4];
  #pragma unroll
  for(int d0=0;d0<4;++d0)qr[d0]=*reinterpret_cast<const bf16x8*>(&Qw[(long)r32*QP+d0*16+hi*8]);
  float mhat=0.f,l_reg=0.f;f32x16 o[2];o[0]=f32x16{};o[1]=f32x16{};f32x16 negm=f32x16{};asm volatile("":"+v"(negm));
  #define CMASK(P0,P1,t) do{}while(0)
  bool resc=false;
  #define START(P0,P1) do{ const float rm=rowmax(P0,P1); resc=false; \
    { const float dl=rm; mhat=fadd_s(mhat,dl); \
      _Pragma("unroll") for(int r=0;r<16;++r){P0[r]=fsub_s(P0[r],dl);P1[r]=fsub_s(P1[r],dl);} \
      _Pragma("unroll") for(int r=0;r<16;++r)negm[r]=-mhat; asm volatile("":"+v"(negm)); } \
    _Pragma("unroll") for(int r=0;r<16;++r)P0[r]=__builtin_amdgcn_exp2f(P0[r]); }while(0)
  #define RESC() do{ if(resc){ asm volatile("s_waitcnt lgkmcnt(0)":::"memory"); \
      _Pragma("unroll") for(int d_=0;d_<2;++d_) _Pragma("unroll") for(int r=0;r<16;++r)o[d_][r]*=wsf[crow(r,hi)]; } }while(0)
  f32x16 pA0,pA1,pB0,pB1;
  int sl_prev=0,sl_cur=0,sl_next=SLOTB;
  #define ROT() do{sl_prev=sl_cur;sl_cur=sl_next;sl_next=(sl_next==(NSLOT-1)*SLOTB)?0:sl_next+SLOTB;}while(0)
  DMA_K(2,2*SLOTB);
  WAIT_BAR(3);
  qkt(pA0,pA1,Kbase,qr,negm,r32,hi);asm volatile("s_nop 15\n\ts_nop 7":"+v"(pA0),"+v"(pA1));CMASK(pA0,pA1,0);
  START(pA0,pA1);
  _Pragma("unroll") for(int r=0;r<16;++r)pA1[r]=__builtin_amdgcn_exp2f(pA1[r]);
  WAIT_BAR(0);
  DMA_K(3,0);DMA_V(1,SLOTB);
  ROT();
  kload8(kf,kp0+sl_cur);
  WAIT_BAR(2);
  s16x4 vlo[8],vhi[8]; u32x4 pw0,pw1,pw2,pw3;
  #define PKW(P,B) cvtpk_s(P[B],P[B+1])
  #define PAF(k) __builtin_bit_cast(bf16x8,pw##k)
  #define VFR(i) (bf16x8){vlo[i][0],vlo[i][1],vlo[i][2],vlo[i][3],vhi[i][0],vhi[i][1],vhi[i][2],vhi[i][3]}
  #define PIN(x) asm volatile("":"+v"(x))
  #define MX3(a,b,c) __builtin_fmaxf(__builtin_fmaxf((a),(b)),(c))
  #define GAPA(MF,A0,A1,A2,A3,W0,W1,PW) do{ MF; sacc+=A0; sacc+=A1; sacc+=A2; sacc+=A3; PIN(sacc); W0; W1; PIN(PW); SBAR(); }while(0)
  #define EX(v) __builtin_amdgcn_exp2f(v)
  #define GAPB(MF,X,B) do{ MF; X[B]=EX(X[B]); X[B+1]=EX(X[B+1]); X[B+2]=EX(X[B+2]); X[B+3]=EX(X[B+3]); PIN(X); SBAR(); }while(0)
  #define VRD(i) do{ vlo[i]=vtr(vp_+(((i)>>2)*4096+((i)&3)*1024)); vhi[i]=vtr(vp_+(((i)>>2)*4096+((i)&3)*1024+512)); }while(0)
  #define KRD(G,j) do{ if(G){ kload2(kf,kp0+sl_next,j); SBAR(); } }while(0)
  #define STEP(C0,C1,P0,P1,t,GK,GV,GL) do{ SBAR(); \
    const lds_cptr vp_=vp0+sl_prev; \
    VRD(0); SBAR(); float sacc=(P0[0]+P0[1]); \
    GAPA(C0=__builtin_amdgcn_mfma_f32_32x32x16_bf16(kf[0],qr[0],negm,0,0,0), P0[2],P0[3],P0[4],P0[5],     pw0[0]=PKW(P0,0), pw0[1]=PKW(P0,2), pw0); \
    VRD(4); SBAR(); GAPA(C1=__builtin_amdgcn_mfma_f32_32x32x16_bf16(kf[1],qr[0],negm,0,0,0), P0[6],P0[7],P0[8],P0[9],     pw0[2]=PKW(P0,4), pw0[3]=PKW(P0,6), pw0); \
    VRD(1); SBAR(); GAPA(C0=__builtin_amdgcn_mfma_f32_32x32x16_bf16(kf[2],qr[1],C0,0,0,0),   P0[10],P0[11],P0[12],P0[13], pw1[0]=PKW(P0,8), pw1[1]=PKW(P0,10), pw1); \
    VRD(5); SBAR(); GAPA(C1=__builtin_amdgcn_mfma_f32_32x32x16_bf16(kf[3],qr[1],C1,0,0,0),   P0[14],P0[15],P1[0],P1[1],   pw1[2]=PKW(P0,12),pw1[3]=PKW(P0,14), pw1); \
    VRD(2); SBAR(); GAPA(C0=__builtin_amdgcn_mfma_f32_32x32x16_bf16(kf[4],qr[2],C0,0,0,0),   P1[2],P1[3],P1[4],P1[5],     pw2[0]=PKW(P1,0), pw2[1]=PKW(P1,2), pw2); \
    VRD(6); SBAR(); GAPA(C1=__builtin_amdgcn_mfma_f32_32x32x16_bf16(kf[5],qr[2],C1,0,0,0),   P1[6],P1[7],P1[8],P1[9],     pw2[2]=PKW(P1,4), pw2[3]=PKW(P1,6), pw2); \
    VRD(3); SBAR(); GAPA(C0=__builtin_amdgcn_mfma_f32_32x32x16_bf16(kf[6],qr[3],C0,0,0,0),   P1[10],P1[11],P1[12],P1[13], pw3[0]=PKW(P1,8), pw3[1]=PKW(P1,10), pw3); \
    VRD(7); SBAR(); GAPA(C1=__builtin_amdgcn_mfma_f32_32x32x16_bf16(kf[7],qr[3],C1,0,0,0),   P1[14],P1[15],0.f,0.f,       pw3[2]=PKW(P1,12),pw3[3]=PKW(P1,14), pw3); \
    l_reg+=sacc; \
    if(GK){DMA_K((t)+3,sl_cur);} if(GV){DMA_V((t)+1,sl_next);} \
    CMASK(C0,C1,t); \
    { float a=MX3(C0[0],C0[1],C1[0]),b=MX3(C0[2],C0[3],C1[1]); a=MX3(a,C1[2],C1[3]); \
      _Pragma("unroll") for(int r=4;r<16;r+=4){a=MX3(a,C0[r],C0[r+1]);b=MX3(b,C0[r+2],C0[r+3]);a=MX3(a,C1[r],C1[r+1]);b=MX3(b,C1[r+2],C1[r+3]);} \
      float rm=__builtin_fmaxf(a,b); { auto rr=__builtin_amdgcn_permlane32_swap(__float_as_uint(rm),__float_as_uint(rm),false,false); rm=__builtin_fmaxf(__uint_as_float(rr[0]),__uint_as_float(rr[1])); } \
      resc=false; \
      if(__builtin_expect(__any(rm>(float)THRL),0)){ const float dl=__builtin_fmaxf(rm,0.f); mhat+=dl; \
        _Pragma("unroll") for(int r=0;r<16;++r){C0[r]-=dl;C1[r]-=dl;} \
        _Pragma("unroll") for(int r=0;r<16;++r)negm[r]=-mhat; asm volatile("":"+v"(negm)); \
        const float f=__builtin_amdgcn_exp2f(-dl); l_reg*=f; if(hi==0)wsf[r32]=f; resc=true; } } \
    SBAR(); \
    GAPB(o[0]=__builtin_amdgcn_mfma_f32_32x32x16_bf16(PAF(0),VFR(0),o[0],0,0,0), C0,0); \
    GAPB(o[1]=__builtin_amdgcn_mfma_f32_32x32x16_bf16(PAF(0),VFR(4),o[1],0,0,0), C0,4); \
    KRD(GL,0); GAPB(o[0]=__builtin_amdgcn_mfma_f32_32x32x16_bf16(PAF(1),VFR(1),o[0],0,0,0), C0,8); \
    KRD(GL,1); GAPB(o[1]=__builtin_amdgcn_mfma_f32_32x32x16_bf16(PAF(1),VFR(5),o[1],0,0,0), C0,12); \
    KRD(GL,2); GAPB(o[0]=__builtin_amdgcn_mfma_f32_32x32x16_bf16(PAF(2),VFR(2),o[0],0,0,0), C1,0); \
    KRD(GL,3); GAPB(o[1]=__builtin_amdgcn_mfma_f32_32x32x16_bf16(PAF(2),VFR(6),o[1],0,0,0), C1,4); \
    GAPB(o[0]=__builtin_amdgcn_mfma_f32_32x32x16_bf16(PAF(3),VFR(3),o[0],0,0,0), C1,8); \
    GAPB(o[1]=__builtin_amdgcn_mfma_f32_32x32x16_bf16(PAF(3),VFR(7),o[1],0,0,0), C1,12); \
    }while(0)
  int t=1;
  #undef CMASK
  #define CMASK(P0,P1,t) do{}while(0)
  for(;t+5<NT;t+=2){
    STEP(pB0,pB1,pA0,pA1,t,true,true,true);     WAIT_BAR(2); RESC(); ROT();
    STEP(pA0,pA1,pB0,pB1,t+1,true,true,true);   WAIT_BAR(2); RESC(); ROT();
  }
  #undef CMASK
  #define CMASK(P0,P1,t) do{}while(0)
  #define ENDW(tt) do{ if((tt)+3<NT){WAIT_BAR(2);} else if((tt)+2<NT){WAIT_BAR(1);} else {WAIT_BAR(0);} }while(0)
  for(;t+1<NT;t+=2){
    STEP(pB0,pB1,pA0,pA1,t,(t+3<NT),(t+1<NT),(t+1<NT));       ENDW(t);   RESC(); ROT();
    STEP(pA0,pA1,pB0,pB1,t+1,(t+4<NT),(t+2<NT),(t+2<NT));     ENDW(t+1); RESC(); ROT();
  }
  STEP(pB0,pB1,pA0,pA1,NT-1,false,false,false); RESC();
  { float sacc=pB0[0]+pB0[1]; _Pragma("unroll") for(int r=2;r<16;++r)sacc+=pB0[r]; _Pragma("unroll") for(int r=0;r<16;++r)sacc+=pB1[r]; l_reg+=sacc;
    pw0=(u32x4){PKW(pB0,0),PKW(pB0,2),PKW(pB0,4),PKW(pB0,6)};pw1=(u32x4){PKW(pB0,8),PKW(pB0,10),PKW(pB0,12),PKW(pB0,14)};pw2=(u32x4){PKW(pB1,0),PKW(pB1,2),PKW(pB1,4),PKW(pB1,6)};pw3=(u32x4){PKW(pB1,8),PKW(pB1,10),PKW(pB1,12),PKW(pB1,14)};
    SBAR(); pv(o,vb0+sl_cur,PAF(0),PAF(1),PAF(2),PAF(3)); }
  #undef PKW
  #undef PAF
  #undef VFR
  #undef PIN
  #undef MX3
  #undef GAPA
  #undef GAPB
  #undef EX
  #undef VRD
  #undef KRD
  #undef STEP
  #undef ENDW
  {auto rr=__builtin_amdgcn_permlane32_swap(__float_as_uint(l_reg),__float_as_uint(l_reg),false,false);l_reg=__uint_as_float(rr[0])+__uint_as_float(rr[1]);}
  if(hi==0)wsf[32+r32]=l_reg;asm volatile("s_waitcnt lgkmcnt(0)":::"memory");
  float rli[16];
  #pragma unroll
  for(int r=0;r<16;++r)rli[r]=__builtin_amdgcn_rcpf(wsf[32+crow(r,hi)]);
  bf16*Ow=Ob+(long)(wid*QBLK)*OP;
  { bf16*stg=(bf16*)(shm+LDS_OST)+wid*2048;
    #pragma unroll
    for(int r=0;r<16;++r){const int orow=crow(r,hi);
      #pragma unroll
      for(int d0=0;d0<2;++d0)stg[orow*64+d0*32+r32]=f2bf_(o[d0][r]*rli[r]);}
    asm volatile("s_waitcnt lgkmcnt(0)":::"memory");
    #pragma unroll
    for(int i=0;i<4;++i){const int row=i*8+(lane>>3),ch=lane&7; const u32x4 v=*(const u32x4*)(stg+row*64+ch*8); ATTN_STORE16(Ow+(long)row*OP+ch*8,v);} }
  asm volatile("s_waitcnt lgkmcnt(0)\n\ts_barrier":::"memory");
  #undef DMA_K
  #undef DMA_V
  #undef CMASK
  #undef START
  #undef RESC
  #undef ROT
}
constexpr int ATTN_LDS_BYTES=LDS_BYTES;
#undef SBAR
#undef WAIT_BAR
}

#define XB_TMO      128
#define XB_XCNT(j)  (256  + 64 * (j))
#define XB_XSUB(j)  (1280 + 64 * (j))
#define XB_XGEN(j)  (2304 + 64 * (j))
#define XB_TOP      3328
#define XB_TOPGEN   3392
#define XCD_BAR_WORDS 3456
#define XB_SPIN_CAP (1u << 22)
__device__ __forceinline__ unsigned xb_ld(unsigned* p)              { return __hip_atomic_load(p, __ATOMIC_RELAXED, __HIP_MEMORY_SCOPE_AGENT); }
__device__ __forceinline__ unsigned xb_add(unsigned* p, unsigned v) { return __hip_atomic_fetch_add(p, v, __ATOMIC_RELAXED, __HIP_MEMORY_SCOPE_AGENT); }
__device__ __forceinline__ unsigned xb_xcc_id() { return (unsigned)__builtin_amdgcn_s_getreg((3 << 11) | 20) & 0xFu; }
#define XB_SPIN(cond, bar) do { unsigned _sp = 0; while (cond) { __builtin_amdgcn_s_sleep(1); \
    if ((++_sp & 255u) == 0u) { if (xb_ld(&(bar)[XB_TMO])) break; if (_sp > XB_SPIN_CAP) { atomicAdd(&(bar)[XB_TMO], 1u); break; } } } } while (0)
struct XcdBarrier { unsigned* bar; unsigned x; volatile LAS unsigned* st; };
__device__ __forceinline__ XcdBarrier xcd_barrier_post(unsigned* bar, volatile LAS unsigned* st, const int tid) {
    XcdBarrier b; b.bar = bar; b.x = xb_xcc_id(); b.st = st;
    if (tid == 0) (void)xb_add(&bar[XB_XCNT(b.x)], 1u);
    return b;
}
__device__ __forceinline__ void xcd_barrier_complete(unsigned* bar, unsigned x, unsigned& nloc, unsigned& nx) {
    const unsigned G = gridDim.x * gridDim.y * gridDim.z;
    unsigned sum, cnt, mine, sp = 0u;
    for (;;) {
        sum = 0u; cnt = 0u; mine = 0u;
#pragma unroll
        for (unsigned j = 0; j < 16; ++j) { const unsigned c = xb_ld(&bar[XB_XCNT(j)]); sum += c; cnt += (c > 0u) ? 1u : 0u; mine = (j == x) ? c : mine; }
        if (sum == G) break;
        __builtin_amdgcn_s_sleep(1);
        if ((++sp & 255u) == 0u) { if (xb_ld(&bar[XB_TMO])) break; if (sp > XB_SPIN_CAP) { atomicAdd(&bar[XB_TMO], 1u); break; } }
    }
    nloc = mine > 0u ? mine : 1u; nx = cnt > 0u ? cnt : 1u;
}
__device__ __forceinline__ void xcd_barrier(const XcdBarrier& b, const int tid) {
    asm volatile("s_waitcnt vmcnt(0)" ::: "memory");
    __syncthreads();
    if (tid == 0) {
        unsigned* bar = b.bar;
        __builtin_amdgcn_s_waitcnt(0);
        unsigned nloc = b.st[0], nx = b.st[1];
        if (nloc == 0u) { xcd_barrier_complete(bar, b.x, nloc, nx); b.st[0] = nloc; b.st[1] = nx; }
        const unsigned old = xb_add(&bar[XB_XSUB(b.x)], 1u);
        const unsigned gen = old / nloc;
        if (old + 1u == (gen + 1u) * nloc) {
            __builtin_amdgcn_fence(__ATOMIC_RELEASE, "agent");
            asm volatile("s_waitcnt vmcnt(0)" ::: "memory");
            const unsigned og = xb_add(&bar[XB_TOP], 1u);
            const unsigned tg = og / nx;
            if (og + 1u == (tg + 1u) * nx) xb_add(&bar[XB_TOPGEN], 1u);
            else XB_SPIN(xb_ld(&bar[XB_TOPGEN]) == tg, bar);
            __builtin_amdgcn_fence(__ATOMIC_ACQUIRE, "agent");
            xb_add(&bar[XB_XGEN(b.x)], 1u);
            asm volatile("s_waitcnt vmcnt(0)" ::: "memory");
        } else {
            XB_SPIN(xb_ld(&bar[XB_XGEN(b.x)]) == gen, bar);
            __builtin_amdgcn_fence(__ATOMIC_ACQUIRE, "agent");
            asm volatile("s_waitcnt vmcnt(0)" ::: "memory");
        }
    }
    __syncthreads();
}

struct Args { const float* in[24]; float* out; unsigned char* ws; int ph_lo, ph_hi, dry, pad; };
struct Frame {
    LAS unsigned char* lds;
    unsigned char* ldsg;
    volatile LAS unsigned* MISC;
    unsigned* ctl;
    unsigned char* ws; float* out; float* xw; const float* const* in;
    int tid, lane, wave, G, gw, NGW;
};
__device__ __forceinline__ const float* inp(const float* p) { unsigned long long v = (unsigned long long)p; asm volatile("" : "+s"(v)); return (const float*)(const GAS float*)v; }
#define F_x (inp(F.in[0]))
#define F_c (inp(F.in[1]))
#define F_ctx (inp(F.in[2]))
#define F_c_ctx (inp(F.in[3]))
#define F_w_mod (inp(F.in[4]))
#define F_b_mod (inp(F.in[5]))
#define F_g_mix (inp(F.in[6]))
#define F_g_ffn (inp(F.in[7]))
#define F_ev_w_in (inp(F.in[8]))
#define F_ev_qg (inp(F.in[9]))
#define F_ev_kg (inp(F.in[10]))
#define F_ev_dw_w (inp(F.in[11]))
#define F_ev_dw_b (inp(F.in[12]))
#define F_ev_ln_g (inp(F.in[13]))
#define F_ev_ln_b (inp(F.in[14]))
#define F_ev_w_out (inp(F.in[15]))
#define F_od_w_in (inp(F.in[16]))
#define F_od_conv_w (inp(F.in[17]))
#define F_od_w_out (inp(F.in[18]))
#define F_router_w (inp(F.in[19]))
#define F_router_b (inp(F.in[20]))
#define F_w_gate (inp(F.in[21]))
#define F_w_up (inp(F.in[22]))
#define F_w_down (inp(F.in[23]))
#define F_MOD    ((float*)(F.ws + WS_MOD))
#define F_ROPE   ((f32x2*)(F.ws + WS_ROPE))
#define F_RT     ((u32x4*)(F.ws + WS_RT))
#define F_ROWTOK ((unsigned*)(F.ws + WS_ROWTOK))
#define F_Z      ((float*)(F.ws + WS_Z))
#define F_W_EVIN  ((bf16*)(F.ws + WS_W_EVIN))
#define F_W_EVOUT ((bf16*)(F.ws + WS_W_EVOUT))
#define F_W_ODIN  ((bf16*)(F.ws + WS_W_ODIN))
#define F_W_ODOUT ((bf16*)(F.ws + WS_W_ODOUT))
#define F_W_MOE1  ((bf16*)(F.ws + WS_W_MOE1))
#define F_W_MOE2  ((bf16*)(F.ws + WS_W_MOE2))
#define F_HB   ((bf16*)(F.ws + WS_HB))
#define F_CAT  ((bf16*)(F.ws + WS_CAT))
#define F_OX   ((bf16*)(F.ws + WS_OX))
#define F_HMID ((bf16*)(F.ws + WS_HMID))
#define F_Y    ((bf16*)(F.ws + WS_Y))
#define F_Q    ((bf16*)(F.ws + WS_Q))
#define F_KB   ((bf16*)(F.ws + WS_K))
#define F_VB   ((bf16*)(F.ws + WS_V))
#define F_AG   ((bf16*)(F.ws + WS_AG))
#define F_SB   ((bf16*)(F.ws + WS_S))
#define F_U    ((bf16*)(F.ws + WS_U))
#define F_GB   ((bf16*)(F.ws + WS_GB))
__device__ __forceinline__ bool ctx_in_l(int l) { return l <= 2; }
__device__ __forceinline__ bool ctx_out_l(int l) { return l < 2; }

__device__ __forceinline__ int rowmap(int n, int mode) {
    if (mode == 0) return n;
    if (mode == 1 || mode == 2) return 256 * (n >> 7) + (n & 127) + (mode == 2 ? 128 : 0);
    if (mode == 3) {
        if (n < 768) { const int d = n & 63, hh = (n >> 6) & 3; return (n & ~255) + 128 * (d >> 5) + 32 * hh + (d & 31); }
        if (n < 1280) { const int o = n - 768; return 768 + 256 * (o >> 7) + (o & 127); }
        const int o = n - 1280; return 768 + 256 * (o >> 7) + 128 + (o & 127);
    }
    if (n < 1024) return 2048 + n;
    if (n < 2048) { const int o = n - 1024; return 256 * (o >> 7) + (o & 127); }
    { const int o = n - 2048; return 256 * (o >> 7) + 128 + (o & 127); }
}
struct TItem { const float* W; bf16* WT; int K, N, mode, k0, n0; };
__device__ __forceinline__ void titem_set(TItem& t, const float* W, int K, int N, bf16* WT, int mode, int item) { const int nblk = N >> 6; t.W = W; t.WT = WT; t.K = K; t.N = N; t.mode = mode; t.k0 = 64 * (item / nblk); t.n0 = 64 * (item % nblk); }
__device__ __forceinline__ void titem_load(const TItem& t, f32x4 (&v)[16], int lane) {
    const float* p = t.W + (size_t)(t.k0 + (lane >> 4)) * t.N + t.n0 + (lane & 15) * 4;
#pragma unroll
    for (int i = 0; i < 16; ++i) v[i] = __builtin_nontemporal_load((const f32x4*)(p + (size_t)(4 * i) * t.N));
}
__device__ __forceinline__ void titem_store(const TItem& t, const f32x4 (&v)[16], float* scr, int lane) {
#pragma unroll
    for (int i = 0; i < 16; ++i) { const int kk = (lane >> 4) + 4 * i; *(f32x4*)(scr + kk * 64 + (((lane & 15) * 4) ^ (4 * ((kk >> 3) & 7)))) = v[i]; }
    LDS_WAIT(); asm volatile("" ::: "memory");
    const int kc = lane & 7;
#pragma unroll
    for (int j = 0; j < 8; ++j) { const int n = (lane >> 3) + 8 * j; const float* sp = scr + (8 * kc) * 64 + (n ^ (4 * kc));
        u32x4 o; o.x = pk2(sp[0 * 64], sp[1 * 64]); o.y = pk2(sp[2 * 64], sp[3 * 64]); o.z = pk2(sp[4 * 64], sp[5 * 64]); o.w = pk2(sp[6 * 64], sp[7 * 64]);
        *(u32x4*)(t.WT + (size_t)rowmap(t.n0 + n, t.mode) * t.K + t.k0 + 8 * kc) = o; }
    LDS_WAIT(); asm volatile("" ::: "memory");
}
__device__ __forceinline__ void mod_unit(Frame& F, int u) {
    const int l = u / 48, cg = u % 48;
    float* act = (float*)F.ldsg;
    float* red = (float*)(F.ldsg + 36864);
    for (int idx = F.tid; idx < 9 * 1024; idx += NTHR) { const int r = idx >> 10, k = idx & 1023; const float v = (r < 8) ? F_c[r * 1024 + k] : F_c_ctx[k]; act[idx] = v / (1.0f + __expf(-v)); }
    __syncthreads();
    const float* W = F_w_mod + (size_t)l * 1024 * 6144 + cg * 128 + F.lane * 2;
    float acc[9][2];
#pragma unroll
    for (int r = 0; r < 9; ++r) { acc[r][0] = 0.f; acc[r][1] = 0.f; }
    const int k0 = F.wave * 128;
#pragma unroll 16
    for (int kk = 0; kk < 128; ++kk) { const int k = k0 + kk; const f32x2 w = __builtin_nontemporal_load((const f32x2*)(W + (size_t)k * 6144));
#pragma unroll
        for (int r = 0; r < 9; ++r) { const float a = act[r * 1024 + k]; acc[r][0] += a * w[0]; acc[r][1] += a * w[1]; } }
#pragma unroll
    for (int r = 0; r < 9; ++r) *(f32x2*)(red + (F.wave * 9 + r) * 128 + F.lane * 2) = (f32x2){acc[r][0], acc[r][1]};
    __syncthreads();
    for (int idx = F.tid; idx < 9 * 128; idx += NTHR) { const int r = idx >> 7, cc = idx & 127; float s = F_b_mod[l * 6144 + cg * 128 + cc];
#pragma unroll
        for (int w = 0; w < 8; ++w) s += red[(w * 9 + r) * 128 + cc];
        F_MOD[(size_t)(l * 9 + r) * 6144 + cg * 128 + cc] = s; }
    __syncthreads();
}
__device__ __forceinline__ void prologue(Frame& F) {
    for (int u = blockIdx.x; u < 192; u += F.G) mod_unit(F, u);
    for (int idx = blockIdx.x * NTHR + F.tid; idx < 128 * 16; idx += F.G * NTHR) { const int pos = idx >> 4, j = idx & 15;
        const float inv = __builtin_amdgcn_exp2f(-(float)j * (13.287712379549449f / 16.0f)); const float ang = (float)pos * inv;
        F_ROPE[idx] = (f32x2){__cosf(ang), __sinf(ang)}; }
    if (blockIdx.x == 0) { for (int i = F.tid; i < D / 2; i += NTHR) ((unsigned*)(F_HB + (size_t)ZROW * D))[i] = 0u; }
    float* scr = (float*)(F.ldsg + F.wave * 16384);
    constexpr int I_EVIN = 16 * (EVIN / 64), I_SQ = 16 * 16, I_ODIN = 16 * (ODIN / 64), I_GU = 16 * 8, I_DN = 8 * 16;
    constexpr int NSMALL = 2 * I_EVIN + 2 * I_SQ + 2 * I_ODIN + 2 * I_SQ;
    constexpr int NITEMS = NSMALL + 64 * (2 * I_GU + I_DN);
#define TDECODE(it, t) do { int r = (it); \
        if (r < 2 * I_EVIN) { const int i = r / I_EVIN; titem_set(t, F_ev_w_in + (size_t)i * D * EVIN, D, EVIN, F_W_EVIN + (size_t)i * EVIN * D, 3, r % I_EVIN); break; } r -= 2 * I_EVIN; \
        if (r < 2 * I_SQ) { const int i = r / I_SQ; titem_set(t, F_ev_w_out + (size_t)i * D * D, D, D, F_W_EVOUT + (size_t)i * D * D, 0, r % I_SQ); break; } r -= 2 * I_SQ; \
        if (r < 2 * I_ODIN) { const int i = r / I_ODIN; titem_set(t, F_od_w_in + (size_t)i * D * ODIN, D, ODIN, F_W_ODIN + (size_t)i * ODIN * D, 4, r % I_ODIN); break; } r -= 2 * I_ODIN; \
        if (r < 2 * I_SQ) { const int i = r / I_SQ; titem_set(t, F_od_w_out + (size_t)i * D * D, D, D, F_W_ODOUT + (size_t)i * D * D, 0, r % I_SQ); break; } r -= 2 * I_SQ; \
        { constexpr int PER = 2 * I_GU + I_DN; const int le = r / PER; int q = r % PER; \
          if (q < I_GU) { titem_set(t, F_w_gate + (size_t)le * D * DE, D, DE, F_W_MOE1 + (size_t)le * D * D, 1, q); break; } q -= I_GU; \
          if (q < I_GU) { titem_set(t, F_w_up + (size_t)le * D * DE, D, DE, F_W_MOE1 + (size_t)le * D * D, 2, q); break; } q -= I_GU; \
          titem_set(t, F_w_down + (size_t)le * DE * D, DE, D, F_W_MOE2 + (size_t)le * D * DE, 0, q); } } while (0)
    int it = F.gw;
    if (it < NITEMS) {
        TItem cur, nxt; f32x4 va[16], vb[16];
        TDECODE(it, cur); titem_load(cur, va, F.lane);
        for (;;) {
            const int itn = it + F.NGW; const bool more = itn < NITEMS;
            if (more) { TDECODE(itn, nxt); titem_load(nxt, vb, F.lane); }
            titem_store(cur, va, scr, F.lane);
            if (!more) break;
            cur = nxt; it = itn;
#pragma unroll
            for (int i = 0; i < 16; ++i) va[i] = vb[i];
        }
    }
#undef TDECODE
}

constexpr int NR = 4;
__device__ __forceinline__ void norm1_phase(Frame& F, int l, bool fin) {
    const int nrows = NLAT + ((!fin && ctx_in_l(l)) ? NCTX : 0);
    const int nch = nrows / NR;
    int pstartv = 0;
    if (l > 0) { const int c = (F.lane < 16) ? (int)__hip_atomic_load(F.ctl + CW_CNT + ((l - 1) * 16 + F.lane) * 64, __ATOMIC_RELAXED, __HIP_MEMORY_SCOPE_AGENT) : 0; const int p = (c + 255) & ~255; int incl = p;
#pragma unroll
        for (int o = 1; o < 16; o <<= 1) { const int t = __shfl_up(incl, o); if (F.lane >= o) incl += t; }
        pstartv = incl - p; }
    for (int ch = F.gw; ch < nch; ch += F.NGW) {
        const int r0 = ch * NR; const bool isz = r0 >= NLAT; const int b = isz ? 8 : (r0 >> 13);
        const float* src; float* dst;
        if (!isz) { src = (l == 0 ? F_x : F.out) + (size_t)r0 * D; dst = F.xw + (size_t)r0 * D; }
        else { const int j = r0 - NLAT; src = (l == 0 ? F_ctx : F_Z) + (size_t)j * D; dst = F_Z + (size_t)j * D; }
        f32x4 v[NR][4];
#pragma unroll
        for (int j = 0; j < NR; ++j)
#pragma unroll
            for (int q = 0; q < 4; ++q) v[j][q] = __builtin_nontemporal_load((const f32x4*)(src + (size_t)j * D + F.lane * 4 + 256 * q));
        if (l > 0) {
            u32x2 dd[NR]; float w0[NR], w1[NR];
#pragma unroll
            for (int j = 0; j < NR; ++j) { const u32x4 rt = F_RT[r0 + j]; w0[j] = __uint_as_float(rt.z); w1[j] = __uint_as_float(rt.w);
                const int e0 = __builtin_amdgcn_readfirstlane((int)(rt.x & 15u)), e1 = __builtin_amdgcn_readfirstlane((int)(rt.y & 15u));
                dd[j].x = (unsigned)__builtin_amdgcn_readlane(pstartv, e0) + (rt.x >> 4); dd[j].y = (unsigned)__builtin_amdgcn_readlane(pstartv, e1) + (rt.y >> 4); }
            const float* gate = F_MOD + (size_t)((l - 1) * 9 + b) * 6144 + 5 * 1024;
            f32x4 g[4];
#pragma unroll
            for (int q = 0; q < 4; ++q) g[q] = *(const f32x4*)(gate + F.lane * 4 + 256 * q);
            u32x2 ya[NR][4], yb[NR][4];
#pragma unroll
            for (int j = 0; j < NR; ++j)
#pragma unroll
                for (int q = 0; q < 4; ++q) { const int col = F.lane * 4 + 256 * q; ya[j][q] = __builtin_nontemporal_load((const u32x2*)(F_Y + (size_t)dd[j].x * D + col)); yb[j][q] = __builtin_nontemporal_load((const u32x2*)(F_Y + (size_t)dd[j].y * D + col)); }
#pragma unroll
            for (int j = 0; j < NR; ++j)
#pragma unroll
                for (int q = 0; q < 4; ++q) { const int col = F.lane * 4 + 256 * q; const u32x2 a = ya[j][q], bq = yb[j][q];
                    v[j][q][0] += g[q][0] * (w0[j] * bflo(a.x) + w1[j] * bflo(bq.x)); v[j][q][1] += g[q][1] * (w0[j] * bfhi(a.x) + w1[j] * bfhi(bq.x));
                    v[j][q][2] += g[q][2] * (w0[j] * bflo(a.y) + w1[j] * bflo(bq.y)); v[j][q][3] += g[q][3] * (w0[j] * bfhi(a.y) + w1[j] * bfhi(bq.y));
                    __builtin_nontemporal_store(v[j][q], (f32x4*)(dst + (size_t)j * D + col)); }
        }
        if (!fin) {
            float rstd[NR];
#pragma unroll
            for (int j = 0; j < NR; ++j) { float ss = 0.f;
#pragma unroll
                for (int q = 0; q < 4; ++q) ss += (v[j][q][0] * v[j][q][0] + v[j][q][1] * v[j][q][1]) + (v[j][q][2] * v[j][q][2] + v[j][q][3] * v[j][q][3]);
                rstd[j] = __builtin_amdgcn_rsqf(wave_sum(ss) * (1.0f / D) + EPS); }
            const float* gm = F_g_mix + l * D; const float* sh = F_MOD + (size_t)(l * 9 + b) * 6144; const float* sc = sh + 1024;
#pragma unroll
            for (int q = 0; q < 4; ++q) { const int col = F.lane * 4 + 256 * q; const f32x4 g = *(const f32x4*)(gm + col), s = *(const f32x4*)(sh + col), cc = *(const f32x4*)(sc + col);
                const f32x4 A = g * (cc + 1.0f);
#pragma unroll
                for (int j = 0; j < NR; ++j) { const f32x4 h = v[j][q] * rstd[j] * A + s;
                    *(u32x2*)(F_HB + (size_t)(r0 + j) * D + col) = (u32x2){pk2(h[0], h[1]), pk2(h[2], h[3])}; } }
        }
    }
}

__device__ __forceinline__ void norm2_phase(Frame& F, int l) {
    float* RWT = (float*)F.ldsg;
    unsigned* wcnt = (unsigned*)(F.ldsg + 65536);
    for (int idx = F.tid; idx < 4096; idx += NTHR) { const f32x4 w = *(const f32x4*)(F_router_w + idx * 4); const int col = idx >> 2, e0 = (idx & 3) * 4;
        RWT[(e0 + 0) * 1024 + col] = w[0]; RWT[(e0 + 1) * 1024 + col] = w[1]; RWT[(e0 + 2) * 1024 + col] = w[2]; RWT[(e0 + 3) * 1024 + col] = w[3]; }
    float rb[16];
#pragma unroll
    for (int e = 0; e < 16; ++e) rb[e] = F_router_b[e];
    __syncthreads();
    unsigned cnt = 0u;
    unsigned* wbase = (unsigned*)(F.ldsg + 66048);
    u32x4* stash = (u32x4*)(F.ldsg + 66560) + F.wave * 96; int nst = 0;
    const int nrows = NLAT + (ctx_out_l(l) ? NCTX : 0);
    const int nch = nrows / NR;
    for (int ch = F.gw; ch < nch; ch += F.NGW) {
        const int r0 = ch * NR; const bool isz = r0 >= NLAT; const int b = isz ? 8 : (r0 >> 13);
        const float* src; float* dst;
        if (!isz) { src = (l == 0 ? F_x : F.out) + (size_t)r0 * D; dst = F.xw + (size_t)r0 * D; }
        else { const int j = r0 - NLAT; src = (l == 0 ? F_ctx : F_Z) + (size_t)j * D; dst = F_Z + (size_t)j * D; }
        const float* mrow = F_MOD + (size_t)(l * 9 + b) * 6144;
        f32x4 v[NR][4]; u32x2 ox[NR][4];
#pragma unroll
        for (int j = 0; j < NR; ++j)
#pragma unroll
            for (int q = 0; q < 4; ++q) { const int col = F.lane * 4 + 256 * q; v[j][q] = __builtin_nontemporal_load((const f32x4*)(src + (size_t)j * D + col)); ox[j][q] = __builtin_nontemporal_load((const u32x2*)(F_OX + (size_t)(r0 + j) * D + col)); }
        float rstd[NR];
        {
            f32x4 g[4];
#pragma unroll
            for (int q = 0; q < 4; ++q) g[q] = *(const f32x4*)(mrow + 2 * 1024 + F.lane * 4 + 256 * q);
#pragma unroll
            for (int j = 0; j < NR; ++j) { float ss = 0.f;
#pragma unroll
                for (int q = 0; q < 4; ++q) { const u32x2 o = ox[j][q];
                    v[j][q][0] += g[q][0] * bflo(o.x); v[j][q][1] += g[q][1] * bfhi(o.x); v[j][q][2] += g[q][2] * bflo(o.y); v[j][q][3] += g[q][3] * bfhi(o.y);
                    __builtin_nontemporal_store(v[j][q], (f32x4*)(dst + (size_t)j * D + F.lane * 4 + 256 * q));
                    ss += (v[j][q][0] * v[j][q][0] + v[j][q][1] * v[j][q][1]) + (v[j][q][2] * v[j][q][2] + v[j][q][3] * v[j][q][3]); }
                rstd[j] = __builtin_amdgcn_rsqf(wave_sum(ss) * (1.0f / D) + EPS); }
        }
        const float* gf = F_g_ffn + l * D;
#pragma unroll
        for (int q = 0; q < 4; ++q) { const int col = F.lane * 4 + 256 * q; const f32x4 g = *(const f32x4*)(gf + col), s = *(const f32x4*)(mrow + 3 * 1024 + col), cc = *(const f32x4*)(mrow + 4 * 1024 + col);
            const f32x4 A = g * (cc + 1.0f);
#pragma unroll
            for (int j = 0; j < NR; ++j) { v[j][q] = v[j][q] * rstd[j] * A + s;
                *(u32x2*)(F_HB + (size_t)(r0 + j) * D + col) = (u32x2){pk2(v[j][q][0], v[j][q][1]), pk2(v[j][q][2], v[j][q][3])}; } }
        float lg[NR * 16];
#pragma unroll
        for (int i = 0; i < NR * 16; ++i) lg[i] = 0.f;
#pragma unroll
        for (int q = 0; q < 4; ++q) { const int col = F.lane * 4 + 256 * q;
#pragma unroll
            for (int e = 0; e < 16; ++e) { const f32x4 w = *(const f32x4*)(RWT + e * 1024 + col);
#pragma unroll
                for (int j = 0; j < NR; ++j) { float t_ = lg[j * 16 + e]; t_ = __builtin_fmaf(v[j][q][0], w[0], t_); t_ = __builtin_fmaf(v[j][q][1], w[1], t_); t_ = __builtin_fmaf(v[j][q][2], w[2], t_); t_ = __builtin_fmaf(v[j][q][3], w[3], t_); lg[j * 16 + e] = t_; }
                if ((e & 3) == 3) asm volatile("" ::: "memory"); } }
#define RS_STEP(N, MASK) do { const bool up_ = (F.lane & (MASK)) != 0; _Pragma("unroll") for (int k = 0; k < (N) / 2; ++k) { const float a_ = lg[k], b_ = lg[k + (N) / 2]; \
            const float send_ = up_ ? a_ : b_, keep_ = up_ ? b_ : a_; lg[k] = keep_ + __shfl_xor(send_, (MASK)); } } while (0)
        RS_STEP(64, 32); RS_STEP(32, 16); RS_STEP(16, 8); RS_STEP(8, 4); RS_STEP(4, 2); RS_STEP(2, 1);
#undef RS_STEP
        const float myv = lg[0];
        float lx[16];
#pragma unroll
        for (int e = 0; e < 16; ++e) lx[e] = __shfl(myv, (F.lane & 48) | e);
        float aff[16], sel[16];
#pragma unroll
        for (int e = 0; e < 16; ++e) { aff[e] = sigmoidf_(lx[e]); sel[e] = aff[e] + rb[e]; }
        float gs[4];
#pragma unroll
        for (int g = 0; g < 4; ++g) { const float a = sel[4 * g], bb = sel[4 * g + 1], c = sel[4 * g + 2], d = sel[4 * g + 3];
            const float hi1 = fmaxf(a, bb), lo1 = fminf(a, bb), hi2 = fmaxf(c, d), lo2 = fminf(c, d);
            gs[g] = fmaxf(hi1, hi2) + fmaxf(fminf(hi1, hi2), fmaxf(lo1, lo2)); }
        int grp = 0; float best = gs[0];
#pragma unroll
        for (int g = 1; g < 4; ++g) if (gs[g] > best) { best = gs[g]; grp = g; }
        float si[4], ai[4];
#pragma unroll
        for (int k = 0; k < 4; ++k) { si[k] = grp == 0 ? sel[k] : grp == 1 ? sel[4 + k] : grp == 2 ? sel[8 + k] : sel[12 + k]; ai[k] = grp == 0 ? aff[k] : grp == 1 ? aff[4 + k] : grp == 2 ? aff[8 + k] : aff[12 + k]; }
        int i0 = 0; float b0 = si[0];
#pragma unroll
        for (int k = 1; k < 4; ++k) if (si[k] > b0) { b0 = si[k]; i0 = k; }
        int i1 = -1; float b1 = -1e30f;
#pragma unroll
        for (int k = 0; k < 4; ++k) if (k != i0 && si[k] > b1) { b1 = si[k]; i1 = k; }
        const float a0 = i0 == 0 ? ai[0] : i0 == 1 ? ai[1] : i0 == 2 ? ai[2] : ai[3];
        const float a1 = i1 == 0 ? ai[0] : i1 == 1 ? ai[1] : i1 == 2 ? ai[2] : ai[3];
        const float inv = fast_rcp(a0 + a1);
        const int e0 = grp * 4 + i0, e1 = grp * 4 + i1;
        unsigned mylr0 = 0u, mylr1 = 0u;
#pragma unroll
        for (int j = 0; j < NR; ++j) {
            const int e0j = __builtin_amdgcn_readlane(e0, 16 * j), e1j = __builtin_amdgcn_readlane(e1, 16 * j);
            const unsigned lr0 = __builtin_amdgcn_readlane(cnt, e0j); cnt += (F.lane == e0j) ? 1u : 0u;
            const unsigned lr1 = __builtin_amdgcn_readlane(cnt, e1j); cnt += (F.lane == e1j) ? 1u : 0u;
            if ((F.lane >> 4) == j) { mylr0 = lr0; mylr1 = lr1; }
        }
        if ((F.lane & 15) == 0) stash[nst + (F.lane >> 4)] = (u32x4){(unsigned)e0 | (mylr0 << 4), (unsigned)e1 | (mylr1 << 4), __float_as_uint(a0 * inv), __float_as_uint(a1 * inv)};
        nst += NR;
    }
    if (F.lane < 16) wcnt[F.wave * 16 + F.lane] = cnt;
    __syncthreads();
    if (F.tid < 16) { const int e = F.tid; unsigned tot = 0u, pre[8];
#pragma unroll
        for (int w = 0; w < 8; ++w) { pre[w] = tot; tot += wcnt[w * 16 + e]; }
        const unsigned base = __hip_atomic_fetch_add(F.ctl + CW_CNT + (l * 16 + e) * 64, tot, __ATOMIC_RELAXED, __HIP_MEMORY_SCOPE_AGENT);
#pragma unroll
        for (int w = 0; w < 8; ++w) wbase[w * 16 + e] = base + pre[w]; }
    __syncthreads();
    for (int i = F.lane; i < nst; i += 64) { const u32x4 st = stash[i]; const int ci = i >> 2, j = i & 3; const unsigned tok = (unsigned)((F.gw + ci * F.NGW) * NR + j);
        const unsigned e0 = st.x & 15u, e1 = st.y & 15u; const unsigned rk0 = wbase[F.wave * 16 + e0] + (st.x >> 4), rk1 = wbase[F.wave * 16 + e1] + (st.y >> 4);
        F_ROWTOK[(size_t)e0 * VCAP + rk0] = tok; F_ROWTOK[(size_t)e1 * VCAP + rk1] = tok;
        F_RT[tok] = (u32x4){e0 | (rk0 << 4), e1 | (rk1 << 4), st.z, st.w}; }
    __syncthreads();
}

__device__ __forceinline__ int moe_prefix(Frame& F, int l, LAS int* pend, LAS int* pstart, LAS int* pcnt) {
    if (F.tid < 64) {
        const int c = (F.lane < 16) ? (int)__hip_atomic_load(F.ctl + CW_CNT + (l * 16 + F.lane) * 64, __ATOMIC_RELAXED, __HIP_MEMORY_SCOPE_AGENT) : 0;
        const int p = (c + 255) & ~255; int incl = p;
#pragma unroll
        for (int o = 1; o < 16; o <<= 1) { const int t = __shfl_up(incl, o); if (F.lane >= o) incl += t; }
        if (F.lane < 16) { pend[F.lane] = incl; pstart[F.lane] = incl - p; pcnt[F.lane] = c; }
    }
    __syncthreads();
    return __builtin_amdgcn_readfirstlane(pend[15] >> 8);
}

__device__ __forceinline__ void attn_phase(Frame& F, int l) {
    const int bx = blockIdx.x; const int vcu = (F.G % 8 == 0) ? (bx % 8) * (F.G / 8) + bx / 8 : bx;
    char* shm = (char*)F.ldsg;
    for (int U = vcu; U < NB * NH * (SEQ / 256); U += F.G) {
        const int h = U >> 8, b = (U & 255) >> 5, qb = U & 31;
        const size_t qrow = (size_t)b * SEQ + (size_t)qb * 256;
        attn_body::attn_unit<8>(F_Q + qrow * AW + h * 64, F_KB + (size_t)b * KVS * KVW + (h >> 2) * 64, F_VB + (size_t)b * KVS * KVW + (h >> 2) * 64, F_CAT + qrow * D + h * 64, KVS / 64, shm, F.tid);
    }
    if (ctx_out_l(l)) {
        for (int V = vcu; V < 8 * 32; V += F.G) {
            const int b = V >> 5, h = V & 31; if (h >= NH) continue;
            const size_t qrow = (size_t)NLAT + (size_t)b * CTXL; const size_t kv0 = (size_t)b * KVS + SEQ;
            attn_body::attn_unit<8>(F_Q + qrow * AW + h * 64, F_KB + kv0 * KVW + (h >> 2) * 64, F_VB + kv0 * KVW + (h >> 2) * 64, F_CAT + qrow * D + h * 64, CTXL / 64, shm, F.tid);
        }
    }
}
__device__ __forceinline__ float cv_ld(const bf16* AG, int s0, int len, int p, int ch) {
    const bool ok = p >= 0 && p < len; const int pc = p < 0 ? 0 : (p >= len ? len - 1 : p);
    const bf16* rp = AG + (size_t)(s0 + pc) * CAW; asm volatile("" : "+s"(rp));
    const float v = __uint_as_float((unsigned)((const GAS bf16*)rp)[ch] << 16);
    return ok ? v : 0.f;
}
__device__ __forceinline__ void conv_unit(Frame& F, const float* dw, const float* db, const float* lg, const float* lb, int s0, int len, int t0, int nchunk) {
    const int ch = F.wave * 64 + F.lane;
    float* ytile = (float*)F.ldsg;
    float w[31];
#pragma unroll
    for (int k = 0; k < 31; ++k) w[k] = dw[k * CAW + ch];
    const float bias = db[ch];
    const bf16* agb = F_AG;
#define CV_LD(p) cv_ld(agb, s0, len, (p), ch)
    float lo[32], hi[32];
#pragma unroll
    for (int i = 0; i < 32; ++i) { lo[i] = CV_LD(t0 - 16 + i); hi[i] = CV_LD(t0 + 16 + i); }
    const f32x4 g0 = *(const f32x4*)(lg + F.lane * 4), g1 = *(const f32x4*)(lg + 256 + F.lane * 4), b0 = *(const f32x4*)(lb + F.lane * 4), b1 = *(const f32x4*)(lb + 256 + F.lane * 4);
    for (int c = 0; c < nchunk; ++c) {
        const int T = t0 + 32 * c;
        float* yb = ytile + (c & 1) * (32 * 512);
#pragma unroll
        for (int u = 0; u < 32; ++u) { float acc = bias;
#pragma unroll
            for (int k = 0; k < 31; ++k) { const int e = u + k + 1; acc += w[k] * (e < 32 ? lo[e & 31] : hi[e & 31]); }
            yb[u * 512 + ch] = acc; }
#pragma unroll
        for (int i = 0; i < 32; ++i) { lo[i] = hi[i]; hi[i] = CV_LD(T + 48 + i); }
        __syncthreads();
#pragma unroll
        for (int rr = 0; rr < 4; ++rr) { const int u = F.wave * 4 + rr; const size_t row = (size_t)s0 + T + u;
            f32x4 y0 = *(const f32x4*)(yb + u * 512 + F.lane * 4), y1 = *(const f32x4*)(yb + u * 512 + 256 + F.lane * 4);
            const float mean = wave_sum((y0[0] + y0[1]) + (y0[2] + y0[3]) + (y1[0] + y1[1]) + (y1[2] + y1[3])) * (1.0f / CAW);
            y0 = y0 - mean; y1 = y1 - mean;
            const float rstd = __builtin_amdgcn_rsqf(wave_sum((y0[0] * y0[0] + y0[1] * y0[1]) + (y0[2] * y0[2] + y0[3] * y0[3]) + (y1[0] * y1[0] + y1[1] * y1[1]) + (y1[2] * y1[2] + y1[3] * y1[3])) * (1.0f / CAW) + EPS);
            y0 = y0 * rstd * g0 + b0; y1 = y1 * rstd * g1 + b1;
            *(u32x2*)(F_CAT + row * D + AW + F.lane * 4) = (u32x2){pk2(siluf_(y0[0]), siluf_(y0[1])), pk2(siluf_(y0[2]), siluf_(y0[3]))};
            *(u32x2*)(F_CAT + row * D + AW + 256 + F.lane * 4) = (u32x2){pk2(siluf_(y1[0]), siluf_(y1[1])), pk2(siluf_(y1[2]), siluf_(y1[3]))}; }
    }
#undef CV_LD
    __syncthreads();
}
__device__ __forceinline__ void conv_phase(Frame& F, int l) {
    const int i = l >> 1;
    const float* dw = F_ev_dw_w + (size_t)i * 31 * CAW; const float* db = F_ev_dw_b + i * CAW; const float* lg = F_ev_ln_g + i * CAW; const float* lb = F_ev_ln_b + i * CAW;
    const int nu = NLAT / 128 + (ctx_out_l(l) ? NCTX / 128 : 0);
    for (int U = blockIdx.x; U < nu; U += F.G) {
        int s0, len, t0;
        if (U < NLAT / 128) { s0 = (U >> 6) * SEQ; len = SEQ; t0 = (U & 63) * 128; } else { const int V = U - NLAT / 128; s0 = NLAT + (V >> 1) * CTXL; len = CTXL; t0 = (V & 1) * 128; }
        conv_unit(F, dw, db, lg, lb, s0, len, t0, 4);
    }
}
__device__ __forceinline__ void sconv_phase(Frame& F, int l) {
    const int i = l >> 1; const int nrows = NLAT + (ctx_out_l(l) ? NCTX : 0);
    const float* cw = F_od_conv_w + (size_t)i * 3 * D;
    const int c0 = F.lane * 8, c1 = 512 + F.lane * 8;
    f32x4 w[3][4];
#pragma unroll
    for (int k = 0; k < 3; ++k) { w[k][0] = *(const f32x4*)(cw + k * D + c0); w[k][1] = *(const f32x4*)(cw + k * D + c0 + 4); w[k][2] = *(const f32x4*)(cw + k * D + c1); w[k][3] = *(const f32x4*)(cw + k * D + c1 + 4); }
    for (int r = F.gw * 2; r < nrows; r += F.NGW * 2) {
        int s0, len; if (r < NLAT) { s0 = r & ~(SEQ - 1); len = SEQ; } else { s0 = NLAT + ((r - NLAT) & ~255); len = CTXL; }
        const int pos = r - s0;
        u32x4 uu[4][2], gb[2][2];
#pragma unroll
        for (int k = 0; k < 4; ++k) { const int p = pos + k - 1; const int pc = p < 0 ? 0 : (p >= len ? len - 1 : p); const bf16* ur = F_U + (size_t)(s0 + pc) * D;
            uu[k][0] = __builtin_nontemporal_load((const u32x4*)(ur + c0)); uu[k][1] = __builtin_nontemporal_load((const u32x4*)(ur + c1)); }
#pragma unroll
        for (int j = 0; j < 2; ++j) { gb[j][0] = __builtin_nontemporal_load((const u32x4*)(F_GB + (size_t)(r + j) * D + c0)); gb[j][1] = __builtin_nontemporal_load((const u32x4*)(F_GB + (size_t)(r + j) * D + c1)); }
        float uf[4][16];
#pragma unroll
        for (int k = 0; k < 4; ++k) { const int p = pos + k - 1; const bool ok = p >= 0 && p < len; unpack8(uu[k][0], uf[k]); unpack8(uu[k][1], uf[k] + 8);
            if (!ok) {
#pragma unroll
                for (int c = 0; c < 16; ++c) uf[k][c] = 0.f; } }
#pragma unroll
        for (int j = 0; j < 2; ++j) { float g[16], y[16]; unpack8(gb[j][0], g); unpack8(gb[j][1], g + 8);
#pragma unroll
            for (int c = 0; c < 16; ++c) { const int q = c >> 2, e = c & 3; y[c] = g[c] * (w[0][q][e] * uf[j][c] + w[1][q][e] * uf[j + 1][c] + w[2][q][e] * uf[j + 2][c]); }
            *(u32x4*)(F_SB + (size_t)(r + j) * D + c0) = pack8(y); *(u32x4*)(F_SB + (size_t)(r + j) * D + c1) = pack8(y + 8); }
    }
}

#ifndef PROBE
#define PROBE (-1)
#endif
#ifndef ONLY
#define ONLY (-1)
#endif
constexpr int PPL = 9, NPH = 1 + DEPTH * PPL + 1;
__global__ void __launch_bounds__(NTHR, 2) fwd(Args args) {
    extern __shared__ __attribute__((aligned(16))) unsigned char lds_[];
    Frame F;
    F.lds = (LAS unsigned char*)lds_; F.ldsg = lds_;
    F.MISC = (volatile LAS unsigned*)(F.lds + MISC_OFF);
    F.tid = threadIdx.x; F.lane = F.tid & 63; F.wave = __builtin_amdgcn_readfirstlane(F.tid >> 6);
    const int wave0 = F.wave;
#define MY_TID() (wave0 * 64 + (int)__builtin_amdgcn_mbcnt_hi(~0u, __builtin_amdgcn_mbcnt_lo(~0u, opaque_zero())))
    F.G = gridDim.x; F.gw = blockIdx.x * NWAVES + F.wave; F.NGW = F.G * NWAVES;
    F.ws = args.ws; F.ctl = (unsigned*)(args.ws + WS_CTL); F.out = args.out; F.in = args.in;
    for (int u = F.tid; u < (LDS_BYTES - LDSCTL_OFF) / 4; u += NTHR) ((LAS unsigned*)(F.lds + LDSCTL_OFF))[u] = 0u;
    __syncthreads();
    const int lo = args.ph_lo, hi = args.ph_hi;
    const int bar_off = args.dry ? 16384 : CW_BAR;
    XcdBarrier bar; bar.bar = F.ctl + bar_off; bar.x = 0; bar.st = F.MISC + 8;
    if (hi - lo > 1) bar = xcd_barrier_post(F.ctl + bar_off, F.MISC + 8, F.tid);
#define IN(k) (lo <= (k) && (k) < hi)
#define EN(id) (ONLY < 0 || ONLY == (id))
#define PH(id, k) for (int rp_ = 0; rp_ < ((PROBE == (id)) ? 2 : 1); ++rp_) if (EN(id) && IN(k))
#define PB() do { if (rp_) __syncthreads(); int t_ = MY_TID(); asm volatile("" : "+v"(t_)); F.tid = t_; F.lane = t_ & 63; F.wave = __builtin_amdgcn_readfirstlane(t_ >> 6); F.gw = blockIdx.x * NWAVES + F.wave; \
    F.ws = args.ws; F.in = args.in; F.out = args.out; { unsigned long long w_ = rfl64((unsigned long long)F.ws), o_ = rfl64((unsigned long long)F.out); asm volatile("" : "+s"(w_), "+s"(o_)); w_ = rfl64(w_); o_ = rfl64(o_); F.ws = (unsigned char*)(GAS unsigned char*)w_; F.out = (float*)(GAS float*)o_; F.xw = args.dry ? (float*)(F.ws + WS_Q) : F.out; } F.ctl = (unsigned*)(F.ws + WS_CTL); } while (0)
#define SEAM(k) do { if (IN(k) && IN((k) + 1)) { unsigned long long b_ = rfl64((unsigned long long)((unsigned*)(args.ws + WS_CTL) + bar_off)); asm volatile("" : "+s"(b_)); bar.bar = (unsigned*)(GAS unsigned*)rfl64(b_); xcd_barrier(bar, MY_TID()); if (PROBE == 200) xcd_barrier(bar, MY_TID()); } } while (0)

#if PROBE >= 300 && PROBE < 400
    {
        int rp_ = 0; PB();
        float* dstp = (float*)(F.ws + WS_P);
        const float* srcp = (const float*)(F.ws + WS_Q);
#if PROBE == 300
        for (int ch = F.gw; ch < NLAT / 4; ch += F.NGW) { f32x4 v[4][4];
#pragma unroll
            for (int j = 0; j < 4; ++j)
#pragma unroll
                for (int q = 0; q < 4; ++q) v[j][q] = __builtin_nontemporal_load((const f32x4*)(srcp + (size_t)(ch * 4 + j) * D + F.lane * 4 + 256 * q));
#pragma unroll
            for (int j = 0; j < 4; ++j)
#pragma unroll
                for (int q = 0; q < 4; ++q) __builtin_nontemporal_store(v[j][q], (f32x4*)(dstp + (size_t)(ch * 4 + j) * D + F.lane * 4 + 256 * q)); }
#elif PROBE == 301
        for (int ch = F.gw; ch < NLAT / 8; ch += F.NGW) { f32x4 v[8][4];
#pragma unroll
            for (int j = 0; j < 8; ++j)
#pragma unroll
                for (int q = 0; q < 4; ++q) v[j][q] = __builtin_nontemporal_load((const f32x4*)(srcp + (size_t)(ch * 8 + j) * D + F.lane * 4 + 256 * q));
#pragma unroll
            for (int j = 0; j < 8; ++j)
#pragma unroll
                for (int q = 0; q < 4; ++q) __builtin_nontemporal_store(v[j][q], (f32x4*)(dstp + (size_t)(ch * 8 + j) * D + F.lane * 4 + 256 * q)); }
#elif PROBE == 302
        for (int ch = F.gw; ch < NLAT / 4; ch += F.NGW) { f32x4 v[4][4];
#pragma unroll
            for (int j = 0; j < 4; ++j)
#pragma unroll
                for (int q = 0; q < 4; ++q) v[j][q] = *(const f32x4*)(srcp + (size_t)(ch * 4 + j) * D + F.lane * 4 + 256 * q);
#pragma unroll
            for (int j = 0; j < 4; ++j)
#pragma unroll
                for (int q = 0; q < 4; ++q) *(f32x4*)(dstp + (size_t)(ch * 4 + j) * D + F.lane * 4 + 256 * q) = v[j][q]; }
#elif PROBE == 303
        { f32x4 acc = {0.f, 0.f, 0.f, 0.f};
        for (int ch = F.gw; ch < NLAT / 4; ch += F.NGW) { f32x4 v[4][4];
#pragma unroll
            for (int j = 0; j < 4; ++j)
#pragma unroll
                for (int q = 0; q < 4; ++q) v[j][q] = __builtin_nontemporal_load((const f32x4*)(srcp + (size_t)(ch * 4 + j) * D + F.lane * 4 + 256 * q));
#pragma unroll
            for (int j = 0; j < 4; ++j)
#pragma unroll
                for (int q = 0; q < 4; ++q) acc += v[j][q]; }
        *(f32x4*)(dstp + (size_t)F.gw * 256 + F.lane * 4) = acc; }
#endif
        __syncthreads();
    }
#endif
    PH(100, 0) { PB(); prologue(F); }
    SEAM(0);
    for (int l = 0; l < DEPTH; ++l) {
        const int pb = 1 + l * PPL; const bool even = !(l & 1); const int li = l >> 1;
        for (int rp_ = 0; rp_ < ((PROBE == 10 && l == 0) ? 2 : 1); ++rp_) if (EN(10) && IN(pb + 0)) { PB(); norm1_phase(F, l, false); }
        SEAM(pb + 0);
        PH(1, pb + 1) {
            PB();
            if (even) {
                pg8::EvenInOrder S; S.d.init(NLAT, EVIN, D, F_W_EVIN + (size_t)li * EVIN * D, F.G, (int)blockIdx.x); S.kvonly = !ctx_out_l(l);
                pg8::EpiEvenIn E{F_Q, F_KB, F_VB, F_AG, F_ev_qg + li * 64, F_ev_kg + li * 64, F_ROPE};
                pg8::gemm_phase<pg8::EpiEvenIn, pg8::EvenInOrder>(F.lds, F_HB, D, S, E, F.tid);
            } else {
                const int M = NLAT + (ctx_out_l(l) ? NCTX : 0);
                pg8::DenseOrder S; S.init(M, ODIN, D, F_W_ODIN + (size_t)li * ODIN * D, F.G, (int)blockIdx.x);
                pg8::EpiOddIn E{F_U, F_GB};
                pg8::gemm_phase<pg8::EpiOddIn, pg8::DenseOrder>(F.lds, F_HB, D, S, E, F.tid);
            }
        }
        if (IN(pb + 1) && IN(pb + 3)) { unsigned long long b_ = rfl64((unsigned long long)((unsigned*)(args.ws + WS_CTL) + bar_off)); asm volatile("" : "+s"(b_)); bar.bar = (unsigned*)(GAS unsigned*)rfl64(b_); xcd_barrier(bar, MY_TID()); if (PROBE == 200) xcd_barrier(bar, MY_TID()); }
        if (even) {
            PH(30, pb + 3) { PB(); attn_phase(F, l); }
            PH(31, pb + 3) { PB(); conv_phase(F, l); }
        } else {
            PH(32, pb + 3) { PB(); sconv_phase(F, l); }
        }
        SEAM(pb + 3);
        PH(4, pb + 4) {
            PB();
            const int M = NLAT + (ctx_out_l(l) ? NCTX : 0);
            pg8::DenseOrder S; S.init(M, D, D, even ? F_W_EVOUT + (size_t)li * D * D : F_W_ODOUT + (size_t)li * D * D, F.G, (int)blockIdx.x);
            pg8::EpiPlain E{F_OX, D};
            pg8::gemm_phase<pg8::EpiPlain, pg8::DenseOrder>(F.lds, even ? F_CAT : F_SB, D, S, E, F.tid);
        }
        SEAM(pb + 4);
        PH(5, pb + 5) { PB(); norm2_phase(F, l); }
        if (IN(pb + 5) && IN(pb + 7)) { unsigned long long b_ = rfl64((unsigned long long)((unsigned*)(args.ws + WS_CTL) + bar_off)); asm volatile("" : "+s"(b_)); bar.bar = (unsigned*)(GAS unsigned*)rfl64(b_); xcd_barrier(bar, MY_TID()); }
        PH(7, pb + 7) {
            PB();
            LAS int* pend = (LAS int*)(F.lds + LDSCTL_OFF); LAS int* pstart = pend + 16; LAS int* pcnt = pend + 32;
            const int nblk = moe_prefix(F, l, pend, pstart, pcnt);
            pg8::MoeOrder<true> S; S.nblk = nblk; S.G = F.G; S.c = (F.G % 8 == 0) ? (int)((blockIdx.x % 8) * (F.G / 8) + blockIdx.x / 8) : (int)blockIdx.x;     S.K = D; S.Bt = F_W_MOE1 + (size_t)l * NE * D * D; S.estride = (size_t)D * D * 2; S.pend = pend; S.rowtok = F_ROWTOK;
            pg8::EpiSwiGLU E{F_HMID};
            pg8::gemm_phase<pg8::EpiSwiGLU, pg8::MoeOrder<true>>(F.lds, F_HB, D, S, E, F.tid);
        }
        SEAM(pb + 7);
        PH(8, pb + 8) {
            PB();
            LAS int* pend = (LAS int*)(F.lds + LDSCTL_OFF); LAS int* pstart = pend + 16; LAS int* pcnt = pend + 32;
            const int nblk = moe_prefix(F, l, pend, pstart, pcnt);
            pg8::MoeOrder<false> S; S.nblk = nblk; S.G = F.G; S.c = (F.G % 8 == 0) ? (int)((blockIdx.x % 8) * (F.G / 8) + blockIdx.x / 8) : (int)blockIdx.x;     S.K = DE; S.Bt = F_W_MOE2 + (size_t)l * NE * D * DE; S.estride = (size_t)D * DE * 2; S.pend = pend; S.rowtok = nullptr;
            pg8::EpiPlain E{F_Y, D};
            pg8::gemm_phase<pg8::EpiPlain, pg8::MoeOrder<false>>(F.lds, F_HMID, DE, S, E, F.tid);
        }
        SEAM(pb + 8);
    }
    PH(11, NPH - 1) { PB(); norm1_phase(F, DEPTH, true); }
#undef IN
#undef SEAM
}

extern "C" void kernel_launch(void* const* d_in, const int* in_sizes, int n_in, void* d_out, int out_size, void* d_ws, size_t ws_size, hipStream_t stream) {
    static int grid = 0;
    if (grid == 0) {
        if (n_in != 24 || in_sizes[0] != NLAT * D || out_size != NLAT * D || ws_size < WS_END) { fprintf(stderr, "kernel_launch: unexpected shapes (n_in %d, in0 %d, out %d, ws %zu); nothing launched\n", n_in, n_in > 0 ? in_sizes[0] : -1, out_size, ws_size); grid = -1; return; }
        int dev = 0, cus = 0, per_cu = 0;
        if (hipGetDevice(&dev) != hipSuccess || hipDeviceGetAttribute(&cus, hipDeviceAttributeMultiprocessorCount, dev) != hipSuccess) { grid = -1; return; }
        if (hipFuncSetAttribute((const void*)fwd, hipFuncAttributeMaxDynamicSharedMemorySize, LDS_BYTES) != hipSuccess) { fprintf(stderr, "kernel_launch: hipFuncSetAttribute failed\n"); grid = -1; return; }
        if (hipOccupancyMaxActiveBlocksPerMultiprocessor(&per_cu, (const void*)fwd, NTHR, LDS_BYTES) != hipSuccess || per_cu < 1) fprintf(stderr, "kernel_launch: occupancy query reports %d\n", per_cu);
        (void)hipGetLastError();
        grid = cus;
    }
    if (grid < 0) return;
    if (hipMemsetAsync((char*)d_ws + WS_CTL, 0, CTL_ZERO_BYTES, stream) != hipSuccess) return;
    Args a{};
    for (int i = 0; i < 24; ++i) a.in[i] = (const float*)d_in[i];
    a.out = (float*)d_out; a.ws = (unsigned char*)d_ws;
#if MK_ONE_LAUNCH
#if defined(PROBE_CUM)
    a.ph_lo = 0; a.ph_hi = PROBE_CUM;
    hipLaunchKernelGGL(fwd, dim3(grid), dim3(NTHR), LDS_BYTES, stream, a);
    if (hipMemsetAsync((char*)d_ws + WS_CTL, 0, CTL_ZERO_BYTES, stream) != hipSuccess) return;
#endif
    a.ph_lo = 0; a.ph_hi = NPH;
    hipLaunchKernelGGL(fwd, dim3(grid), dim3(NTHR), LDS_BYTES, stream, a);
#if defined(PROBE_DRY)
#ifndef PROBE_DRY_N
#define PROBE_DRY_N 1
#endif
    a.ph_lo = PROBE_DRY; a.ph_hi = PROBE_DRY + PROBE_DRY_N; a.dry = 1;
    hipLaunchKernelGGL(fwd, dim3(grid), dim3(NTHR), LDS_BYTES, stream, a);
#endif
#else
    for (int p = 0; p < NPH; ++p) {
        if (p >= 1 && p < NPH - 1) { const int l = (p - 1) / PPL, k = (p - 1) % PPL; (void)l; if (k == 2 || k == 6) continue; }
        a.ph_lo = p; a.ph_hi = p + 1;
        hipLaunchKernelGGL(fwd, dim3(grid), dim3(NTHR), LDS_BYTES, stream, a);
    }
#endif
}
```

```cpp
#include <hip/hip_runtime.h>
#include <cstdio>
#include <cstdint>

#ifndef MK_ONE_LAUNCH
#define MK_ONE_LAUNCH 1
#endif

#define LAS __attribute__((address_space(3)))
#define GAS __attribute__((address_space(1)))
typedef unsigned short bf16;
typedef short bf16x8 __attribute__((ext_vector_type(8)));
typedef float f32x4 __attribute__((ext_vector_type(4)));
typedef float f32x2 __attribute__((ext_vector_type(2)));
typedef unsigned u32x4 __attribute__((ext_vector_type(4)));
typedef unsigned u32x2 __attribute__((ext_vector_type(2)));
typedef __bf16 bf16x2_t __attribute__((ext_vector_type(2)));

constexpr int D = 1024, NB = 8, SEQ = 8192, NLAT = NB * SEQ, CTXL = 256, NCTX = NB * CTXL, TALL = NLAT + NCTX, ZROW = TALL;
constexpr int KVS = SEQ + CTXL;
constexpr int NH = 8, NKVH = 2, HD = 64, AW = 512, KVW = 128, CAW = 512, EVIN = 1792, ODIN = 3072;
constexpr int NE = 16, DE = 512, MAXBLK = 544, MAXROWS = MAXBLK * 256, VCAP = 2 * TALL;
constexpr int DEPTH = 4;
constexpr float EPS = 1e-6f;
constexpr float C2 = 0.125f * 1.4426950408889634f;

constexpr size_t MiB = 1u << 20;
constexpr size_t WS_CTL = 0, CTL_ZERO_BYTES = 128 * 1024;
constexpr size_t WS_MOD = 1 * MiB;
constexpr size_t WS_ROPE = 2 * MiB;
constexpr size_t WS_RT = 3 * MiB;
constexpr size_t WS_DEST = 5 * MiB;
constexpr size_t WS_WB = 6 * MiB;
constexpr size_t WS_ROWTOK = 931 * MiB;
constexpr size_t WS_Z = 8 * MiB;
constexpr size_t WS_W_EVIN = 16 * MiB, WS_W_EVOUT = 23 * MiB, WS_W_ODIN = 27 * MiB, WS_W_ODOUT = 39 * MiB, WS_W_MOE1 = 43 * MiB, WS_W_MOE2 = 171 * MiB;
constexpr size_t WS_HB = 236 * MiB;
constexpr size_t WS_BIG = 369 * MiB;
constexpr size_t WS_P = WS_BIG, WS_CAT = WS_BIG, WS_OX = 501 * MiB, WS_HMID = WS_BIG, WS_Y = 505 * MiB;
constexpr size_t WS_Q = 765 * MiB, WS_K = 831 * MiB, WS_V = 848 * MiB, WS_AG = 865 * MiB, WS_S = 765 * MiB;
constexpr size_t WS_U = WS_BIG, WS_GB = 633 * MiB;
constexpr size_t WS_END = 940 * MiB;
constexpr int CW_TMO = 0, CW_CODE = 1, CW_BAR = 4096, CW_CNT = 8192;

constexpr int RING_BYTES = 131072, LDSCTL_OFF = RING_BYTES, MISC_OFF = LDSCTL_OFF + 320, LDS_BYTES = 147456;
constexpr int NWAVES = 8, NTHR = 512;

__device__ __forceinline__ unsigned pk2(float lo, float hi) { f32x2 v = {lo, hi}; bf16x2_t b = __builtin_convertvector(v, bf16x2_t); return __builtin_bit_cast(unsigned, b); }
__device__ __forceinline__ float bflo(unsigned w) { return __uint_as_float(w << 16); }
__device__ __forceinline__ float bfhi(unsigned w) { return __uint_as_float(w & 0xffff0000u); }
__device__ __forceinline__ void unpack8(const u32x4 w, float* f) { f[0] = bflo(w.x); f[1] = bfhi(w.x); f[2] = bflo(w.y); f[3] = bfhi(w.y); f[4] = bflo(w.z); f[5] = bfhi(w.z); f[6] = bflo(w.w); f[7] = bfhi(w.w); }
__device__ __forceinline__ u32x4 pack8(const float* f) { u32x4 w; w.x = pk2(f[0], f[1]); w.y = pk2(f[2], f[3]); w.z = pk2(f[4], f[5]); w.w = pk2(f[6], f[7]); return w; }
__device__ __forceinline__ float wave_sum(float v) {
#pragma unroll
    for (int o = 1; o < 64; o <<= 1) v += __shfl_xor(v, o);
    return v;
}
__device__ __forceinline__ float fast_exp2(float x) { return __builtin_amdgcn_exp2f(x); }
__device__ __forceinline__ float fast_rcp(float x) { return __builtin_amdgcn_rcpf(x); }
__device__ __forceinline__ float sigmoidf_(float x) { return fast_rcp(1.0f + fast_exp2(-1.4426950408889634f * x)); }
__device__ __forceinline__ float siluf_(float x) { return x * sigmoidf_(x); }
__device__ __forceinline__ unsigned opaque_zero() { unsigned z = 0u; asm volatile("" : "+v"(z)); return z; }
__device__ __forceinline__ unsigned long long rfl64(unsigned long long v) { const unsigned lo = __builtin_amdgcn_readfirstlane((unsigned)v), hi = __builtin_amdgcn_readfirstlane((unsigned)(v >> 32)); return ((unsigned long long)hi << 32) | lo; }
#define LDS_WAIT() asm volatile("s_waitcnt lgkmcnt(0)" ::: "memory")

namespace pg8 {
constexpr int BM = 256, BK = 64, HALF = 128, HTB = HALF * BK * 2, STAGE_BYTES = 8 * HTB, NXCD = 8, WGM = 8;
__host__ __device__ __forceinline__ int lds_byte(int r, int c) { const int st = (r >> 4) * 2 + (c >> 5), rr = r & 15, cc = c & 31, ob = rr * 64 + cc * 2; return st * 1024 + (ob ^ (((ob >> 9) & 1) << 5)); }
__host__ __device__ __forceinline__ void stage_rc(int b, int& R, int& C) { const int st = b / 1024, sb = b % 1024, swz = sb ^ (((sb >> 9) & 1) << 5); R = (st >> 1) * 16 + swz / 64; C = (st & 1) * 32 + (swz % 64) / 2; }
__host__ __device__ __forceinline__ int perm32(int rho) { const int n = rho >> 4, i = rho & 15; return 8 * (i >> 2) + 4 * n + (i & 3); }

struct Unit { int pm, pn, e; };

struct DenseOrder {
    int nM, nN, nwg, G, c, K; const bf16* Bt;
    __device__ void init(int M, int N, int K_, const bf16* Bt_, int G_, int c_) { nM = M / BM; nN = N / BM; nwg = nM * nN; G = G_; c = c_; K = K_; Bt = Bt_; }
    __device__ bool next(int i, Unit& u) const {
        const long L = (long)i * G + c; if (L >= nwg) return false;
        int wgid = (int)L; { const int q = nwg / NXCD, r = nwg % NXCD, xcd = wgid % NXCD, off = wgid / NXCD; wgid = (xcd < r ? xcd * (q + 1) : r * (q + 1) + (xcd - r) * q) + off; }
        const int nig = WGM * nN, gid = wgid / nig, fm = gid * WGM, gsz = (nM - fm) < WGM ? (nM - fm) : WGM;
        u.pm = fm + ((wgid % nig) % gsz); u.pn = (wgid % nig) / gsz; u.e = 0; return true;
    }
    __device__ __forceinline__ const char* bbase(const Unit& u) const { return (const char*)Bt + (size_t)u.pn * 256 * K * 2; }
    __device__ __forceinline__ void aoffs(const Unit& u, const int (&Rr)[2], const int (&Cc)[2], unsigned (&a)[2][2]) const {
#pragma unroll
        for (int h = 0; h < 2; ++h)
#pragma unroll
            for (int i = 0; i < 2; ++i) a[h][i] = (unsigned)((u.pm * 256 + h * 128 + Rr[i]) * K + Cc[i]) * 2u;
    }
    __device__ __forceinline__ void tok_load(const Unit&, const int (&)[2], unsigned (&)[2][2]) const {}
    __device__ __forceinline__ void aoffs_from(const Unit& u, const int (&Rr)[2], const int (&Cc)[2], const unsigned (&)[2][2], unsigned (&a)[2][2]) const { aoffs(u, Rr, Cc, a); }
};
template <bool GATHER> struct MoeOrder {
    int nblk, G, c, K; const bf16* Bt; size_t estride; const LAS int* pend; const unsigned* rowtok;
    __device__ bool next(int i, Unit& u) const {
        const long L = (long)i * G + c; if (L >= (long)nblk * 4) return false;
        u.pm = (int)(L >> 2); u.pn = (int)(L & 3); const int r0 = u.pm * 256; int e = 0;
#pragma unroll
        for (int j = 0; j < 15; ++j) e += (r0 >= pend[j]) ? 1 : 0;
        u.e = __builtin_amdgcn_readfirstlane(e); return true;
    }
    __device__ __forceinline__ const char* bbase(const Unit& u) const { return (const char*)Bt + (size_t)u.e * estride + (size_t)u.pn * 256 * K * 2; }
    __device__ __forceinline__ void tok_load(const Unit& u, const int (&Rr)[2], unsigned (&raw)[2][2]) const {
#pragma unroll
        for (int h = 0; h < 2; ++h)
#pragma unroll
            for (int i = 0; i < 2; ++i) { const int row = u.pm * 256 + h * 128 + Rr[i];
                raw[h][i] = GATHER ? rowtok[(size_t)u.e * VCAP + (row - pend[16 + u.e])] : (unsigned)row; }
    }
    __device__ __forceinline__ void aoffs_from(const Unit& u, const int (&Rr)[2], const int (&Cc)[2], const unsigned (&raw)[2][2], unsigned (&a)[2][2]) const {
#pragma unroll
        for (int h = 0; h < 2; ++h)
#pragma unroll
            for (int i = 0; i < 2; ++i) { unsigned src = raw[h][i];
                if (GATHER) { const int rin = u.pm * 256 + h * 128 + Rr[i] - pend[16 + u.e]; src = rin < pend[32 + u.e] ? src : (unsigned)ZROW; }
                a[h][i] = (src * (unsigned)K + (unsigned)Cc[i]) * 2u; }
    }
    __device__ __forceinline__ void aoffs(const Unit& u, const int (&Rr)[2], const int (&Cc)[2], unsigned (&a)[2][2]) const { unsigned raw[2][2]; tok_load(u, Rr, raw); aoffs_from(u, Rr, Cc, raw, a); }
};

struct EpiPlain {
    bf16* O; int ldc;
    __device__ __forceinline__ void operator()(const f32x4 (&acc)[2][2][4][2], const Unit& u, int wr, int wc, int fr, int fq) const {
        const int row0 = u.pm * BM + wr * 64 + fr, col0 = u.pn * BM + wc * 32 + 8 * fq;
#pragma unroll
        for (int ai = 0; ai < 2; ++ai)
#pragma unroll
            for (int m = 0; m < 4; ++m) { bf16* rowp = O + (size_t)(row0 + ai * HALF + m * 16) * ldc + col0;
#pragma unroll
                for (int bj = 0; bj < 2; ++bj) { const f32x4 v0 = acc[ai][bj][m][0], v1 = acc[ai][bj][m][1];
                    u32x4 w; w.x = pk2(v0[0], v0[1]); w.y = pk2(v0[2], v0[3]); w.z = pk2(v1[0], v1[1]); w.w = pk2(v1[2], v1[3]);
                    *(u32x4*)(rowp + bj * HALF) = w; } }
    }
};
struct EpiSwiGLU {
    bf16* H;
    __device__ __forceinline__ void operator()(const f32x4 (&acc)[2][2][4][2], const Unit& u, int wr, int wc, int fr, int fq) const {
        const int row0 = u.pm * BM + wr * 64 + fr, col0 = u.pn * 128 + wc * 32 + 8 * fq;
#pragma unroll
        for (int ai = 0; ai < 2; ++ai)
#pragma unroll
            for (int m = 0; m < 4; ++m) { bf16* rowp = H + (size_t)(row0 + ai * HALF + m * 16) * DE + col0;
                float o[8];
#pragma unroll
                for (int n = 0; n < 2; ++n)
#pragma unroll
                    for (int j = 0; j < 4; ++j) { const float g = acc[ai][0][m][n][j], up = acc[ai][1][m][n][j]; o[n * 4 + j] = siluf_(g) * up; }
                *(u32x4*)rowp = pack8(o); }
    }
};

struct EpiEvenIn {
    bf16 *Q, *KB, *VB, *AG; const float* qg; const float* kg; const f32x2* rope;
    __device__ __forceinline__ void operator()(const f32x4 (&acc)[2][2][4][2], const Unit& u, int wr, int wc, int fr, int fq) const {
        const int row0 = u.pm * BM + wr * 64 + fr;
        if (u.pn >= 3) {
            const int col0 = (u.pn - 3) * 128 + wc * 32 + 8 * fq;
#pragma unroll
            for (int ai = 0; ai < 2; ++ai)
#pragma unroll
                for (int m = 0; m < 4; ++m) { float o[8];
#pragma unroll
                    for (int n = 0; n < 2; ++n)
#pragma unroll
                        for (int j = 0; j < 4; ++j) o[n * 4 + j] = acc[ai][0][m][n][j] * sigmoidf_(acc[ai][1][m][n][j]);
                    *(u32x4*)(AG + (size_t)(row0 + ai * HALF + m * 16) * CAW + col0) = pack8(o); }
            return;
        }
        if (u.pn == 2 && wc >= 2) {
#pragma unroll
            for (int ai = 0; ai < 2; ++ai)
#pragma unroll
                for (int m = 0; m < 4; ++m) { const int row = row0 + ai * HALF + m * 16;
                    const size_t kvrow = row < NLAT ? (size_t)(row >> 13) * KVS + (row & (SEQ - 1)) : (size_t)((row - NLAT) >> 8) * KVS + SEQ + ((row - NLAT) & 255);
#pragma unroll
                    for (int bj = 0; bj < 2; ++bj) { float o[8];
#pragma unroll
                        for (int n = 0; n < 2; ++n)
#pragma unroll
                            for (int j = 0; j < 4; ++j) o[n * 4 + j] = acc[ai][bj][m][n][j];
                        *(u32x4*)(VB + kvrow * KVW + (wc - 2) * 64 + 32 * bj + 8 * fq) = pack8(o); } }
            return;
        }
        const bool isq = u.pn < 2; const float* g = isq ? qg : kg; const float post = isq ? C2 : 1.0f;
        f32x4 gv[2][2];
#pragma unroll
        for (int bj = 0; bj < 2; ++bj)
#pragma unroll
            for (int n = 0; n < 2; ++n) gv[bj][n] = *(const f32x4*)(g + 32 * bj + 8 * fq + 4 * n);
#pragma unroll
        for (int ai = 0; ai < 2; ++ai)
#pragma unroll
            for (int m = 0; m < 4; ++m) { const int row = row0 + ai * HALF + m * 16;
                float ss = 0.f;
#pragma unroll
                for (int bj = 0; bj < 2; ++bj)
#pragma unroll
                    for (int n = 0; n < 2; ++n) { const f32x4 x = acc[ai][bj][m][n]; ss += (x[0] * x[0] + x[1] * x[1]) + (x[2] * x[2] + x[3] * x[3]); }
                ss += __shfl_xor(ss, 16); ss += __shfl_xor(ss, 32);
                const float rstd = __builtin_amdgcn_rsqf(ss * (1.0f / 64.0f) + EPS);
                const bool isx = row < NLAT; const int pos = row & (SEQ - 1);
                bf16* dst; if (isq) dst = Q + (size_t)row * AW + (u.pn * 4 + wc) * 64;
                else { const size_t kvrow = isx ? (size_t)(row >> 13) * KVS + pos : (size_t)((row - NLAT) >> 8) * KVS + SEQ + ((row - NLAT) & 255); dst = KB + kvrow * KVW + wc * 64; }
#pragma unroll
                for (int bj = 0; bj < 2; ++bj) { float o[8];
                    const int ps = bj ? (pos & 63) : (pos >> 6);
#pragma unroll
                    for (int n = 0; n < 2; ++n) { f32x4 f = acc[ai][bj][m][n] * rstd * gv[bj][n];
                        if (isx) { const f32x4 cs = *(const f32x4*)(rope + ps * 16 + 4 * fq + 2 * n);
                            const float x0 = f[0], x1 = f[1], x2 = f[2], x3 = f[3];
                            f[0] = x0 * cs[0] - x1 * cs[1]; f[1] = x0 * cs[1] + x1 * cs[0]; f[2] = x2 * cs[2] - x3 * cs[3]; f[3] = x2 * cs[3] + x3 * cs[2]; }
                        o[n * 4 + 0] = f[0] * post; o[n * 4 + 1] = f[1] * post; o[n * 4 + 2] = f[2] * post; o[n * 4 + 3] = f[3] * post; }
                    *(u32x4*)(dst + 32 * bj + 8 * fq) = pack8(o); } }
    }
};
struct EpiOddIn {
    bf16 *U, *GB;
    __device__ __forceinline__ void operator()(const f32x4 (&acc)[2][2][4][2], const Unit& u, int wr, int wc, int fr, int fq) const {
        const int row0 = u.pm * BM + wr * 64 + fr;
#pragma unroll
        for (int ai = 0; ai < 2; ++ai)
#pragma unroll
            for (int m = 0; m < 4; ++m) { const size_t row = (size_t)(row0 + ai * HALF + m * 16);
                if (u.pn < 8) { float o[8];
#pragma unroll
                    for (int n = 0; n < 2; ++n)
#pragma unroll
                        for (int j = 0; j < 4; ++j) o[n * 4 + j] = acc[ai][0][m][n][j] * acc[ai][1][m][n][j];
                    *(u32x4*)(U + row * D + u.pn * 128 + wc * 32 + 8 * fq) = pack8(o);
                } else {
#pragma unroll
                    for (int bj = 0; bj < 2; ++bj) { float o[8];
#pragma unroll
                        for (int n = 0; n < 2; ++n)
#pragma unroll
                            for (int j = 0; j < 4; ++j) o[n * 4 + j] = acc[ai][bj][m][n][j];
                        *(u32x4*)(GB + row * D + (u.pn - 8) * 256 + bj * HALF + wc * 32 + 8 * fq) = pack8(o); } } }
    }
};
struct EvenInOrder {
    DenseOrder d; bool kvonly;
    __device__ bool next(int i, Unit& u) const {
        const long L = (long)i * d.G + d.c; const int nx = d.nwg;
        if (L < nx) return d.next(i, u);
        const int j = (int)(L - nx); const int nextra = kvonly ? (NCTX / 256) : (NCTX / 256) * 7; if (j >= nextra) return false;
        if (kvonly) { u.pm = NLAT / 256 + j; u.pn = 2; } else { u.pm = NLAT / 256 + j / 7; u.pn = j % 7; }
        u.e = 0; return true;
    }
    __device__ __forceinline__ const char* bbase(const Unit& u) const { return d.bbase(u); }
    __device__ __forceinline__ void aoffs(const Unit& u, const int (&Rr)[2], const int (&Cc)[2], unsigned (&a)[2][2]) const { d.aoffs(u, Rr, Cc, a); }
    __device__ __forceinline__ void tok_load(const Unit&, const int (&)[2], unsigned (&)[2][2]) const {}
    __device__ __forceinline__ void aoffs_from(const Unit& u, const int (&Rr)[2], const int (&Cc)[2], const unsigned (&)[2][2], unsigned (&a)[2][2]) const { d.aoffs(u, Rr, Cc, a); }
};

template <class Epi, class Sched>
__device__ __forceinline__ void gemm_phase(LAS unsigned char* lds, const bf16* A, const int K, const Sched& S, const Epi& E, const int tid) {
    const int wid = __builtin_amdgcn_readfirstlane(tid >> 6), lane = tid & 63, wr = wid >> 2, wc = wid & 3, fr = lane & 15, fq = lane >> 4;
    const int nt = K / BK;
    int Rr[2], Cc[2]; unsigned voffB[2];
#pragma unroll
    for (int i = 0; i < 2; ++i) { int R, C; stage_rc(tid * 16 + i * 8192, R, C); const int Rb = (R & ~31) + perm32(R & 31); Rr[i] = R; Cc[i] = C; voffB[i] = (unsigned)(Rb * K + C) * 2u; }
    const size_t kstep = (size_t)(BK * 2);
    const size_t hstep = (size_t)HALF * K * 2;
    const unsigned ldsw = (unsigned)wid * 1024u;
    const int aoff = lds_byte(wr * 64 + fr, fq * 8), boff = lds_byte(wc * 32 + fr, fq * 8);
    const char* Ab = (const char*)A;
#define PG8_SA(b, h) (((b) * 2 + (h)) * HTB)
#define PG8_SB(b, h) ((4 + (b) * 2 + (h)) * HTB)
#define PG8_STAGE_B(bufoff, gbase) do { const char* _ub = (const char*)(gbase); asm volatile("" : "+s"(_ub)); _Pragma("unroll") for (int _i = 0; _i < 2; ++_i) \
        __builtin_amdgcn_global_load_lds((const unsigned*)(_ub + voffB[_i]), (LAS unsigned*)(lds + (bufoff) + ldsw + _i * 8192), 16, 0, 0); } while (0)
#define PG8_STAGE_A(bufoff, kb, offs) do { const char* _ub = Ab + (size_t)(kb); asm volatile("" : "+s"(_ub)); _Pragma("unroll") for (int _i = 0; _i < 2; ++_i) \
        __builtin_amdgcn_global_load_lds((const unsigned*)(_ub + (offs)[_i]), (LAS unsigned*)(lds + (bufoff) + ldsw + _i * 8192), 16, 0, 0); } while (0)
#define PG8_LDA(dst, b, h) do { _Pragma("unroll") for (int m = 0; m < 4; ++m) _Pragma("unroll") for (int k = 0; k < 2; ++k) dst[m][k] = *(const LAS bf16x8*)(lds + PG8_SA(b, h) + aoff + m * 2048 + k * 1024); } while (0)
#define PG8_LDB(dst, b, h) do { _Pragma("unroll") for (int n = 0; n < 2; ++n) _Pragma("unroll") for (int k = 0; k < 2; ++k) dst[n][k] = *(const LAS bf16x8*)(lds + PG8_SB(b, h) + boff + n * 2048 + k * 1024); } while (0)
#define PG8_MMA(ai, bj, At, Bt) do { __builtin_amdgcn_s_setprio(1); _Pragma("unroll") for (int m = 0; m < 4; ++m) _Pragma("unroll") for (int n = 0; n < 2; ++n) _Pragma("unroll") for (int k = 0; k < 2; ++k) \
        acc[ai][bj][m][n] = __builtin_amdgcn_mfma_f32_16x16x32_bf16(Bt[n][k], At[m][k], acc[ai][bj][m][n], 0, 0, 0); __builtin_amdgcn_s_setprio(0); } while (0)
#define PG8_WAIT_V(n) asm volatile("s_waitcnt vmcnt(" #n ")" ::: "memory")
#define PG8_WAIT_L(n) asm volatile("s_waitcnt lgkmcnt(" #n ")" ::: "memory")
#define PG8_BAR __builtin_amdgcn_s_barrier()
#define PG8_SCHED __builtin_amdgcn_sched_barrier(0)
    Unit cur, nxt; int ui = 0;
    if (!S.next(0, cur)) return;
    f32x4 acc[2][2][4][2];
#pragma unroll
    for (int a = 0; a < 2; ++a)
#pragma unroll
        for (int b = 0; b < 2; ++b)
#pragma unroll
            for (int m = 0; m < 4; ++m)
#pragma unroll
                for (int n = 0; n < 2; ++n) acc[a][b][m][n] = (f32x4){0.f, 0.f, 0.f, 0.f};
    bf16x8 At[4][2], B0[2][2], B1[2][2];
    unsigned aC[2][2], aN[2][2], rawN[2][2];
    S.aoffs(cur, Rr, Cc, aC);
    const char* cB = S.bbase(cur);
    Unit nn; bool has_next = S.next(1, nxt);
    if (has_next) S.tok_load(nxt, Rr, rawN);
    PG8_STAGE_B(PG8_SB(0, 0), cB); PG8_STAGE_B(PG8_SB(0, 1), cB + hstep); PG8_STAGE_A(PG8_SA(0, 0), 0, aC[0]); PG8_STAGE_A(PG8_SA(0, 1), 0, aC[1]);
    if (wr == 1) PG8_BAR;
    PG8_WAIT_V(2); PG8_BAR;
    PG8_STAGE_B(PG8_SB(1, 0), cB + kstep); PG8_STAGE_A(PG8_SA(1, 0), kstep, aC[0]); PG8_STAGE_B(PG8_SB(1, 1), cB + hstep + kstep);
    PG8_WAIT_V(6); PG8_BAR;
    for (;;) {
        const char* nB = has_next ? S.bbase(nxt) : cB;
        if (has_next) S.aoffs_from(nxt, Rr, Cc, rawN, aN);
        else {
#pragma unroll
            for (int h = 0; h < 2; ++h)
#pragma unroll
                for (int i = 0; i < 2; ++i) aN[h][i] = aC[h][i];
        }
#pragma unroll 1
        for (int t = 0; t < nt; t += 2) {
            const bool last = (t == nt - 2);
            const size_t kb1 = (size_t)(t + 1) * kstep;
            const size_t kb2 = last ? (size_t)0 : (size_t)(t + 2) * kstep, kb3 = kb2 + kstep;
            const char* b2 = last ? nB : cB + (size_t)(t + 2) * kstep; const char* b3 = b2 + kstep;
            unsigned x2[2][2];
#pragma unroll
            for (int h = 0; h < 2; ++h)
#pragma unroll
                for (int i = 0; i < 2; ++i) x2[h][i] = last ? aN[h][i] : aC[h][i];
            PG8_LDB(B0, 0, 0); PG8_LDB(B1, 0, 1); PG8_SCHED; PG8_LDA(At, 0, 0); PG8_STAGE_A(PG8_SA(1, 1), kb1, aC[1]);
            PG8_WAIT_V(8); PG8_WAIT_L(0); PG8_BAR; PG8_MMA(0, 0, At, B0); PG8_MMA(0, 1, At, B1); PG8_BAR; PG8_SCHED;
            PG8_LDA(At, 0, 1); PG8_STAGE_B(PG8_SB(0, 0), b2); PG8_STAGE_B(PG8_SB(0, 1), b2 + hstep); PG8_STAGE_A(PG8_SA(0, 0), kb2, x2[0]);
            PG8_WAIT_V(8); PG8_WAIT_L(0); PG8_BAR; PG8_MMA(1, 0, At, B0); PG8_MMA(1, 1, At, B1); PG8_BAR; PG8_SCHED;
            PG8_LDB(B0, 1, 0); PG8_LDB(B1, 1, 1); PG8_SCHED; PG8_LDA(At, 1, 0); PG8_STAGE_A(PG8_SA(0, 1), kb2, x2[1]);
            PG8_WAIT_V(8); PG8_WAIT_L(0); PG8_BAR; PG8_MMA(0, 0, At, B0); PG8_MMA(0, 1, At, B1); PG8_BAR; PG8_SCHED;
            PG8_LDA(At, 1, 1); PG8_STAGE_B(PG8_SB(1, 0), b3); PG8_STAGE_B(PG8_SB(1, 1), b3 + hstep); PG8_STAGE_A(PG8_SA(1, 0), kb3, x2[0]);
            PG8_WAIT_V(8); PG8_WAIT_L(0); PG8_BAR; PG8_MMA(1, 0, At, B0); PG8_MMA(1, 1, At, B1); PG8_BAR; PG8_SCHED;
        }
        const bool has_nn = has_next && S.next(ui + 2, nn);
        if (has_nn) S.tok_load(nn, Rr, rawN);
        if (wr == 0) PG8_BAR;
        E(acc, cur, wr, wc, fr, fq);
        if (!has_next) break;
#pragma unroll
        for (int a = 0; a < 2; ++a)
#pragma unroll
            for (int b = 0; b < 2; ++b)
#pragma unroll
                for (int m = 0; m < 4; ++m)
#pragma unroll
                    for (int n = 0; n < 2; ++n) acc[a][b][m][n] = (f32x4){0.f, 0.f, 0.f, 0.f};
        cur = nxt; cB = nB; ++ui; nxt = nn; has_next = has_nn;
#pragma unroll
        for (int h = 0; h < 2; ++h)
#pragma unroll
            for (int i = 0; i < 2; ++i) aC[h][i] = aN[h][i];
        if (wr == 1) PG8_BAR;
    }
    PG8_WAIT_V(0);
    PG8_BAR;
#undef PG8_SA
#undef PG8_SB
#undef PG8_STAGE_A
#undef PG8_STAGE_B
#undef PG8_LDA
#undef PG8_LDB
#undef PG8_MMA
#undef PG8_WAIT_V
#undef PG8_WAIT_L
#undef PG8_BAR
#undef PG8_SCHED
}
}

#ifndef ATTN_STORE16
#define ATTN_STORE16(p,v) (*(u32x4*)(p)=(v))
#endif
namespace attn_body {
using bf16=unsigned short;
using bf16x8=__attribute__((ext_vector_type(8)))short;
using s16x4=__attribute__((ext_vector_type(4)))short;
using f32x16=__attribute__((ext_vector_type(16)))float;
using u32x4=__attribute__((ext_vector_type(4)))unsigned;
constexpr int D=64,QP=512,KP=128,OP=1024;
constexpr int NW=8,QBLK=32,QB=QBLK*NW,KVBLK=64;
constexpr int ATTN_UNIT_ROWS=QB;
__device__ __forceinline__ int crow(int r,int hi){return (r&3)+8*(r>>2)+4*hi;}
#define SBAR() __builtin_amdgcn_sched_barrier(0)
constexpr int NSLOT=3, SLOTB=8192;
constexpr int LDS_K=0, LDS_V=NSLOT*SLOTB, LDS_WS=2*NSLOT*SLOTB, LDS_OST=LDS_WS+NW*64*4, LDS_BYTES=LDS_OST+NW*4096;
constexpr float C2=0.125f*1.4426950408889634f;
__device__ __forceinline__ void glds16(const void*sbase,unsigned voff,unsigned lds_dst){unsigned keep;
  asm volatile("s_mov_b32 %0, m0\n\ts_mov_b32 m0, %3\n\ts_nop 0\n\tglobal_load_lds_dwordx4 %1, %2\n\ts_mov_b32 m0, %0":"=&s"(keep):"v"(voff),"s"(sbase),"s"(lds_dst):"memory");}
__device__ __forceinline__ float max3f(float a,float b,float c){float r;asm("v_max3_f32 %0, %1, %2, %3":"=v"(r):"v"(a),"v"(b),"v"(c));return r;}
__device__ __forceinline__ float max2f(float a,float b){float r;asm("v_max_f32_e32 %0, %1, %2":"=v"(r):"v"(a),"v"(b));return r;}
__device__ __forceinline__ float fadd_s(float a,float b){float r;asm("v_add_f32_e32 %0, %1, %2":"=v"(r):"v"(a),"v"(b));return r;}
__device__ __forceinline__ float fsub_s(float a,float b){float r;asm("v_sub_f32_e32 %0, %1, %2":"=v"(r):"v"(a),"v"(b));return r;}
typedef float f32x2_t __attribute__((ext_vector_type(2))); typedef __bf16 bf16x2_t __attribute__((ext_vector_type(2)));
__device__ __forceinline__ unsigned cvtpk_s(float lo,float hi){f32x2_t v={lo,hi};bf16x2_t b=__builtin_convertvector(v,bf16x2_t);return __builtin_bit_cast(unsigned,b);}
#define WAIT_BAR(N) asm volatile("s_waitcnt vmcnt(" #N ") lgkmcnt(0)\n\ts_barrier":::"memory")

__device__ __forceinline__ void qkt(f32x16&p0,f32x16&p1,const char*Kslot,const bf16x8*qr,const f32x16&negm,int r32,int hi){
  const char*kb=Kslot+hi*1024+r32*16;
  #pragma unroll
  for(int d0=0;d0<4;++d0){
    const bf16x8 b0=*reinterpret_cast<const bf16x8*>(kb+d0*2048);
    const bf16x8 b1=*reinterpret_cast<const bf16x8*>(kb+d0*2048+512);
    if(d0==0){p0=__builtin_amdgcn_mfma_f32_32x32x16_bf16(b0,qr[0],negm,0,0,0);p1=__builtin_amdgcn_mfma_f32_32x32x16_bf16(b1,qr[0],negm,0,0,0);}
    else{p0=__builtin_amdgcn_mfma_f32_32x32x16_bf16(b0,qr[d0],p0,0,0,0);p1=__builtin_amdgcn_mfma_f32_32x32x16_bf16(b1,qr[d0],p1,0,0,0);}}
}
typedef __attribute__((address_space(3))) const char* lds_cptr;
typedef short v4i16_t __attribute__((ext_vector_type(4)));
__device__ __forceinline__ void kload8(bf16x8*kf,lds_cptr kp){
  kf[0]=*(const __attribute__((address_space(3))) bf16x8*)(kp);      kf[1]=*(const __attribute__((address_space(3))) bf16x8*)(kp+512);
  kf[2]=*(const __attribute__((address_space(3))) bf16x8*)(kp+2048); kf[3]=*(const __attribute__((address_space(3))) bf16x8*)(kp+2560);
  kf[4]=*(const __attribute__((address_space(3))) bf16x8*)(kp+4096); kf[5]=*(const __attribute__((address_space(3))) bf16x8*)(kp+4608);
  kf[6]=*(const __attribute__((address_space(3))) bf16x8*)(kp+6144); kf[7]=*(const __attribute__((address_space(3))) bf16x8*)(kp+6656);
}
__device__ __forceinline__ void kload2(bf16x8*kf,lds_cptr kp,int j){ kf[2*j]=*(const __attribute__((address_space(3))) bf16x8*)(kp+j*2048); kf[2*j+1]=*(const __attribute__((address_space(3))) bf16x8*)(kp+j*2048+512); }
__device__ __forceinline__ s16x4 vtr(lds_cptr p){ return __builtin_bit_cast(s16x4,__builtin_amdgcn_ds_read_tr16_b64_v4i16((__attribute__((address_space(3))) v4i16_t*)p)); }
__device__ __forceinline__ float rowmax(const f32x16&p0,const f32x16&p1){
  float a=max3f(p0[0],p0[1],p1[0]),b=max3f(p0[2],p0[3],p1[1]);a=max3f(a,p1[2],p1[3]);
  #pragma unroll
  for(int r=4;r<16;r+=4){a=max3f(a,p0[r],p0[r+1]);b=max3f(b,p0[r+2],p0[r+3]);a=max3f(a,p1[r],p1[r+1]);b=max3f(b,p1[r+2],p1[r+3]);}
  const float m=max2f(a,b);
  auto rr=__builtin_amdgcn_permlane32_swap(__float_as_uint(m),__float_as_uint(m),false,false);
  return max2f(__uint_as_float(rr[0]),__uint_as_float(rr[1]));
}
__device__ __forceinline__ void pv(f32x16*o,int vb,bf16x8 pa0,bf16x8 pa1,bf16x8 pa2,bf16x8 pa3){
  #pragma unroll
  for(int d0=0;d0<2;++d0){s16x4 lo[4],hi[4];
    #pragma unroll
    for(int ks=0;ks<4;++ks){
      asm volatile("ds_read_b64_tr_b16 %0,%1 offset:%c2":"=&v"(lo[ks]):"v"(vb),"i"(d0*4096+ks*1024):"memory");
      asm volatile("ds_read_b64_tr_b16 %0,%1 offset:%c2":"=&v"(hi[ks]):"v"(vb),"i"(d0*4096+ks*1024+512):"memory");}
    asm volatile("s_waitcnt lgkmcnt(0)":::"memory");SBAR();
    #define PK(k) (bf16x8){lo[k][0],lo[k][1],lo[k][2],lo[k][3],hi[k][0],hi[k][1],hi[k][2],hi[k][3]}
    o[d0]=__builtin_amdgcn_mfma_f32_32x32x16_bf16(pa0,PK(0),o[d0],0,0,0);
    o[d0]=__builtin_amdgcn_mfma_f32_32x32x16_bf16(pa1,PK(1),o[d0],0,0,0);
    o[d0]=__builtin_amdgcn_mfma_f32_32x32x16_bf16(pa2,PK(2),o[d0],0,0,0);
    o[d0]=__builtin_amdgcn_mfma_f32_32x32x16_bf16(pa3,PK(3),o[d0],0,0,0);
    #undef PK
  }
}

__device__ __forceinline__ unsigned short f2bf_(float x){f32x2_t v={x,0.f};bf16x2_t bb=__builtin_convertvector(v,bf16x2_t);return (unsigned short)(__builtin_bit_cast(unsigned,bb)&0xffffu);}
template<int THRL> __device__ __forceinline__ void attn_unit(const bf16*Qb,const bf16*__restrict__ Kh,const bf16*__restrict__ Vh,bf16*Ob,const int NT,char*shm,const int tid){
  const int lane=tid&63,r32=lane&31,hi=lane>>5; const int wid=__builtin_amdgcn_readfirstlane(tid>>6);
  const bf16*Qw=Qb+(long)(wid*QBLK)*QP;
  const unsigned lds0=(unsigned)(uintptr_t)shm;
  float*wsf=(float*)(shm+LDS_WS)+wid*64;
  const unsigned ksrc=(unsigned)(lane*KP+wid*8)*2u;
  const unsigned vsrc=(unsigned)((16*(wid&3)+(lane>>2))*KP+(wid>>2)*32+(lane&3)*8)*2u;
  const unsigned kdst=lds0+LDS_K+wid*1024, vdst=lds0+LDS_V+wid*1024;
  #define DMA_K(t,slot) glds16(Kh+(long)(t)*KVBLK*KP,ksrc,(unsigned)__builtin_amdgcn_readfirstlane(kdst+(slot)))
  #define DMA_V(t,slot) glds16(Vh+(long)(t)*KVBLK*KP,vsrc,(unsigned)__builtin_amdgcn_readfirstlane(vdst+(slot)))
  const int vb0=(int)(lds0+LDS_V)+((lane>>4)&1)*32+(lane&3)*8+(4*hi+((lane&15)>>2))*64;
  const char*Kbase=shm+LDS_K; bf16x8 kf[8];
  const lds_cptr shm3=(lds_cptr)shm; const lds_cptr kp0=shm3+LDS_K+hi*1024+r32*16; const lds_cptr vp0=shm3+LDS_V+((lane>>4)&1)*32+(lane&3)*8+(4*hi+((lane&15)>>2))*64;
  DMA_K(0,0);DMA_V(0,0);DMA_K(1,SLOTB);
  bf16x8 qr[4];
  #pragma unroll
  for(int d0=0;d0<4;++d0)qr[d0]=*reinterpret_cast<const bf16x8*>(&Qw[(long)r32*QP+d0*16+hi*8]);
  float mhat=0.f,l_reg=0.f;f32x16 o[2];o[0]=f32x16{};o[1]=f32x16{};f32x16 negm=f32x16{};asm volatile("":"+v"(negm));
  #define CMASK(P0,P1,t) do{}while(0)
  bool resc=false;
  #define START(P0,P1) do{ const float rm=rowmax(P0,P1); resc=false; \
    { const float dl=rm; mhat=fadd_s(mhat,dl); \
      _Pragma("unroll") for(int r=0;r<16;++r){P0[r]=fsub_s(P0[r],dl);P1[r]=fsub_s(P1[r],dl);} \
      _Pragma("unroll") for(int r=0;r<16;++r)negm[r]=-mhat; asm volatile("":"+v"(negm)); } \
    _Pragma("unroll") for(int r=0;r<16;++r)P0[r]=__builtin_amdgcn_exp2f(P0[r]); }while(0)
  #define RESC() do{ if(resc){ asm volatile("s_waitcnt lgkmcnt(0)":::"memory"); \
      _Pragma("unroll") for(int d_=0;d_<2;++d_) _Pragma("unroll") for(int r=0;r<16;++r)o[d_][r]*=wsf[crow(r,hi)]; } }while(0)
  f32x16 pA0,pA1,pB0,pB1;
  int sl_prev=0,sl_cur=0,sl_next=SLOTB;
  #define ROT() do{sl_prev=sl_cur;sl_cur=sl_next;sl_next=(sl_next==(NSLOT-1)*SLOTB)?0:sl_next+SLOTB;}while(0)
  DMA_K(2,2*SLOTB);
  WAIT_BAR(3);
  qkt(pA0,pA1,Kbase,qr,negm,r32,hi);asm volatile("s_nop 15\n\ts_nop 7":"+v"(pA0),"+v"(pA1));CMASK(pA0,pA1,0);
  START(pA0,pA1);
  _Pragma("unroll") for(int r=0;r<16;++r)pA1[r]=__builtin_amdgcn_exp2f(pA1[r]);
  WAIT_BAR(0);
  DMA_K(3,0);DMA_V(1,SLOTB);
  ROT();
  kload8(kf,kp0+sl_cur);
  WAIT_BAR(2);
  s16x4 vlo[8],vhi[8]; u32x4 pw0,pw1,pw2,pw3;
  #define PKW(P,B) cvtpk_s(P[B],P[B+1])
  #define PAF(k) __builtin_bit_cast(bf16x8,pw##k)
  #define VFR(i) (bf16x8){vlo[i][0],vlo[i][1],vlo[i][2],vlo[i][3],vhi[i][0],vhi[i][1],vhi[i][2],vhi[i][3]}
  #define PIN(x) asm volatile("":"+v"(x))
  #define MX3(a,b,c) __builtin_fmaxf(__builtin_fmaxf((a),(b)),(c))
  #define GAPA(MF,A0,A1,A2,A3,W0,W1,PW) do{ MF; sacc+=A0; sacc+=A1; sacc+=A2; sacc+=A3; PIN(sacc); W0; W1; PIN(PW); SBAR(); }while(0)
  #define EX(v) __builtin_amdgcn_exp2f(v)
  #define GAPB(MF,X,B) do{ MF; X[B]=EX(X[B]); X[B+1]=EX(X[B+1]); X[B+2]=EX(X[B+2]); X[B+3]=EX(X[B+3]); PIN(X); SBAR(); }while(0)
  #define VRD(i) do{ vlo[i]=vtr(vp_+(((i)>>2)*4096+((i)&3)*1024)); vhi[i]=vtr(vp_+(((i)>>2)*4096+((i)&3)*1024+512)); }while(0)
  #define KRD(G,j) do{ if(G){ kload2(kf,kp0+sl_next,j); SBAR(); } }while(0)
  #define STEP(C0,C1,P0,P1,t,GK,GV,GL) do{ SBAR(); \
    const lds_cptr vp_=vp0+sl_prev; \
    VRD(0); SBAR(); float sacc=(P0[0]+P0[1]); \
    GAPA(C0=__builtin_amdgcn_mfma_f32_32x32x16_bf16(kf[0],qr[0],negm,0,0,0), P0[2],P0[3],P0[4],P0[5],     pw0[0]=PKW(P0,0), pw0[1]=PKW(P0,2), pw0); \
    VRD(4); SBAR(); GAPA(C1=__builtin_amdgcn_mfma_f32_32x32x16_bf16(kf[1],qr[0],negm,0,0,0), P0[6],P0[7],P0[8],P0[9],     pw0[2]=PKW(P0,4), pw0[3]=PKW(P0,6), pw0); \
    VRD(1); SBAR(); GAPA(C0=__builtin_amdgcn_mfma_f32_32x32x16_bf16(kf[2],qr[1],C0,0,0,0),   P0[10],P0[11],P0[12],P0[13], pw1[0]=PKW(P0,8), pw1[1]=PKW(P0,10), pw1); \
    VRD(5); SBAR(); GAPA(C1=__builtin_amdgcn_mfma_f32_32x32x16_bf16(kf[3],qr[1],C1,0,0,0),   P0[14],P0[15],P1[0],P1[1],   pw1[2]=PKW(P0,12),pw1[3]=PKW(P0,14), pw1); \
    VRD(2); SBAR(); GAPA(C0=__builtin_amdgcn_mfma_f32_32x32x16_bf16(kf[4],qr[2],C0,0,0,0),   P1[2],P1[3],P1[4],P1[5],     pw2[0]=PKW(P1,0), pw2[1]=PKW(P1,2), pw2); \
    VRD(6); SBAR(); GAPA(C1=__builtin_amdgcn_mfma_f32_32x32x16_bf16(kf[5],qr[2],C1,0,0,0),   P1[6],P1[7],P1[8],P1[9],     pw2[2]=PKW(P1,4), pw2[3]=PKW(P1,6), pw2); \
    VRD(3); SBAR(); GAPA(C0=__builtin_amdgcn_mfma_f32_32x32x16_bf16(kf[6],qr[3],C0,0,0,0),   P1[10],P1[11],P1[12],P1[13], pw3[0]=PKW(P1,8), pw3[1]=PKW(P1,10), pw3); \
    VRD(7); SBAR(); GAPA(C1=__builtin_amdgcn_mfma_f32_32x32x16_bf16(kf[7],qr[3],C1,0,0,0),   P1[14],P1[15],0.f,0.f,       pw3[2]=PKW(P1,12),pw3[3]=PKW(P1,14), pw3); \
    l_reg+=sacc; \
    if(GK){DMA_K((t)+3,sl_cur);} if(GV){DMA_V((t)+1,sl_next);} \
    CMASK(C0,C1,t); \
    { float a=MX3(C0[0],C0[1],C1[0]),b=MX3(C0[2],C0[3],C1[1]); a=MX3(a,C1[2],C1[3]); \
      _Pragma("unroll") for(int r=4;r<16;r+=4){a=MX3(a,C0[r],C0[r+1]);b=MX3(b,C0[r+2],C0[r+3]);a=MX3(a,C1[r],C1[r+1]);b=MX3(b,C1[r+2],C1[r+3]);} \
      float rm=__builtin_fmaxf(a,b); { auto rr=__builtin_amdgcn_permlane32_swap(__float_as_uint(rm),__float_as_uint(rm),false,false); rm=__builtin_fmaxf(__uint_as_float(rr[0]),__uint_as_float(rr[1])); } \
      resc=false; \
      if(__builtin_expect(__any(rm>(float)THRL),0)){ const float dl=__builtin_fmaxf(rm,0.f); mhat+=dl; \
        _Pragma("unroll") for(int r=0;r<16;++r){C0[r]-=dl;C1[r]-=dl;} \
        _Pragma("unroll") for(int r=0;r<16;++r)negm[r]=-mhat; asm volatile("":"+v"(negm)); \
        const float f=__builtin_amdgcn_exp2f(-dl); l_reg*=f; if(hi==0)wsf[r32]=f; resc=true; } } \
    SBAR(); \
    GAPB(o[0]=__builtin_amdgcn_mfma_f32_32x32x16_bf16(PAF(0),VFR(0),o[0],0,0,0), C0,0); \
    GAPB(o[1]=__builtin_amdgcn_mfma_f32_32x32x16_bf16(PAF(0),VFR(4),o[1],0,0,0), C0,4); \
    KRD(GL,0); GAPB(o[0]=__builtin_amdgcn_mfma_f32_32x32x16_bf16(PAF(1),VFR(1),o[0],0,0,0), C0,8); \
    KRD(GL,1); GAPB(o[1]=__builtin_amdgcn_mfma_f32_32x32x16_bf16(PAF(1),VFR(5),o[1],0,0,0), C0,12); \
    KRD(GL,2); GAPB(o[0]=__builtin_amdgcn_mfma_f32_32x32x16_bf16(PAF(2),VFR(2),o[0],0,0,0), C1,0); \
    KRD(GL,3); GAPB(o[1]=__builtin_amdgcn_mfma_f32_32x32x16_bf16(PAF(2),VFR(6),o[1],0,0,0), C1,4); \
    GAPB(o[0]=__builtin_amdgcn_mfma_f32_32x32x16_bf16(PAF(3),VFR(3),o[0],0,0,0), C1,8); \
    GAPB(o[1]=__builtin_amdgcn_mfma_f32_32x32x16_bf16(PAF(3),VFR(7),o[1],0,0,0), C1,12); \
    }while(0)
  int t=1;
  #undef CMASK
  #define CMASK(P0,P1,t) do{}while(0)
  for(;t+5<NT;t+=2){
    STEP(pB0,pB1,pA0,pA1,t,true,true,true);     WAIT_BAR(2); RESC(); ROT();
    STEP(pA0,pA1,pB0,pB1,t+1,true,true,true);   WAIT_BAR(2); RESC(); ROT();
  }
  #undef CMASK
  #define CMASK(P0,P1,t) do{}while(0)
  #define ENDW(tt) do{ if((tt)+3<NT){WAIT_BAR(2);} else if((tt)+2<NT){WAIT_BAR(1);} else {WAIT_BAR(0);} }while(0)
  for(;t+1<NT;t+=2){
    STEP(pB0,pB1,pA0,pA1,t,(t+3<NT),(t+1<NT),(t+1<NT));       ENDW(t);   RESC(); ROT();
    STEP(pA0,pA1,pB0,pB1,t+1,(t+4<NT),(t+2<NT),(t+2<NT));     ENDW(t+1); RESC(); ROT();
  }
  STEP(pB0,pB1,pA0,pA1,NT-1,false,false,false); RESC();
  { float sacc=pB0[0]+pB0[1]; _Pragma("unroll") for(int r=2;r<16;++r)sacc+=pB0[r]; _Pragma("unroll") for(int r=0;r<16;++r)sacc+=pB1[r]; l_reg+=sacc;
    pw0=(u32x4){PKW(pB0,0),PKW(pB0,2),PKW(pB0,4),PKW(pB0,6)};pw1=(u32x4){PKW(pB0,8),PKW(pB0,10),PKW(pB0,12),PKW(pB0,14)};pw2=(u32x4){PKW(pB1,0),PKW(pB1,2),PKW(pB1,4),PKW(pB1,6)};pw3=(u32x4){PKW(pB1,8),PKW(pB1,10),PKW(pB1,12),PKW(pB1,14)};
    SBAR(); pv(o,vb0+sl_cur,PAF(0),PAF(1),PAF(2),PAF(3)); }
  #undef PKW
  #undef PAF
  #undef VFR
  #undef PIN
  #undef MX3
  #undef GAPA
  #undef GAPB
  #undef EX
  #undef VRD
  #undef KRD
  #undef STEP
  #undef ENDW
  {auto rr=__builtin_amdgcn_permlane32_swap(__float_as_uint(l_reg),__float_as_uint(l_reg),false,false);l_reg=__uint_as_float(rr[0])+__uint_as_float(rr[1]);}
  if(hi==0)wsf[32+r32]=l_reg;asm volatile("s_waitcnt lgkmcnt(0)":::"memory");
  float rli[16];
  #pragma unroll
  for(int r=0;r<16;++r)rli[r]=__builtin_amdgcn_rcpf(wsf[32+crow(r,hi)]);
  bf16*Ow=Ob+(long)(wid*QBLK)*OP;
  { bf16*stg=(bf16*)(shm+LDS_OST)+wid*2048;
    #pragma unroll
    for(int r=0;r<16;++r){const int orow=crow(r,hi);
      #pragma unroll
      for(int d0=0;d0<2;++d0)stg[orow*64+d0*32+r32]=f2bf_(o[d0][r]*rli[r]);}
    asm volatile("s_waitcnt lgkmcnt(0)":::"memory");
    #pragma unroll
    for(int i=0;i<4;++i){const int row=i*8+(lane>>3),ch=lane&7; const u32x4 v=*(const u32x4*)(stg+row*64+ch*8); ATTN_STORE16(Ow+(long)row*OP+ch*8,v);} }
  asm volatile("s_waitcnt lgkmcnt(0)\n\ts_barrier":::"memory");
  #undef DMA_K
  #undef DMA_V
  #undef CMASK
  #undef START
  #undef RESC
  #undef ROT
}
constexpr int ATTN_LDS_BYTES=LDS_BYTES;
#undef SBAR
#undef WAIT_BAR
}

#define XB_TMO      128
#define XB_XCNT(j)  (256  + 64 * (j))
#define XB_XSUB(j)  (1280 + 64 * (j))
#define XB_XGEN(j)  (2304 + 64 * (j))
#define XB_TOP      3328
#define XB_TOPGEN   3392
#define XCD_BAR_WORDS 3456
#define XB_SPIN_CAP (1u << 22)
__device__ __forceinline__ unsigned xb_ld(unsigned* p)              { return __hip_atomic_load(p, __ATOMIC_RELAXED, __HIP_MEMORY_SCOPE_AGENT); }
__device__ __forceinline__ unsigned xb_add(unsigned* p, unsigned v) { return __hip_atomic_fetch_add(p, v, __ATOMIC_RELAXED, __HIP_MEMORY_SCOPE_AGENT); }
__device__ __forceinline__ unsigned xb_xcc_id() { return (unsigned)__builtin_amdgcn_s_getreg((3 << 11) | 20) & 0xFu; }
#define XB_SPIN(cond, bar) do { unsigned _sp = 0; while (cond) { __builtin_amdgcn_s_sleep(1); \
    if ((++_sp & 255u) == 0u) { if (xb_ld(&(bar)[XB_TMO])) break; if (_sp > XB_SPIN_CAP) { atomicAdd(&(bar)[XB_TMO], 1u); break; } } } } while (0)
struct XcdBarrier { unsigned* bar; unsigned x; volatile LAS unsigned* st; };
__device__ __forceinline__ XcdBarrier xcd_barrier_post(unsigned* bar, volatile LAS unsigned* st, const int tid) {
    XcdBarrier b; b.bar = bar; b.x = xb_xcc_id(); b.st = st;
    if (tid == 0) (void)xb_add(&bar[XB_XCNT(b.x)], 1u);
    return b;
}
__device__ __forceinline__ void xcd_barrier_complete(unsigned* bar, unsigned x, unsigned& nloc, unsigned& nx) {
    const unsigned G = gridDim.x * gridDim.y * gridDim.z;
    unsigned sum, cnt, mine, sp = 0u;
    for (;;) {
        sum = 0u; cnt = 0u; mine = 0u;
#pragma unroll
        for (unsigned j = 0; j < 16; ++j) { const unsigned c = xb_ld(&bar[XB_XCNT(j)]); sum += c; cnt += (c > 0u) ? 1u : 0u; mine = (j == x) ? c : mine; }
        if (sum == G) break;
        __builtin_amdgcn_s_sleep(1);
        if ((++sp & 255u) == 0u) { if (xb_ld(&bar[XB_TMO])) break; if (sp > XB_SPIN_CAP) { atomicAdd(&bar[XB_TMO], 1u); break; } }
    }
    nloc = mine > 0u ? mine : 1u; nx = cnt > 0u ? cnt : 1u;
}
__device__ __forceinline__ void xcd_barrier(const XcdBarrier& b, const int tid) {
    asm volatile("s_waitcnt vmcnt(0)" ::: "memory");
    __syncthreads();
    if (tid == 0) {
        unsigned* bar = b.bar;
        __builtin_amdgcn_s_waitcnt(0);
        unsigned nloc = b.st[0], nx = b.st[1];
        if (nloc == 0u) { xcd_barrier_complete(bar, b.x, nloc, nx); b.st[0] = nloc; b.st[1] = nx; }
        const unsigned old = xb_add(&bar[XB_XSUB(b.x)], 1u);
        const unsigned gen = old / nloc;
        if (old + 1u == (gen + 1u) * nloc) {
            __builtin_amdgcn_fence(__ATOMIC_RELEASE, "agent");
            asm volatile("s_waitcnt vmcnt(0)" ::: "memory");
            const unsigned og = xb_add(&bar[XB_TOP], 1u);
            const unsigned tg = og / nx;
            if (og + 1u == (tg + 1u) * nx) xb_add(&bar[XB_TOPGEN], 1u);
            else XB_SPIN(xb_ld(&bar[XB_TOPGEN]) == tg, bar);
            __builtin_amdgcn_fence(__ATOMIC_ACQUIRE, "agent");
            xb_add(&bar[XB_XGEN(b.x)], 1u);
            asm volatile("s_waitcnt vmcnt(0)" ::: "memory");
        } else {
            XB_SPIN(xb_ld(&bar[XB_XGEN(b.x)]) == gen, bar);
            __builtin_amdgcn_fence(__ATOMIC_ACQUIRE, "agent");
            asm volatile("s_waitcnt vmcnt(0)" ::: "memory");
        }
    }
    __syncthreads();
}

struct Args { const float* in[24]; float* out; unsigned char* ws; int ph_lo, ph_hi, dry, pad; };
struct Frame {
    LAS unsigned char* lds;
    unsigned char* ldsg;
    volatile LAS unsigned* MISC;
    unsigned* ctl;
    unsigned char* ws; float* out; float* xw; const float* const* in;
    int tid, lane, wave, G, gw, NGW;
};
__device__ __forceinline__ const float* inp(const float* p) { unsigned long long v = (unsigned long long)p; asm volatile("" : "+s"(v)); return (const float*)(const GAS float*)v; }
#define F_x (inp(F.in[0]))
#define F_c (inp(F.in[1]))
#define F_ctx (inp(F.in[2]))
#define F_c_ctx (inp(F.in[3]))
#define F_w_mod (inp(F.in[4]))
#define F_b_mod (inp(F.in[5]))
#define F_g_mix (inp(F.in[6]))
#define F_g_ffn (inp(F.in[7]))
#define F_ev_w_in (inp(F.in[8]))
#define F_ev_qg (inp(F.in[9]))
#define F_ev_kg (inp(F.in[10]))
#define F_ev_dw_w (inp(F.in[11]))
#define F_ev_dw_b (inp(F.in[12]))
#define F_ev_ln_g (inp(F.in[13]))
#define F_ev_ln_b (inp(F.in[14]))
#define F_ev_w_out (inp(F.in[15]))
#define F_od_w_in (inp(F.in[16]))
#define F_od_conv_w (inp(F.in[17]))
#define F_od_w_out (inp(F.in[18]))
#define F_router_w (inp(F.in[19]))
#define F_router_b (inp(F.in[20]))
#define F_w_gate (inp(F.in[21]))
#define F_w_up (inp(F.in[22]))
#define F_w_down (inp(F.in[23]))
#define F_MOD    ((float*)(F.ws + WS_MOD))
#define F_ROPE   ((f32x2*)(F.ws + WS_ROPE))
#define F_RT     ((u32x4*)(F.ws + WS_RT))
#define F_ROWTOK ((unsigned*)(F.ws + WS_ROWTOK))
#define F_Z      ((float*)(F.ws + WS_Z))
#define F_W_EVIN  ((bf16*)(F.ws + WS_W_EVIN))
#define F_W_EVOUT ((bf16*)(F.ws + WS_W_EVOUT))
#define F_W_ODIN  ((bf16*)(F.ws + WS_W_ODIN))
#define F_W_ODOUT ((bf16*)(F.ws + WS_W_ODOUT))
#define F_W_MOE1  ((bf16*)(F.ws + WS_W_MOE1))
#define F_W_MOE2  ((bf16*)(F.ws + WS_W_MOE2))
#define F_HB   ((bf16*)(F.ws + WS_HB))
#define F_CAT  ((bf16*)(F.ws + WS_CAT))
#define F_OX   ((bf16*)(F.ws + WS_OX))
#define F_HMID ((bf16*)(F.ws + WS_HMID))
#define F_Y    ((bf16*)(F.ws + WS_Y))
#define F_Q    ((bf16*)(F.ws + WS_Q))
#define F_KB   ((bf16*)(F.ws + WS_K))
#define F_VB   ((bf16*)(F.ws + WS_V))
#define F_AG   ((bf16*)(F.ws + WS_AG))
#define F_SB   ((bf16*)(F.ws + WS_S))
#define F_U    ((bf16*)(F.ws + WS_U))
#define F_GB   ((bf16*)(F.ws + WS_GB))
__device__ __forceinline__ bool ctx_in_l(int l) { return l <= 2; }
__device__ __forceinline__ bool ctx_out_l(int l) { return l < 2; }

__device__ __forceinline__ int rowmap(int n, int mode) {
    if (mode == 0) return n;
    if (mode == 1 || mode == 2) return 256 * (n >> 7) + (n & 127) + (mode == 2 ? 128 : 0);
    if (mode == 3) {
        if (n < 768) { const int d = n & 63, hh = (n >> 6) & 3; return (n & ~255) + 128 * (d >> 5) + 32 * hh + (d & 31); }
        if (n < 1280) { const int o = n - 768; return 768 + 256 * (o >> 7) + (o & 127); }
        const int o = n - 1280; return 768 + 256 * (o >> 7) + 128 + (o & 127);
    }
    if (n < 1024) return 2048 + n;
    if (n < 2048) { const int o = n - 1024; return 256 * (o >> 7) + (o & 127); }
    { const int o = n - 2048; return 256 * (o >> 7) + 128 + (o & 127); }
}
struct TItem { const float* W; bf16* WT; int K, N, mode, k0, n0; };
__device__ __forceinline__ void titem_set(TItem& t, const float* W, int K, int N, bf16* WT, int mode, int item) { const int nblk = N >> 6; t.W = W; t.WT = WT; t.K = K; t.N = N; t.mode = mode; t.k0 = 64 * (item / nblk); t.n0 = 64 * (item % nblk); }
__device__ __forceinline__ void titem_load(const TItem& t, f32x4 (&v)[16], int lane) {
    const float* p = t.W + (size_t)(t.k0 + (lane >> 4)) * t.N + t.n0 + (lane & 15) * 4;
#pragma unroll
    for (int i = 0; i < 16; ++i) v[i] = __builtin_nontemporal_load((const f32x4*)(p + (size_t)(4 * i) * t.N));
}
__device__ __forceinline__ void titem_store(const TItem& t, const f32x4 (&v)[16], float* scr, int lane) {
#pragma unroll
    for (int i = 0; i < 16; ++i) { const int kk = (lane >> 4) + 4 * i; *(f32x4*)(scr + kk * 64 + (((lane & 15) * 4) ^ (4 * ((kk >> 3) & 7)))) = v[i]; }
    LDS_WAIT(); asm volatile("" ::: "memory");
    const int kc = lane & 7;
#pragma unroll
    for (int j = 0; j < 8; ++j) { const int n = (lane >> 3) + 8 * j; const float* sp = scr + (8 * kc) * 64 + (n ^ (4 * kc));
        u32x4 o; o.x = pk2(sp[0 * 64], sp[1 * 64]); o.y = pk2(sp[2 * 64], sp[3 * 64]); o.z = pk2(sp[4 * 64], sp[5 * 64]); o.w = pk2(sp[6 * 64], sp[7 * 64]);
        *(u32x4*)(t.WT + (size_t)rowmap(t.n0 + n, t.mode) * t.K + t.k0 + 8 * kc) = o; }
    LDS_WAIT(); asm volatile("" ::: "memory");
}
constexpr int I_EVIN = 16 * (EVIN / 64), I_SQ = 16 * 16, I_ODIN = 16 * (ODIN / 64), I_GU = 16 * 8, I_DN = 8 * 16, I_MOE = NE * (2 * I_GU + I_DN);
__device__ __forceinline__ int layer_items(int l) { return ((l & 1) ? I_ODIN : I_EVIN) + I_SQ + I_MOE; }
__device__ __forceinline__ void titem_decode(Frame& F, int l, int r, TItem& t) {
    const int li = l >> 1;
    if (!(l & 1)) {
        if (r < I_EVIN) { titem_set(t, F_ev_w_in + (size_t)li * D * EVIN, D, EVIN, F_W_EVIN + (size_t)li * EVIN * D, 3, r); return; } r -= I_EVIN;
        if (r < I_SQ) { titem_set(t, F_ev_w_out + (size_t)li * D * D, D, D, F_W_EVOUT + (size_t)li * D * D, 0, r); return; } r -= I_SQ;
    } else {
        if (r < I_ODIN) { titem_set(t, F_od_w_in + (size_t)li * D * ODIN, D, ODIN, F_W_ODIN + (size_t)li * ODIN * D, 4, r); return; } r -= I_ODIN;
        if (r < I_SQ) { titem_set(t, F_od_w_out + (size_t)li * D * D, D, D, F_W_ODOUT + (size_t)li * D * D, 0, r); return; } r -= I_SQ;
    }
    constexpr int PER = 2 * I_GU + I_DN; const int le = l * NE + r / PER; int q = r % PER;
    if (q < I_GU) { titem_set(t, F_w_gate + (size_t)le * D * DE, D, DE, F_W_MOE1 + (size_t)le * D * D, 1, q); return; } q -= I_GU;
    if (q < I_GU) { titem_set(t, F_w_up + (size_t)le * D * DE, D, DE, F_W_MOE1 + (size_t)le * D * D, 2, q); return; } q -= I_GU;
    titem_set(t, F_w_down + (size_t)le * DE * D, DE, D, F_W_MOE2 + (size_t)le * D * DE, 0, q);
}
__device__ __forceinline__ void convert_items(Frame& F, int l, int lo, int hi, int rank, int nb) {
    float* scr = (float*)(F.ldsg + F.wave * 16384);
    int it = lo + rank * NWAVES + F.wave; const int step = nb * NWAVES;
    if (it < hi) {
        TItem cur, nxt; f32x4 va[16], vb[16];
        titem_decode(F, l, it, cur); titem_load(cur, va, F.lane);
        for (;;) {
            const int itn = it + step; const bool more = itn < hi;
            if (more) { titem_decode(F, l, itn, nxt); titem_load(nxt, vb, F.lane); }
            titem_store(cur, va, scr, F.lane);
            if (!more) break;
            cur = nxt; it = itn;
#pragma unroll
            for (int i = 0; i < 16; ++i) va[i] = vb[i];
        }
    }
}
__device__ __forceinline__ void convert_tail(Frame& F, int l, int j, int T, int cidx) {
    if (l + 1 >= DEPTH) return;
    const int n = layer_items(l + 1), lo = (n * j) >> 2, hi = (n * (j + 1)) >> 2;
    const int rem = T % F.G;
    if (rem == 0) convert_items(F, l + 1, lo, hi, cidx, F.G);
    else if (cidx >= rem) convert_items(F, l + 1, lo, hi, cidx - rem, F.G - rem);
}
__device__ __forceinline__ void mod_unit(Frame& F, int u) {
    const int l = u / 48, cg = u % 48;
    float* act = (float*)F.ldsg;
    float* red = (float*)(F.ldsg + 36864);
    for (int idx = F.tid; idx < 9 * 1024; idx += NTHR) { const int r = idx >> 10, k = idx & 1023; const float v = (r < 8) ? F_c[r * 1024 + k] : F_c_ctx[k]; act[idx] = v / (1.0f + __expf(-v)); }
    __syncthreads();
    const float* W = F_w_mod + (size_t)l * 1024 * 6144 + cg * 128 + F.lane * 2;
    float acc[9][2];
#pragma unroll
    for (int r = 0; r < 9; ++r) { acc[r][0] = 0.f; acc[r][1] = 0.f; }
    const int k0 = F.wave * 128;
#pragma unroll 16
    for (int kk = 0; kk < 128; ++kk) { const int k = k0 + kk; const f32x2 w = __builtin_nontemporal_load((const f32x2*)(W + (size_t)k * 6144));
#pragma unroll
        for (int r = 0; r < 9; ++r) { const float a = act[r * 1024 + k]; acc[r][0] += a * w[0]; acc[r][1] += a * w[1]; } }
#pragma unroll
    for (int r = 0; r < 9; ++r) *(f32x2*)(red + (F.wave * 9 + r) * 128 + F.lane * 2) = (f32x2){acc[r][0], acc[r][1]};
    __syncthreads();
    for (int idx = F.tid; idx < 9 * 128; idx += NTHR) { const int r = idx >> 7, cc = idx & 127; float s = F_b_mod[l * 6144 + cg * 128 + cc];
#pragma unroll
        for (int w = 0; w < 8; ++w) s += red[(w * 9 + r) * 128 + cc];
        F_MOD[(size_t)(l * 9 + r) * 6144 + cg * 128 + cc] = s; }
    __syncthreads();
}
__device__ __forceinline__ void prologue(Frame& F) {
    for (int u = blockIdx.x; u < 192; u += F.G) mod_unit(F, u);
    for (int idx = blockIdx.x * NTHR + F.tid; idx < 128 * 16; idx += F.G * NTHR) { const int pos = idx >> 4, j = idx & 15;
        const float inv = __builtin_amdgcn_exp2f(-(float)j * (13.287712379549449f / 16.0f)); const float ang = (float)pos * inv;
        F_ROPE[idx] = (f32x2){__cosf(ang), __sinf(ang)}; }
    if (blockIdx.x == 0) { for (int i = F.tid; i < D / 2; i += NTHR) ((unsigned*)(F_HB + (size_t)ZROW * D))[i] = 0u; }
    convert_items(F, 0, 0, layer_items(0), (int)blockIdx.x, F.G);
}

constexpr int NR = 4;
__device__ __forceinline__ void norm1_phase(Frame& F, int l, bool fin) {
    const int nrows = NLAT + ((!fin && ctx_in_l(l)) ? NCTX : 0);
    const int nch = nrows / NR;
    int pstartv = 0;
    if (l > 0) { const int c = (F.lane < 16) ? (int)__hip_atomic_load(F.ctl + CW_CNT + ((l - 1) * 16 + F.lane) * 64, __ATOMIC_RELAXED, __HIP_MEMORY_SCOPE_AGENT) : 0; const int p = (c + 255) & ~255; int incl = p;
#pragma unroll
        for (int o = 1; o < 16; o <<= 1) { const int t = __shfl_up(incl, o); if (F.lane >= o) incl += t; }
        pstartv = incl - p; }
    for (int ch = F.gw; ch < nch; ch += F.NGW) {
        const int r0 = ch * NR; const bool isz = r0 >= NLAT; const int b = isz ? 8 : (r0 >> 13);
        const float* src; float* dst;
        if (!isz) { src = (l == 0 ? F_x : F.out) + (size_t)r0 * D; dst = F.xw + (size_t)r0 * D; }
        else { const int j = r0 - NLAT; src = (l == 0 ? F_ctx : F_Z) + (size_t)j * D; dst = F_Z + (size_t)j * D; }
        f32x4 v[NR][4];
#pragma unroll
        for (int j = 0; j < NR; ++j)
#pragma unroll
            for (int q = 0; q < 4; ++q) v[j][q] = __builtin_nontemporal_load((const f32x4*)(src + (size_t)j * D + F.lane * 4 + 256 * q));
        if (l > 0) {
            u32x2 dd[NR]; float w0[NR], w1[NR];
#pragma unroll
            for (int j = 0; j < NR; ++j) { const u32x4 rt = F_RT[r0 + j]; w0[j] = __uint_as_float(rt.z); w1[j] = __uint_as_float(rt.w);
                const int e0 = __builtin_amdgcn_readfirstlane((int)(rt.x & 15u)), e1 = __builtin_amdgcn_readfirstlane((int)(rt.y & 15u));
                dd[j].x = (unsigned)__builtin_amdgcn_readlane(pstartv, e0) + (rt.x >> 4); dd[j].y = (unsigned)__builtin_amdgcn_readlane(pstartv, e1) + (rt.y >> 4); }
            const float* gate = F_MOD + (size_t)((l - 1) * 9 + b) * 6144 + 5 * 1024;
            f32x4 g[4];
#pragma unroll
            for (int q = 0; q < 4; ++q) g[q] = *(const f32x4*)(gate + F.lane * 4 + 256 * q);
            u32x2 ya[NR][4], yb[NR][4];
#pragma unroll
            for (int j = 0; j < NR; ++j)
#pragma unroll
                for (int q = 0; q < 4; ++q) { const int col = F.lane * 4 + 256 * q; ya[j][q] = __builtin_nontemporal_load((const u32x2*)(F_Y + (size_t)dd[j].x * D + col)); yb[j][q] = __builtin_nontemporal_load((const u32x2*)(F_Y + (size_t)dd[j].y * D + col)); }
#pragma unroll
            for (int j = 0; j < NR; ++j)
#pragma unroll
                for (int q = 0; q < 4; ++q) { const int col = F.lane * 4 + 256 * q; const u32x2 a = ya[j][q], bq = yb[j][q];
                    v[j][q][0] += g[q][0] * (w0[j] * bflo(a.x) + w1[j] * bflo(bq.x)); v[j][q][1] += g[q][1] * (w0[j] * bfhi(a.x) + w1[j] * bfhi(bq.x));
                    v[j][q][2] += g[q][2] * (w0[j] * bflo(a.y) + w1[j] * bflo(bq.y)); v[j][q][3] += g[q][3] * (w0[j] * bfhi(a.y) + w1[j] * bfhi(bq.y));
                    __builtin_nontemporal_store(v[j][q], (f32x4*)(dst + (size_t)j * D + col)); }
        }
        if (!fin) {
            float rstd[NR];
#pragma unroll
            for (int j = 0; j < NR; ++j) { float ss = 0.f;
#pragma unroll
                for (int q = 0; q < 4; ++q) ss += (v[j][q][0] * v[j][q][0] + v[j][q][1] * v[j][q][1]) + (v[j][q][2] * v[j][q][2] + v[j][q][3] * v[j][q][3]);
                rstd[j] = __builtin_amdgcn_rsqf(wave_sum(ss) * (1.0f / D) + EPS); }
            const float* gm = F_g_mix + l * D; const float* sh = F_MOD + (size_t)(l * 9 + b) * 6144; const float* sc = sh + 1024;
#pragma unroll
            for (int q = 0; q < 4; ++q) { const int col = F.lane * 4 + 256 * q; const f32x4 g = *(const f32x4*)(gm + col), s = *(const f32x4*)(sh + col), cc = *(const f32x4*)(sc + col);
                const f32x4 A = g * (cc + 1.0f);
#pragma unroll
                for (int j = 0; j < NR; ++j) { const f32x4 h = v[j][q] * rstd[j] * A + s;
                    *(u32x2*)(F_HB + (size_t)(r0 + j) * D + col) = (u32x2){pk2(h[0], h[1]), pk2(h[2], h[3])}; } }
        }
    }
}

__device__ __forceinline__ void norm2_phase(Frame& F, int l) {
    float* RWT = (float*)F.ldsg;
    unsigned* wcnt = (unsigned*)(F.ldsg + 65536);
    for (int idx = F.tid; idx < 4096; idx += NTHR) { const f32x4 w = *(const f32x4*)(F_router_w + idx * 4); const int col = idx >> 2, e0 = (idx & 3) * 4;
        RWT[(e0 + 0) * 1024 + col] = w[0]; RWT[(e0 + 1) * 1024 + col] = w[1]; RWT[(e0 + 2) * 1024 + col] = w[2]; RWT[(e0 + 3) * 1024 + col] = w[3]; }
    float rb[16];
#pragma unroll
    for (int e = 0; e < 16; ++e) rb[e] = F_router_b[e];
    __syncthreads();
    unsigned cnt = 0u;
    unsigned* wbase = (unsigned*)(F.ldsg + 66048);
    u32x4* stash = (u32x4*)(F.ldsg + 66560) + F.wave * 96; int nst = 0;
    const int nrows = NLAT + (ctx_out_l(l) ? NCTX : 0);
    const int nch = nrows / NR;
    for (int ch = F.gw; ch < nch; ch += F.NGW) {
        const int r0 = ch * NR; const bool isz = r0 >= NLAT; const int b = isz ? 8 : (r0 >> 13);
        const float* src; float* dst;
        if (!isz) { src = (l == 0 ? F_x : F.out) + (size_t)r0 * D; dst = F.xw + (size_t)r0 * D; }
        else { const int j = r0 - NLAT; src = (l == 0 ? F_ctx : F_Z) + (size_t)j * D; dst = F_Z + (size_t)j * D; }
        const float* mrow = F_MOD + (size_t)(l * 9 + b) * 6144;
        f32x4 v[NR][4]; u32x2 ox[NR][4];
#pragma unroll
        for (int j = 0; j < NR; ++j)
#pragma unroll
            for (int q = 0; q < 4; ++q) { const int col = F.lane * 4 + 256 * q; v[j][q] = __builtin_nontemporal_load((const f32x4*)(src + (size_t)j * D + col)); ox[j][q] = __builtin_nontemporal_load((const u32x2*)(F_OX + (size_t)(r0 + j) * D + col)); }
        float rstd[NR];
        {
            f32x4 g[4];
#pragma unroll
            for (int q = 0; q < 4; ++q) g[q] = *(const f32x4*)(mrow + 2 * 1024 + F.lane * 4 + 256 * q);
#pragma unroll
            for (int j = 0; j < NR; ++j) { float ss = 0.f;
#pragma unroll
                for (int q = 0; q < 4; ++q) { const u32x2 o = ox[j][q];
                    v[j][q][0] += g[q][0] * bflo(o.x); v[j][q][1] += g[q][1] * bfhi(o.x); v[j][q][2] += g[q][2] * bflo(o.y); v[j][q][3] += g[q][3] * bfhi(o.y);
                    __builtin_nontemporal_store(v[j][q], (f32x4*)(dst + (size_t)j * D + F.lane * 4 + 256 * q));
                    ss += (v[j][q][0] * v[j][q][0] + v[j][q][1] * v[j][q][1]) + (v[j][q][2] * v[j][q][2] + v[j][q][3] * v[j][q][3]); }
                rstd[j] = __builtin_amdgcn_rsqf(wave_sum(ss) * (1.0f / D) + EPS); }
        }
        const float* gf = F_g_ffn + l * D;
#pragma unroll
        for (int q = 0; q < 4; ++q) { const int col = F.lane * 4 + 256 * q; const f32x4 g = *(const f32x4*)(gf + col), s = *(const f32x4*)(mrow + 3 * 1024 + col), cc = *(const f32x4*)(mrow + 4 * 1024 + col);
            const f32x4 A = g * (cc + 1.0f);
#pragma unroll
            for (int j = 0; j < NR; ++j) { v[j][q] = v[j][q] * rstd[j] * A + s;
                *(u32x2*)(F_HB + (size_t)(r0 + j) * D + col) = (u32x2){pk2(v[j][q][0], v[j][q][1]), pk2(v[j][q][2], v[j][q][3])}; } }
        float lg[NR * 16];
#pragma unroll
        for (int i = 0; i < NR * 16; ++i) lg[i] = 0.f;
#pragma unroll
        for (int q = 0; q < 4; ++q) { const int col = F.lane * 4 + 256 * q;
#pragma unroll
            for (int e = 0; e < 16; ++e) { const f32x4 w = *(const f32x4*)(RWT + e * 1024 + col);
#pragma unroll
                for (int j = 0; j < NR; ++j) { float t_ = lg[j * 16 + e]; t_ = __builtin_fmaf(v[j][q][0], w[0], t_); t_ = __builtin_fmaf(v[j][q][1], w[1], t_); t_ = __builtin_fmaf(v[j][q][2], w[2], t_); t_ = __builtin_fmaf(v[j][q][3], w[3], t_); lg[j * 16 + e] = t_; }
                if ((e & 3) == 3) asm volatile("" ::: "memory"); } }
#define RS_STEP(N, MASK) do { const bool up_ = (F.lane & (MASK)) != 0; _Pragma("unroll") for (int k = 0; k < (N) / 2; ++k) { const float a_ = lg[k], b_ = lg[k + (N) / 2]; \
            const float send_ = up_ ? a_ : b_, keep_ = up_ ? b_ : a_; lg[k] = keep_ + __shfl_xor(send_, (MASK)); } } while (0)
        RS_STEP(64, 32); RS_STEP(32, 16); RS_STEP(16, 8); RS_STEP(8, 4); RS_STEP(4, 2); RS_STEP(2, 1);
#undef RS_STEP
        const float myv = lg[0];
        float lx[16];
#pragma unroll
        for (int e = 0; e < 16; ++e) lx[e] = __shfl(myv, (F.lane & 48) | e);
        float aff[16], sel[16];
#pragma unroll
        for (int e = 0; e < 16; ++e) { aff[e] = sigmoidf_(lx[e]); sel[e] = aff[e] + rb[e]; }
        float gs[4];
#pragma unroll
        for (int g = 0; g < 4; ++g) { const float a = sel[4 * g], bb = sel[4 * g + 1], c = sel[4 * g + 2], d = sel[4 * g + 3];
            const float hi1 = fmaxf(a, bb), lo1 = fminf(a, bb), hi2 = fmaxf(c, d), lo2 = fminf(c, d);
            gs[g] = fmaxf(hi1, hi2) + fmaxf(fminf(hi1, hi2), fmaxf(lo1, lo2)); }
        int grp = 0; float best = gs[0];
#pragma unroll
        for (int g = 1; g < 4; ++g) if (gs[g] > best) { best = gs[g]; grp = g; }
        float si[4], ai[4];
#pragma unroll
        for (int k = 0; k < 4; ++k) { si[k] = grp == 0 ? sel[k] : grp == 1 ? sel[4 + k] : grp == 2 ? sel[8 + k] : sel[12 + k]; ai[k] = grp == 0 ? aff[k] : grp == 1 ? aff[4 + k] : grp == 2 ? aff[8 + k] : aff[12 + k]; }
        int i0 = 0; float b0 = si[0];
#pragma unroll
        for (int k = 1; k < 4; ++k) if (si[k] > b0) { b0 = si[k]; i0 = k; }
        int i1 = -1; float b1 = -1e30f;
#pragma unroll
        for (int k = 0; k < 4; ++k) if (k != i0 && si[k] > b1) { b1 = si[k]; i1 = k; }
        const float a0 = i0 == 0 ? ai[0] : i0 == 1 ? ai[1] : i0 == 2 ? ai[2] : ai[3];
        const float a1 = i1 == 0 ? ai[0] : i1 == 1 ? ai[1] : i1 == 2 ? ai[2] : ai[3];
        const float inv = fast_rcp(a0 + a1);
        const int e0 = grp * 4 + i0, e1 = grp * 4 + i1;
        unsigned mylr0 = 0u, mylr1 = 0u;
#pragma unroll
        for (int j = 0; j < NR; ++j) {
            const int e0j = __builtin_amdgcn_readlane(e0, 16 * j), e1j = __builtin_amdgcn_readlane(e1, 16 * j);
            const unsigned lr0 = __builtin_amdgcn_readlane(cnt, e0j); cnt += (F.lane == e0j) ? 1u : 0u;
            const unsigned lr1 = __builtin_amdgcn_readlane(cnt, e1j); cnt += (F.lane == e1j) ? 1u : 0u;
            if ((F.lane >> 4) == j) { mylr0 = lr0; mylr1 = lr1; }
        }
        if ((F.lane & 15) == 0) stash[nst + (F.lane >> 4)] = (u32x4){(unsigned)e0 | (mylr0 << 4), (unsigned)e1 | (mylr1 << 4), __float_as_uint(a0 * inv), __float_as_uint(a1 * inv)};
        nst += NR;
    }
    if (F.lane < 16) wcnt[F.wave * 16 + F.lane] = cnt;
    __syncthreads();
    if (F.tid < 16) { const int e = F.tid; unsigned tot = 0u, pre[8];
#pragma unroll
        for (int w = 0; w < 8; ++w) { pre[w] = tot; tot += wcnt[w * 16 + e]; }
        const unsigned base = __hip_atomic_fetch_add(F.ctl + CW_CNT + (l * 16 + e) * 64, tot, __ATOMIC_RELAXED, __HIP_MEMORY_SCOPE_AGENT);
#pragma unroll
        for (int w = 0; w < 8; ++w) wbase[w * 16 + e] = base + pre[w]; }
    __syncthreads();
    for (int i = F.lane; i < nst; i += 64) { const u32x4 st = stash[i]; const int ci = i >> 2, j = i & 3; const unsigned tok = (unsigned)((F.gw + ci * F.NGW) * NR + j);
        const unsigned e0 = st.x & 15u, e1 = st.y & 15u; const unsigned rk0 = wbase[F.wave * 16 + e0] + (st.x >> 4), rk1 = wbase[F.wave * 16 + e1] + (st.y >> 4);
        F_ROWTOK[(size_t)e0 * VCAP + rk0] = tok; F_ROWTOK[(size_t)e1 * VCAP + rk1] = tok;
        F_RT[tok] = (u32x4){e0 | (rk0 << 4), e1 | (rk1 << 4), st.z, st.w}; }
    __syncthreads();
}

__device__ __forceinline__ int moe_prefix(Frame& F, int l, LAS int* pend, LAS int* pstart, LAS int* pcnt) {
    if (F.tid < 64) {
        const int c = (F.lane < 16) ? (int)__hip_atomic_load(F.ctl + CW_CNT + (l * 16 + F.lane) * 64, __ATOMIC_RELAXED, __HIP_MEMORY_SCOPE_AGENT) : 0;
        const int p = (c + 255) & ~255; int incl = p;
#pragma unroll
        for (int o = 1; o < 16; o <<= 1) { const int t = __shfl_up(incl, o); if (F.lane >= o) incl += t; }
        if (F.lane < 16) { pend[F.lane] = incl; pstart[F.lane] = incl - p; pcnt[F.lane] = c; }
    }
    __syncthreads();
    return __builtin_amdgcn_readfirstlane(pend[15] >> 8);
}

__device__ __forceinline__ void attn_phase(Frame& F, int l) {
    const int bx = blockIdx.x; const int vcu = (F.G % 8 == 0) ? (bx % 8) * (F.G / 8) + bx / 8 : bx;
    char* shm = (char*)F.ldsg;
    for (int U = vcu; U < NB * NH * (SEQ / 256); U += F.G) {
        const int h = U >> 8, b = (U & 255) >> 5, qb = U & 31;
        const size_t qrow = (size_t)b * SEQ + (size_t)qb * 256;
        attn_body::attn_unit<8>(F_Q + qrow * AW + h * 64, F_KB + (size_t)b * KVS * KVW + (h >> 2) * 64, F_VB + (size_t)b * KVS * KVW + (h >> 2) * 64, F_CAT + qrow * D + h * 64, KVS / 64, shm, F.tid);
    }
    if (ctx_out_l(l)) {
        for (int V = vcu; V < 8 * 32; V += F.G) {
            const int b = V >> 5, h = V & 31; if (h >= NH) continue;
            const size_t qrow = (size_t)NLAT + (size_t)b * CTXL; const size_t kv0 = (size_t)b * KVS + SEQ;
            attn_body::attn_unit<8>(F_Q + qrow * AW + h * 64, F_KB + kv0 * KVW + (h >> 2) * 64, F_VB + kv0 * KVW + (h >> 2) * 64, F_CAT + qrow * D + h * 64, CTXL / 64, shm, F.tid);
        }
    }
}
__device__ __forceinline__ float cv_ld(const bf16* AG, int s0, int len, int p, int ch) {
    const bool ok = p >= 0 && p < len; const int pc = p < 0 ? 0 : (p >= len ? len - 1 : p);
    const bf16* rp = AG + (size_t)(s0 + pc) * CAW; asm volatile("" : "+s"(rp));
    const float v = __uint_as_float((unsigned)((const GAS bf16*)rp)[ch] << 16);
    return ok ? v : 0.f;
}
__device__ __forceinline__ void conv_unit(Frame& F, const float* dw, const float* db, const float* lg, const float* lb, int s0, int len, int t0, int nchunk) {
    const int ch = F.wave * 64 + F.lane;
    float* ytile = (float*)F.ldsg;
    float w[31];
#pragma unroll
    for (int k = 0; k < 31; ++k) w[k] = dw[k * CAW + ch];
    const float bias = db[ch];
    const bf16* agb = F_AG;
#define CV_LD(p) cv_ld(agb, s0, len, (p), ch)
    float lo[32], hi[32];
#pragma unroll
    for (int i = 0; i < 32; ++i) { lo[i] = CV_LD(t0 - 16 + i); hi[i] = CV_LD(t0 + 16 + i); }
    const f32x4 g0 = *(const f32x4*)(lg + F.lane * 4), g1 = *(const f32x4*)(lg + 256 + F.lane * 4), b0 = *(const f32x4*)(lb + F.lane * 4), b1 = *(const f32x4*)(lb + 256 + F.lane * 4);
    for (int c = 0; c < nchunk; ++c) {
        const int T = t0 + 32 * c;
        float* yb = ytile + (c & 1) * (32 * 512);
#pragma unroll
        for (int u = 0; u < 32; ++u) { float acc = bias;
#pragma unroll
            for (int k = 0; k < 31; ++k) { const int e = u + k + 1; acc += w[k] * (e < 32 ? lo[e & 31] : hi[e & 31]); }
            yb[u * 512 + ch] = acc; }
#pragma unroll
        for (int i = 0; i < 32; ++i) { lo[i] = hi[i]; hi[i] = CV_LD(T + 48 + i); }
        __syncthreads();
#pragma unroll
        for (int rr = 0; rr < 4; ++rr) { const int u = F.wave * 4 + rr; const size_t row = (size_t)s0 + T + u;
            f32x4 y0 = *(const f32x4*)(yb + u * 512 + F.lane * 4), y1 = *(const f32x4*)(yb + u * 512 + 256 + F.lane * 4);
            const float mean = wave_sum((y0[0] + y0[1]) + (y0[2] + y0[3]) + (y1[0] + y1[1]) + (y1[2] + y1[3])) * (1.0f / CAW);
            y0 = y0 - mean; y1 = y1 - mean;
            const float rstd = __builtin_amdgcn_rsqf(wave_sum((y0[0] * y0[0] + y0[1] * y0[1]) + (y0[2] * y0[2] + y0[3] * y0[3]) + (y1[0] * y1[0] + y1[1] * y1[1]) + (y1[2] * y1[2] + y1[3] * y1[3])) * (1.0f / CAW) + EPS);
            y0 = y0 * rstd * g0 + b0; y1 = y1 * rstd * g1 + b1;
            *(u32x2*)(F_CAT + row * D + AW + F.lane * 4) = (u32x2){pk2(siluf_(y0[0]), siluf_(y0[1])), pk2(siluf_(y0[2]), siluf_(y0[3]))};
            *(u32x2*)(F_CAT + row * D + AW + 256 + F.lane * 4) = (u32x2){pk2(siluf_(y1[0]), siluf_(y1[1])), pk2(siluf_(y1[2]), siluf_(y1[3]))}; }
    }
#undef CV_LD
    __syncthreads();
}
__device__ __forceinline__ void conv_phase(Frame& F, int l) {
    const int i = l >> 1;
    const float* dw = F_ev_dw_w + (size_t)i * 31 * CAW; const float* db = F_ev_dw_b + i * CAW; const float* lg = F_ev_ln_g + i * CAW; const float* lb = F_ev_ln_b + i * CAW;
    const int nu = NLAT / 128 + (ctx_out_l(l) ? NCTX / 128 : 0);
    for (int U = blockIdx.x; U < nu; U += F.G) {
        int s0, len, t0;
        if (U < NLAT / 128) { s0 = (U >> 6) * SEQ; len = SEQ; t0 = (U & 63) * 128; } else { const int V = U - NLAT / 128; s0 = NLAT + (V >> 1) * CTXL; len = CTXL; t0 = (V & 1) * 128; }
        conv_unit(F, dw, db, lg, lb, s0, len, t0, 4);
    }
}
__device__ __forceinline__ void sconv_phase(Frame& F, int l) {
    const int i = l >> 1; const int nrows = NLAT + (ctx_out_l(l) ? NCTX : 0);
    const float* cw = F_od_conv_w + (size_t)i * 3 * D;
    const int c0 = F.lane * 8, c1 = 512 + F.lane * 8;
    f32x4 w[3][4];
#pragma unroll
    for (int k = 0; k < 3; ++k) { w[k][0] = *(const f32x4*)(cw + k * D + c0); w[k][1] = *(const f32x4*)(cw + k * D + c0 + 4); w[k][2] = *(const f32x4*)(cw + k * D + c1); w[k][3] = *(const f32x4*)(cw + k * D + c1 + 4); }
    for (int r = F.gw * 2; r < nrows; r += F.NGW * 2) {
        int s0, len; if (r < NLAT) { s0 = r & ~(SEQ - 1); len = SEQ; } else { s0 = NLAT + ((r - NLAT) & ~255); len = CTXL; }
        const int pos = r - s0;
        u32x4 uu[4][2], gb[2][2];
#pragma unroll
        for (int k = 0; k < 4; ++k) { const int p = pos + k - 1; const int pc = p < 0 ? 0 : (p >= len ? len - 1 : p); const bf16* ur = F_U + (size_t)(s0 + pc) * D;
            uu[k][0] = __builtin_nontemporal_load((const u32x4*)(ur + c0)); uu[k][1] = __builtin_nontemporal_load((const u32x4*)(ur + c1)); }
#pragma unroll
        for (int j = 0; j < 2; ++j) { gb[j][0] = __builtin_nontemporal_load((const u32x4*)(F_GB + (size_t)(r + j) * D + c0)); gb[j][1] = __builtin_nontemporal_load((const u32x4*)(F_GB + (size_t)(r + j) * D + c1)); }
        float uf[4][16];
#pragma unroll
        for (int k = 0; k < 4; ++k) { const int p = pos + k - 1; const bool ok = p >= 0 && p < len; unpack8(uu[k][0], uf[k]); unpack8(uu[k][1], uf[k] + 8);
            if (!ok) {
#pragma unroll
                for (int c = 0; c < 16; ++c) uf[k][c] = 0.f; } }
#pragma unroll
        for (int j = 0; j < 2; ++j) { float g[16], y[16]; unpack8(gb[j][0], g); unpack8(gb[j][1], g + 8);
#pragma unroll
            for (int c = 0; c < 16; ++c) { const int q = c >> 2, e = c & 3; y[c] = g[c] * (w[0][q][e] * uf[j][c] + w[1][q][e] * uf[j + 1][c] + w[2][q][e] * uf[j + 2][c]); }
            *(u32x4*)(F_SB + (size_t)(r + j) * D + c0) = pack8(y); *(u32x4*)(F_SB + (size_t)(r + j) * D + c1) = pack8(y + 8); }
    }
}

#ifndef PROBE
#define PROBE (-1)
#endif
#ifndef ONLY
#define ONLY (-1)
#endif
constexpr int PPL = 9, NPH = 1 + DEPTH * PPL + 1;
__global__ void __launch_bounds__(NTHR, 2) fwd(Args args) {
    extern __shared__ __attribute__((aligned(16))) unsigned char lds_[];
    Frame F;
    F.lds = (LAS unsigned char*)lds_; F.ldsg = lds_;
    F.MISC = (volatile LAS unsigned*)(F.lds + MISC_OFF);
    F.tid = threadIdx.x; F.lane = F.tid & 63; F.wave = __builtin_amdgcn_readfirstlane(F.tid >> 6);
    const int wave0 = F.wave;
#define MY_TID() (wave0 * 64 + (int)__builtin_amdgcn_mbcnt_hi(~0u, __builtin_amdgcn_mbcnt_lo(~0u, opaque_zero())))
    F.G = gridDim.x; F.gw = blockIdx.x * NWAVES + F.wave; F.NGW = F.G * NWAVES;
    F.ws = args.ws; F.ctl = (unsigned*)(args.ws + WS_CTL); F.out = args.out; F.in = args.in;
    for (int u = F.tid; u < (LDS_BYTES - LDSCTL_OFF) / 4; u += NTHR) ((LAS unsigned*)(F.lds + LDSCTL_OFF))[u] = 0u;
    __syncthreads();
    const int lo = args.ph_lo, hi = args.ph_hi;
    const int bar_off = args.dry ? 16384 : CW_BAR;
    XcdBarrier bar; bar.bar = F.ctl + bar_off; bar.x = 0; bar.st = F.MISC + 8;
    if (hi - lo > 1) bar = xcd_barrier_post(F.ctl + bar_off, F.MISC + 8, F.tid);
#define IN(k) (lo <= (k) && (k) < hi)
#define EN(id) (ONLY < 0 || ONLY == (id))
#define PH(id, k) for (int rp_ = 0; rp_ < ((PROBE == (id)) ? 2 : 1); ++rp_) if (EN(id) && IN(k))
#define PB() do { if (rp_) __syncthreads(); int t_ = MY_TID(); asm volatile("" : "+v"(t_)); F.tid = t_; F.lane = t_ & 63; F.wave = __builtin_amdgcn_readfirstlane(t_ >> 6); F.gw = blockIdx.x * NWAVES + F.wave; \
    F.ws = args.ws; F.in = args.in; F.out = args.out; { unsigned long long w_ = rfl64((unsigned long long)F.ws), o_ = rfl64((unsigned long long)F.out); asm volatile("" : "+s"(w_), "+s"(o_)); w_ = rfl64(w_); o_ = rfl64(o_); F.ws = (unsigned char*)(GAS unsigned char*)w_; F.out = (float*)(GAS float*)o_; F.xw = args.dry ? (float*)(F.ws + WS_Q) : F.out; } F.ctl = (unsigned*)(F.ws + WS_CTL); } while (0)
#define SEAM(k) do { if (IN(k) && IN((k) + 1)) { unsigned long long b_ = rfl64((unsigned long long)((unsigned*)(args.ws + WS_CTL) + bar_off)); asm volatile("" : "+s"(b_)); bar.bar = (unsigned*)(GAS unsigned*)rfl64(b_); xcd_barrier(bar, MY_TID()); if (PROBE == 200) xcd_barrier(bar, MY_TID()); } } while (0)

#if PROBE >= 300 && PROBE < 400
    {
        int rp_ = 0; PB();
        float* dstp = (float*)(F.ws + WS_P);
        const float* srcp = (const float*)(F.ws + WS_Q);
#if PROBE == 300
        for (int ch = F.gw; ch < NLAT / 4; ch += F.NGW) { f32x4 v[4][4];
#pragma unroll
            for (int j = 0; j < 4; ++j)
#pragma unroll
                for (int q = 0; q < 4; ++q) v[j][q] = __builtin_nontemporal_load((const f32x4*)(srcp + (size_t)(ch * 4 + j) * D + F.lane * 4 + 256 * q));
#pragma unroll
            for (int j = 0; j < 4; ++j)
#pragma unroll
                for (int q = 0; q < 4; ++q) __builtin_nontemporal_store(v[j][q], (f32x4*)(dstp + (size_t)(ch * 4 + j) * D + F.lane * 4 + 256 * q)); }
#elif PROBE == 301
        for (int ch = F.gw; ch < NLAT / 8; ch += F.NGW) { f32x4 v[8][4];
#pragma unroll
            for (int j = 0; j < 8; ++j)
#pragma unroll
                for (int q = 0; q < 4; ++q) v[j][q] = __builtin_nontemporal_load((const f32x4*)(srcp + (size_t)(ch * 8 + j) * D + F.lane * 4 + 256 * q));
#pragma unroll
            for (int j = 0; j < 8; ++j)
#pragma unroll
                for (int q = 0; q < 4; ++q) __builtin_nontemporal_store(v[j][q], (f32x4*)(dstp + (size_t)(ch * 8 + j) * D + F.lane * 4 + 256 * q)); }
#elif PROBE == 302
        for (int ch = F.gw; ch < NLAT / 4; ch += F.NGW) { f32x4 v[4][4];
#pragma unroll
            for (int j = 0; j < 4; ++j)
#pragma unroll
                for (int q = 0; q < 4; ++q) v[j][q] = *(const f32x4*)(srcp + (size_t)(ch * 4 + j) * D + F.lane * 4 + 256 * q);
#pragma unroll
            for (int j = 0; j < 4; ++j)
#pragma unroll
                for (int q = 0; q < 4; ++q) *(f32x4*)(dstp + (size_t)(ch * 4 + j) * D + F.lane * 4 + 256 * q) = v[j][q]; }
#elif PROBE == 303
        { f32x4 acc = {0.f, 0.f, 0.f, 0.f};
        for (int ch = F.gw; ch < NLAT / 4; ch += F.NGW) { f32x4 v[4][4];
#pragma unroll
            for (int j = 0; j < 4; ++j)
#pragma unroll
                for (int q = 0; q < 4; ++q) v[j][q] = __builtin_nontemporal_load((const f32x4*)(srcp + (size_t)(ch * 4 + j) * D + F.lane * 4 + 256 * q));
#pragma unroll
            for (int j = 0; j < 4; ++j)
#pragma unroll
                for (int q = 0; q < 4; ++q) acc += v[j][q]; }
        *(f32x4*)(dstp + (size_t)F.gw * 256 + F.lane * 4) = acc; }
#endif
        __syncthreads();
    }
#endif
    PH(100, 0) { PB(); prologue(F); }
    SEAM(0);
    for (int l = 0; l < DEPTH; ++l) {
        const int pb = 1 + l * PPL; const bool even = !(l & 1); const int li = l >> 1;
        for (int rp_ = 0; rp_ < ((PROBE == 10 && l == 0) ? 2 : 1); ++rp_) if (EN(10) && IN(pb + 0)) { PB(); norm1_phase(F, l, false); }
        SEAM(pb + 0);
        PH(1, pb + 1) {
            PB();
            if (even) {
                pg8::EvenInOrder S; S.d.init(NLAT, EVIN, D, F_W_EVIN + (size_t)li * EVIN * D, F.G, (int)blockIdx.x); S.kvonly = !ctx_out_l(l);
                pg8::EpiEvenIn E{F_Q, F_KB, F_VB, F_AG, F_ev_qg + li * 64, F_ev_kg + li * 64, F_ROPE};
                pg8::gemm_phase<pg8::EpiEvenIn, pg8::EvenInOrder>(F.lds, F_HB, D, S, E, F.tid);
                convert_tail(F, l, 0, S.d.nwg + (S.kvonly ? NCTX / 256 : (NCTX / 256) * 7), (int)blockIdx.x);
            } else {
                const int M = NLAT + (ctx_out_l(l) ? NCTX : 0);
                pg8::DenseOrder S; S.init(M, ODIN, D, F_W_ODIN + (size_t)li * ODIN * D, F.G, (int)blockIdx.x);
                pg8::EpiOddIn E{F_U, F_GB};
                pg8::gemm_phase<pg8::EpiOddIn, pg8::DenseOrder>(F.lds, F_HB, D, S, E, F.tid);
                convert_tail(F, l, 0, S.nwg, (int)blockIdx.x);
            }
        }
        if (IN(pb + 1) && IN(pb + 3)) { unsigned long long b_ = rfl64((unsigned long long)((unsigned*)(args.ws + WS_CTL) + bar_off)); asm volatile("" : "+s"(b_)); bar.bar = (unsigned*)(GAS unsigned*)rfl64(b_); xcd_barrier(bar, MY_TID()); if (PROBE == 200) xcd_barrier(bar, MY_TID()); }
        if (even) {
            PH(30, pb + 3) { PB(); attn_phase(F, l); }
            PH(31, pb + 3) { PB(); conv_phase(F, l); }
        } else {
            PH(32, pb + 3) { PB(); sconv_phase(F, l); }
        }
        SEAM(pb + 3);
        PH(4, pb + 4) {
            PB();
            const int M = NLAT + (ctx_out_l(l) ? NCTX : 0);
            pg8::DenseOrder S; S.init(M, D, D, even ? F_W_EVOUT + (size_t)li * D * D : F_W_ODOUT + (size_t)li * D * D, F.G, (int)blockIdx.x);
            pg8::EpiPlain E{F_OX, D};
            pg8::gemm_phase<pg8::EpiPlain, pg8::DenseOrder>(F.lds, even ? F_CAT : F_SB, D, S, E, F.tid);
            convert_tail(F, l, 1, S.nwg, (int)blockIdx.x);
        }
        SEAM(pb + 4);
        PH(5, pb + 5) { PB(); norm2_phase(F, l); }
        if (IN(pb + 5) && IN(pb + 7)) { unsigned long long b_ = rfl64((unsigned long long)((unsigned*)(args.ws + WS_CTL) + bar_off)); asm volatile("" : "+s"(b_)); bar.bar = (unsigned*)(GAS unsigned*)rfl64(b_); xcd_barrier(bar, MY_TID()); }
        PH(7, pb + 7) {
            PB();
            LAS int* pend = (LAS int*)(F.lds + LDSCTL_OFF); LAS int* pstart = pend + 16; LAS int* pcnt = pend + 32;
            const int nblk = moe_prefix(F, l, pend, pstart, pcnt);
            pg8::MoeOrder<true> S; S.nblk = nblk; S.G = F.G; S.c = (F.G % 8 == 0) ? (int)((blockIdx.x % 8) * (F.G / 8) + blockIdx.x / 8) : (int)blockIdx.x;     S.K = D; S.Bt = F_W_MOE1 + (size_t)l * NE * D * D; S.estride = (size_t)D * D * 2; S.pend = pend; S.rowtok = F_ROWTOK;
            pg8::EpiSwiGLU E{F_HMID};
            pg8::gemm_phase<pg8::EpiSwiGLU, pg8::MoeOrder<true>>(F.lds, F_HB, D, S, E, F.tid);
            convert_tail(F, l, 2, nblk * 4, S.c);
        }
        SEAM(pb + 7);
        PH(8, pb + 8) {
            PB();
            LAS int* pend = (LAS int*)(F.lds + LDSCTL_OFF); LAS int* pstart = pend + 16; LAS int* pcnt = pend + 32;
            const int nblk = moe_prefix(F, l, pend, pstart, pcnt);
            pg8::MoeOrder<false> S; S.nblk = nblk; S.G = F.G; S.c = (F.G % 8 == 0) ? (int)((blockIdx.x % 8) * (F.G / 8) + blockIdx.x / 8) : (int)blockIdx.x;     S.K = DE; S.Bt = F_W_MOE2 + (size_t)l * NE * D * DE; S.estride = (size_t)D * DE * 2; S.pend = pend; S.rowtok = nullptr;
            pg8::EpiPlain E{F_Y, D};
            pg8::gemm_phase<pg8::EpiPlain, pg8::MoeOrder<false>>(F.lds, F_HMID, DE, S, E, F.tid);
            convert_tail(F, l, 3, nblk * 4, S.c);
        }
        SEAM(pb + 8);
    }
    PH(11, NPH - 1) { PB(); norm1_phase(F, DEPTH, true); }
#undef IN
#undef SEAM
}

extern "C" void kernel_launch(void* const* d_in, const int* in_sizes, int n_in, void* d_out, int out_size, void* d_ws, size_t ws_size, hipStream_t stream) {
    static int grid = 0;
    if (grid == 0) {
        if (n_in != 24 || in_sizes[0] != NLAT * D || out_size != NLAT * D || ws_size < WS_END) { fprintf(stderr, "kernel_launch: unexpected shapes (n_in %d, in0 %d, out %d, ws %zu); nothing launched\n", n_in, n_in > 0 ? in_sizes[0] : -1, out_size, ws_size); grid = -1; return; }
        int dev = 0, cus = 0, per_cu = 0;
        if (hipGetDevice(&dev) != hipSuccess || hipDeviceGetAttribute(&cus, hipDeviceAttributeMultiprocessorCount, dev) != hipSuccess) { grid = -1; return; }
        if (hipFuncSetAttribute((const void*)fwd, hipFuncAttributeMaxDynamicSharedMemorySize, LDS_BYTES) != hipSuccess) { fprintf(stderr, "kernel_launch: hipFuncSetAttribute failed\n"); grid = -1; return; }
        if (hipOccupancyMaxActiveBlocksPerMultiprocessor(&per_cu, (const void*)fwd, NTHR, LDS_BYTES) != hipSuccess || per_cu < 1) fprintf(stderr, "kernel_launch: occupancy query reports %d\n", per_cu);
        (void)hipGetLastError();
        grid = cus;
    }
    if (grid < 0) return;
    if (hipMemsetAsync((char*)d_ws + WS_CTL, 0, CTL_ZERO_BYTES, stream) != hipSuccess) return;
    Args a{};
    for (int i = 0; i < 24; ++i) a.in[i] = (const float*)d_in[i];
    a.out = (float*)d_out; a.ws = (unsigned char*)d_ws;
#if MK_ONE_LAUNCH
#if defined(PROBE_CUM)
    a.ph_lo = 0; a.ph_hi = PROBE_CUM;
    hipLaunchKernelGGL(fwd, dim3(grid), dim3(NTHR), LDS_BYTES, stream, a);
    if (hipMemsetAsync((char*)d_ws + WS_CTL, 0, CTL_ZERO_BYTES, stream) != hipSuccess) return;
#endif
    a.ph_lo = 0; a.ph_hi = NPH;
    hipLaunchKernelGGL(fwd, dim3(grid), dim3(NTHR), LDS_BYTES, stream, a);
#if defined(PROBE_DRY)
#ifndef PROBE_DRY_N
#define PROBE_DRY_N 1
#endif
    a.ph_lo = PROBE_DRY; a.ph_hi = PROBE_DRY + PROBE_DRY_N; a.dry = 1;
    hipLaunchKernelGGL(fwd, dim3(grid), dim3(NTHR), LDS_BYTES, stream, a);
#endif
#else
    for (int p = 0; p < NPH; ++p) {
        if (p >= 1 && p < NPH - 1) { const int l = (p - 1) / PPL, k = (p - 1) % PPL; (void)l; if (k == 2 || k == 6) continue; }
        a.ph_lo = p; a.ph_hi = p + 1;
        hipLaunchKernelGGL(fwd, dim3(grid), dim3(NTHR), LDS_BYTES, stream, a);
    }
#endif
}
```
